# Optimizing an MI355X kernel written in HIP

```python
import jax, jax.numpy as jnp
from jax import lax
import numpy as np

D_MODEL = 1024
BATCH = 8
SEQ = 2048
DEPTH = 1
DEC_BATCH = 128
DEC_SEQ = 4
PAST_LEN = 16384
PAGE_SIZE = 128

N_META = 16
RET_HEADS = 4
RET_DK = 64
RET_DV = 128
RET_CHUNK = 128
RWKV_HEADS = 8
RWKV_HD = 64
RWKV_W = RWKV_HEADS * RWKV_HD
DECAY_LORA = 64
AAA_LORA = 64
GATE_LORA = 128
D_FF = 2816
ROPE_BASE = 10000.0
NORM_EPS = 1e-6
RET_GN_EPS = 1e-6
RWKV_GN_EPS = 64e-5

RET_QK = RET_HEADS * RET_DK
RET_V = RET_HEADS * RET_DV
SHIFT_W = 3 * RWKV_W + DECAY_LORA + AAA_LORA + GATE_LORA
GATE_W = 2 * D_MODEL
PROJ_W = 2 * RET_QK + 2 * RET_V + SHIFT_W + GATE_W

kernel_name = 'hybrid_retention_rwkv7_decoder'


def _rmsnorm(x, g):
    x32 = x.astype(jnp.float32)
    y = x32 * lax.rsqrt(jnp.mean(x32 * x32, axis=-1, keepdims=True) + NORM_EPS)
    return (y * g.astype(jnp.float32)).astype(x.dtype)


def _swiglu(x, w_gate, w_up, w_down):
    return (jax.nn.silu(x @ w_gate) * (x @ w_up)) @ w_down


def _rotary(x, pos):
    half = x.shape[-1] // 2
    inv_freq = ROPE_BASE ** (-jnp.arange(half, dtype=jnp.float32) / half)
    ang = pos.astype(jnp.float32)[:, None] * inv_freq[None, :]
    cos = jnp.cos(ang)[None, :, None, :]
    sin = jnp.sin(ang)[None, :, None, :]
    x1, x2 = x[..., :half], x[..., half:]
    return jnp.concatenate([x1 * cos - x2 * sin, x1 * sin + x2 * cos], axis=-1)


def _head_norm(y, eps):
    mu = jnp.mean(y, axis=-1, keepdims=True)
    yc = y - mu
    var = jnp.mean(yc * yc, axis=-1, keepdims=True)
    out = yc * lax.rsqrt(var + eps)
    return out.reshape(y.shape[0], y.shape[1], -1)


def _retention_chunk(S, q, k, v, log_gamma):
    L = q.shape[1]
    idx = jnp.arange(L, dtype=jnp.float32)
    diff = idx[:, None] - idx[None, :]
    mask = jnp.where(diff >= 0, jnp.exp(log_gamma[:, None, None] * jnp.maximum(diff, 0.0)), 0.0)
    scores = jnp.einsum('bihd,bjhd->bhij', q, k) * mask[None]
    o = jnp.einsum('bhij,bjhv->bihv', scores, v)
    q_decay = jnp.exp(log_gamma[:, None] * (idx + 1.0)[None, :])
    o = o + jnp.einsum('bihd,bhdv,hi->bihv', q, S, q_decay)
    k_decay = jnp.exp(log_gamma[:, None] * (L - 1.0 - idx)[None, :])
    S_new = jnp.exp(log_gamma * L)[None, :, None, None] * S + jnp.einsum('bjhd,hj,bjhv->bhdv', k, k_decay, v)
    return o, S_new


def _retention_mix(q, k, v, S, log_gamma, lead):
    B, T = q.shape[0], q.shape[1]
    outs = []
    if lead > 0:
        o, S = _retention_chunk(S, q[:, :lead], k[:, :lead], v[:, :lead], log_gamma)
        outs.append(o)
    n_full, rem = divmod(T - lead, RET_CHUNK)
    if n_full > 0:
        def to_blocks(a):
            s = a[:, lead:lead + n_full * RET_CHUNK]
            return s.reshape((B, n_full, RET_CHUNK) + a.shape[2:]).swapaxes(0, 1)

        def step(S_c, blk):
            qc, kc, vc = blk
            o_c, S_c = _retention_chunk(S_c, qc, kc, vc, log_gamma)
            return S_c, o_c

        S, o_blocks = lax.scan(step, S, (to_blocks(q), to_blocks(k), to_blocks(v)))
        outs.append(o_blocks.swapaxes(0, 1).reshape((B, n_full * RET_CHUNK) + v.shape[2:]))
    if rem > 0:
        s0 = lead + n_full * RET_CHUNK
        o, S = _retention_chunk(S, q[:, s0:], k[:, s0:], v[:, s0:], log_gamma)
        outs.append(o)
    o_all = jnp.concatenate(outs, axis=1) if len(outs) > 1 else outs[0]
    return o_all, S


def _rwkv7_mix(p, prev, S, mu_shift, w0, w2, a0, a2, g2, k_k, k_a, r_k, lnx_g, lnx_b):
    B, T, _ = p.shape
    p_prev = jnp.concatenate([prev[:, None, :], p[:, :-1]], axis=1)
    pm = p + (p_prev - p) * mu_shift
    splits = [RWKV_W, 2 * RWKV_W, 3 * RWKV_W, 3 * RWKV_W + DECAY_LORA, 3 * RWKV_W + DECAY_LORA + AAA_LORA]
    r, k, v, xw, xa, xg = jnp.split(pm, splits, axis=-1)
    w = -jax.nn.softplus(-(w0 + jnp.tanh(xw) @ w2)) - 0.5
    decay = jnp.exp(-jnp.exp(w))
    a = jax.nn.sigmoid(a0 + xa @ a2)
    g = jax.nn.sigmoid(xg) @ g2

    def hs(t):
        return t.reshape(B, T, RWKV_HEADS, RWKV_HD)

    kk = hs(k * k_k)
    kk = kk * lax.rsqrt(jnp.maximum(jnp.sum(kk * kk, axis=-1, keepdims=True), 1e-24))
    k = k * (1.0 + (a - 1.0) * k_a)
    r_h, k_h, v_h, a_h = hs(r), hs(k), hs(v), hs(a)
    b_h = kk * a_h

    def step(S_t, inp):
        r_t, w_t, k_t, v_t, kk_t, b_t = inp
        sa = jnp.einsum('bhvk,bhk->bhv', S_t, -kk_t)
        S_t = S_t * w_t[:, :, None, :] + sa[..., :, None] * b_t[..., None, :] + v_t[..., :, None] * k_t[..., None, :]
        y_t = jnp.einsum('bhvk,bhk->bhv', S_t, r_t)
        return S_t, y_t

    seq = tuple(jnp.moveaxis(t, 1, 0) for t in (r_h, hs(decay), k_h, v_h, kk, b_h))
    S, y = lax.scan(step, S, seq)
    y = jnp.moveaxis(y, 0, 1)
    out = _head_norm(y, RWKV_GN_EPS) * lnx_g + lnx_b
    bonus = jnp.sum(r_h * k_h * r_k, axis=-1, keepdims=True) * v_h
    out = (out + bonus.reshape(B, T, RWKV_W)) * g
    return out, S, p[:, -1]


def _layer(x, pos, lead, S_ret, S_wkv, shift_prev,
           ffn1_norm, ffn1_w_gate, ffn1_w_up, ffn1_w_down, mix_norm, w_in, ret_gn_g,
           mu_shift, w0, w2, a0, a2, g2, k_k, k_a, r_k, lnx_g, lnx_b,
           w_out_ret, w_out_rwkv, w_out, ffn2_norm, ffn2_w_gate, ffn2_w_up, ffn2_w_down):
    B, T, _ = x.shape
    h = x + 0.5 * _swiglu(_rmsnorm(x, ffn1_norm), ffn1_w_gate, ffn1_w_up, ffn1_w_down)
    u = _rmsnorm(h, mix_norm)
    p = (u @ w_in).astype(jnp.float32)
    splits = [RET_QK, 2 * RET_QK, 2 * RET_QK + RET_V, 2 * RET_QK + 2 * RET_V, 2 * RET_QK + 2 * RET_V + SHIFT_W]
    q, k, v, g_ret, p_rwkv, gates = jnp.split(p, splits, axis=-1)
    log_gamma = jnp.log1p(-jnp.exp2(-5.0 - jnp.arange(RET_HEADS, dtype=jnp.float32)))
    q = _rotary(q.reshape(B, T, RET_HEADS, RET_DK), pos)
    k = _rotary(k.reshape(B, T, RET_HEADS, RET_DK), pos) * (RET_DK ** -0.5)
    v = v.reshape(B, T, RET_HEADS, RET_DV)
    o_ret, S_ret_new = _retention_mix(q, k, v, S_ret.astype(jnp.float32), log_gamma, lead)
    o_ret = _head_norm(o_ret, RET_GN_EPS) * ret_gn_g * jax.nn.silu(g_ret)
    o_rwkv, S_wkv_new, shift_new = _rwkv7_mix(p_rwkv, shift_prev.astype(jnp.float32), S_wkv.astype(jnp.float32),
                                             mu_shift, w0, w2, a0, a2, g2, k_k, k_a, r_k, lnx_g, lnx_b)
    gate_a, gate_b = jnp.split(jax.nn.sigmoid(gates), 2, axis=-1)
    merged = gate_a * (o_ret @ w_out_ret) + gate_b * (o_rwkv @ w_out_rwkv)
    h = h + (merged @ w_out).astype(h.dtype)
    h = h + 0.5 * _swiglu(_rmsnorm(h, ffn2_norm), ffn2_w_gate, ffn2_w_up, ffn2_w_down)
    return h, S_ret_new, S_wkv_new, shift_new


def setup_inputs(seed: int = 0) -> dict:
    key = jax.random.key(seed)
    ks = jax.random.split(key, 32)
    f32 = jnp.float32

    def nrm(k, shape, scale):
        return scale * jax.random.normal(k, shape, f32)

    def gain(k, n):
        return 1.0 + 0.05 * jax.random.normal(k, (n,), f32)

    return {
        'x_prompt': nrm(ks[0], (BATCH, SEQ, D_MODEL), 1.0),
        'x_sample': nrm(ks[1], (DEC_BATCH, DEC_SEQ, D_MODEL), 1.0),
        'state_ret': nrm(ks[2], (DEC_BATCH, RET_HEADS, RET_DK, RET_DV), 0.5),
        'state_wkv': nrm(ks[3], (DEC_BATCH, RWKV_HEADS, RWKV_HD, RWKV_HD), 0.3),
        'state_shift': nrm(ks[4], (DEC_BATCH, SHIFT_W), 1.0),
        'meta_tokens': nrm(ks[5], (N_META, D_MODEL), 1.0),
        'ffn1_norm': gain(ks[6], D_MODEL),
        'ffn1_w_gate': nrm(ks[7], (D_MODEL, D_FF), D_MODEL ** -0.5),
        'ffn1_w_up': nrm(ks[8], (D_MODEL, D_FF), D_MODEL ** -0.5),
        'ffn1_w_down': nrm(ks[9], (D_FF, D_MODEL), D_FF ** -0.5),
        'mix_norm': gain(ks[10], D_MODEL),
        'w_in': nrm(ks[11], (D_MODEL, PROJ_W), D_MODEL ** -0.5),
        'ret_gn_g': gain(ks[12], RET_V),
        'mu_shift': jax.random.uniform(ks[13], (SHIFT_W,), f32, 0.0, 1.0),
        'w0': jax.random.uniform(ks[14], (RWKV_W,), f32, -6.5, -1.5),
        'w2': nrm(ks[15], (DECAY_LORA, RWKV_W), 0.1 * DECAY_LORA ** -0.5),
        'a0': nrm(ks[16], (RWKV_W,), 0.1),
        'a2': nrm(ks[17], (AAA_LORA, RWKV_W), 0.1 * AAA_LORA ** -0.5),
        'g2': nrm(ks[18], (GATE_LORA, RWKV_W), GATE_LORA ** -0.5),
        'k_k': 0.85 + 0.05 * jax.random.normal(ks[19], (RWKV_W,), f32),
        'k_a': gain(ks[20], RWKV_W),
        'r_k': nrm(ks[21], (RWKV_HEADS, RWKV_HD), 0.1),
        'lnx_g': gain(ks[22], RWKV_W),
        'lnx_b': nrm(ks[23], (RWKV_W,), 0.02),
        'w_out_ret': nrm(ks[24], (RET_V, D_MODEL), RET_V ** -0.5),
        'w_out_rwkv': nrm(ks[25], (RWKV_W, D_MODEL), RWKV_W ** -0.5),
        'w_out': nrm(ks[26], (D_MODEL, D_MODEL), D_MODEL ** -0.5),
        'ffn2_norm': gain(ks[27], D_MODEL),
        'ffn2_w_gate': nrm(ks[28], (D_MODEL, D_FF), D_MODEL ** -0.5),
        'ffn2_w_up': nrm(ks[29], (D_MODEL, D_FF), D_MODEL ** -0.5),
        'ffn2_w_down': nrm(ks[30], (D_FF, D_MODEL), D_FF ** -0.5),
        'final_norm': gain(ks[31], D_MODEL),
    }


def reference(x_prompt, x_sample, state_ret, state_wkv, state_shift, meta_tokens,
              ffn1_norm, ffn1_w_gate, ffn1_w_up, ffn1_w_down, mix_norm, w_in, ret_gn_g,
              mu_shift, w0, w2, a0, a2, g2, k_k, k_a, r_k, lnx_g, lnx_b,
              w_out_ret, w_out_rwkv, w_out, ffn2_norm, ffn2_w_gate, ffn2_w_up, ffn2_w_down, final_norm):
    weights = (ffn1_norm, ffn1_w_gate, ffn1_w_up, ffn1_w_down, mix_norm, w_in, ret_gn_g,
               mu_shift, w0, w2, a0, a2, g2, k_k, k_a, r_k, lnx_g, lnx_b,
               w_out_ret, w_out_rwkv, w_out, ffn2_norm, ffn2_w_gate, ffn2_w_up, ffn2_w_down)
    st_dtype = state_ret.dtype
    Bp = x_prompt.shape[0]
    meta = jnp.broadcast_to(meta_tokens.astype(x_prompt.dtype)[None], (Bp, N_META, D_MODEL))
    h_p = jnp.concatenate([meta, x_prompt], axis=1)
    pos_p = jnp.arange(h_p.shape[1], dtype=jnp.int32)
    S_ret_p = jnp.zeros((Bp, RET_HEADS, RET_DK, RET_DV), jnp.float32)
    S_wkv_p = jnp.zeros((Bp, RWKV_HEADS, RWKV_HD, RWKV_HD), jnp.float32)
    sh_p = jnp.zeros((Bp, SHIFT_W), jnp.float32)
    h_s = x_sample
    pos_s = PAST_LEN + jnp.arange(x_sample.shape[1], dtype=jnp.int32)
    S_ret_s, S_wkv_s, sh_s = state_ret, state_wkv, state_shift
    for _ in range(DEPTH):
        h_p, S_ret_p, S_wkv_p, sh_p = _layer(h_p, pos_p, N_META, S_ret_p, S_wkv_p, sh_p, *weights)
        h_s, S_ret_s, S_wkv_s, sh_s = _layer(h_s, pos_s, 0, S_ret_s, S_wkv_s, sh_s, *weights)
    y_prompt = _rmsnorm(h_p, final_norm)[:, N_META:].astype(x_prompt.dtype)
    y_sample = _rmsnorm(h_s, final_norm).astype(x_sample.dtype)
    return (y_prompt, y_sample,
            S_ret_p.astype(st_dtype), S_wkv_p.astype(st_dtype), sh_p.astype(st_dtype),
            S_ret_s.astype(st_dtype), S_wkv_s.astype(st_dtype), sh_s.astype(st_dtype))
```

```cpp
#include <hip/hip_runtime.h>
#include <hip/hip_cooperative_groups.h>
#include <cstdio>
#include <cmath>
namespace cg = cooperative_groups;

#ifndef PHMASK
#define PHMASK 0xffff
#endif
#define PEN(k) (((PHMASK) >> (k)) & 1)
#ifndef DUPMASK
#define DUPMASK 0
#endif
#ifndef DUP6
#define DUP6 0
#endif
#ifndef SINGLE_LAUNCH
#define SINGLE_LAUNCH 1
#endif

typedef unsigned short bf16_t;
typedef short bf16x8 __attribute__((ext_vector_type(8)));
typedef float f32x4 __attribute__((ext_vector_type(4)));
typedef unsigned u32x4 __attribute__((ext_vector_type(4)));
typedef float f32x2 __attribute__((ext_vector_type(2)));

constexpr int NT = 256;
constexpr int M_TOK = 17024, MP = 16512, TP = 2064;
constexpr int PAST = 16384;
constexpr int LDS_BYTES = 73728;
constexpr int NPHASE = 14;

constexpr size_t S1024 = (size_t)M_TOK * 1024 * 2;
constexpr size_t S512 = S1024 / 2;
constexpr size_t OFF_W1GU = 0;
constexpr size_t OFF_W1D = OFF_W1GU + 11534336;
constexpr size_t OFF_WIN = OFF_W1D + 5767168;
constexpr size_t OFF_WR = OFF_WIN + 11010048;
constexpr size_t OFF_WW = OFF_WR + 1048576;
constexpr size_t OFF_WO = OFF_WW + 1048576;
constexpr size_t OFF_H = OFF_WO + 2097152;
constexpr size_t OFF_T = OFF_H + S1024;
constexpr size_t OFF_A = OFF_T;
constexpr size_t OFF_HF = OFF_T + S1024;
constexpr size_t OFF_QK = OFF_HF;
constexpr size_t OFF_V = OFF_QK + S512;
constexpr size_t OFF_GR = OFF_V + S512;
constexpr size_t OFF_PR = OFF_GR + S512;
constexpr size_t OFF_GB = OFF_PR + (size_t)M_TOK * 1792 * 2;
constexpr size_t OFF_Y = OFF_GB + S1024;
constexpr size_t OFF_END = OFF_Y + S512;
constexpr size_t OFF_MG = OFF_QK;
constexpr size_t OFF_BAR = OFF_END;
constexpr size_t WS_NEED = OFF_BAR + 16384;
constexpr size_t OFF_H3 = OFF_HF + (size_t)M_TOK * 2816 * 2;
constexpr size_t OFF_LD = OFF_A, OFF_AA = OFF_A + S512;
static_assert(OFF_H3 + (size_t)M_TOK * 1024 * 4 == OFF_END, "map");
constexpr size_t OO_GA = 0, OO_GG = S1024, OO_RHO = S1024 + S512;
constexpr size_t O_YP = 0, O_YS = 16777216, O_RETP = 17301504, O_WKVP = 17563648, O_SHP = 17825792, O_RETS = 17840128, O_WKVS = 22034432, O_SHS = 26228736;

struct Params {
  const float *x_prompt, *x_sample, *state_ret, *state_wkv, *state_shift, *meta;
  const float *ffn1_norm, *ffn1_wg, *ffn1_wu, *ffn1_wd, *mix_norm, *w_in, *ret_gn_g, *mu, *w0, *w2, *a0, *a2, *g2, *k_k, *k_a, *r_k, *lnx_g, *lnx_b;
  const float *w_out_ret, *w_out_rwkv, *w_out, *ffn2_norm, *ffn2_wg, *ffn2_wu, *ffn2_wd, *final_norm;
  float* out;
  unsigned char* ws;
  float invf[32];
  float lg2g[4];
  int phase_lo, phase_hi;
};


#define XB_TMO      128
#define XB_XCNT(j)  (256  + 64 * (j))
#define XB_XSUB(j)  (1280 + 64 * (j))
#define XB_XGEN(j)  (2304 + 64 * (j))
#define XB_TOP      3328
#define XB_TOPGEN   3392
#define XCD_BAR_WORDS 3456
#define XB_SPIN_CAP (1u << 18)
#define LAS __attribute__((address_space(3)))
__device__ __forceinline__ unsigned xb_ld(unsigned* p)              { return __hip_atomic_load(p, __ATOMIC_RELAXED, __HIP_MEMORY_SCOPE_AGENT); }
__device__ __forceinline__ unsigned xb_add(unsigned* p, unsigned v) { return __hip_atomic_fetch_add(p, v, __ATOMIC_RELAXED, __HIP_MEMORY_SCOPE_AGENT); }
__device__ __forceinline__ unsigned xb_xcc_id() { return (unsigned)__builtin_amdgcn_s_getreg((3 << 11) | 20) & 0xFu; }
#define XB_SPIN(cond, bar) do { unsigned _sp = 0; while (cond) { __builtin_amdgcn_s_sleep(1); \
    if ((++_sp & 255u) == 0u) { if (xb_ld(&(bar)[XB_TMO])) break; if (_sp > XB_SPIN_CAP) { atomicAdd(&(bar)[XB_TMO], 1u); break; } } } } while (0)
struct XcdBarrier { unsigned* bar; unsigned x; volatile LAS unsigned* st; };
__device__ __forceinline__ XcdBarrier xcd_barrier_post(unsigned* bar, volatile LAS unsigned* st) {
    XcdBarrier b; b.bar = bar; b.x = xb_xcc_id(); b.st = st;
    if (threadIdx.x == 0) (void)xb_add(&bar[XB_XCNT(b.x)], 1u);
    return b;
}
__device__ __forceinline__ void xcd_barrier_complete(unsigned* bar, unsigned x, unsigned& nloc, unsigned& nx) {
    const unsigned G = gridDim.x * gridDim.y * gridDim.z;
    unsigned sum, cnt, mine, sp = 0u;
    for (;;) {
        sum = 0u; cnt = 0u; mine = 0u;
#pragma unroll
        for (unsigned j = 0; j < 16; ++j) { const unsigned c = xb_ld(&bar[XB_XCNT(j)]); sum += c; cnt += (c > 0u) ? 1u : 0u; mine = (j == x) ? c : mine; }
        if (sum == G) break;
        __builtin_amdgcn_s_sleep(1);
        if ((++sp & 255u) == 0u) { if (xb_ld(&bar[XB_TMO])) break; if (sp > XB_SPIN_CAP) { atomicAdd(&bar[XB_TMO], 1u); break; } }
    }
    nloc = mine > 0u ? mine : 1u; nx = cnt > 0u ? cnt : 1u;
}
__device__ __forceinline__ void xcd_barrier(const XcdBarrier& b) {
    asm volatile("s_waitcnt vmcnt(0)" ::: "memory");
    __syncthreads();
    if (threadIdx.x == 0) {
        unsigned* bar = b.bar;
        __builtin_amdgcn_s_waitcnt(0);
        unsigned nloc = b.st[0], nx = b.st[1];
        if (nloc == 0u) { xcd_barrier_complete(bar, b.x, nloc, nx); b.st[0] = nloc; b.st[1] = nx; }
        const unsigned old = xb_add(&bar[XB_XSUB(b.x)], 1u);
        const unsigned gen = old / nloc;
        if (old + 1u == (gen + 1u) * nloc) {
            __builtin_amdgcn_fence(__ATOMIC_RELEASE, "agent");
            asm volatile("s_waitcnt vmcnt(0)" ::: "memory");
            const unsigned og = xb_add(&bar[XB_TOP], 1u);
            const unsigned tg = og / nx;
            if (og + 1u == (tg + 1u) * nx) xb_add(&bar[XB_TOPGEN], 1u);
            else XB_SPIN(xb_ld(&bar[XB_TOPGEN]) == tg, bar);
            __builtin_amdgcn_fence(__ATOMIC_ACQUIRE, "agent");
            xb_add(&bar[XB_XGEN(b.x)], 1u);
            asm volatile("s_waitcnt vmcnt(0)" ::: "memory");
        } else {
            XB_SPIN(xb_ld(&bar[XB_XGEN(b.x)]) == gen, bar);
            __builtin_amdgcn_fence(__ATOMIC_ACQUIRE, "agent");
            asm volatile("s_waitcnt vmcnt(0)" ::: "memory");
        }
    }
    __syncthreads();
}

__device__ __forceinline__ float bf2f(unsigned h) { return __uint_as_float(h << 16); }
__device__ __forceinline__ unsigned f2bf(float f) { unsigned u = __float_as_uint(f); return (u + 0x7fffu + ((u >> 16) & 1u)) >> 16; }
__device__ __forceinline__ unsigned pk2(float a, float b) { return f2bf(a) | (f2bf(b) << 16); }
__device__ __forceinline__ uint2 pk4(float a, float b, float c, float d) { uint2 r; r.x = pk2(a, b); r.y = pk2(c, d); return r; }
__device__ __forceinline__ void unpk4(uint2 u, float (&o)[4]) { o[0] = __uint_as_float(u.x << 16); o[1] = __uint_as_float(u.x & 0xffff0000u); o[2] = __uint_as_float(u.y << 16); o[3] = __uint_as_float(u.y & 0xffff0000u); }
template <int CTRL> __device__ __forceinline__ float dppf(float x) { return __builtin_bit_cast(float, __builtin_amdgcn_update_dpp(0, __builtin_bit_cast(int, x), CTRL, 0xf, 0xf, true)); }
__device__ __forceinline__ float rowsum16(float x) { x += dppf<0xB1>(x); x += dppf<0x4E>(x); x += dppf<0x141>(x); x += dppf<0x140>(x); return x; }
__device__ __forceinline__ float wavesum(float x) {
#pragma unroll
  for (int o = 32; o >= 1; o >>= 1) x += __shfl_xor(x, o);
  return x;
}
__device__ __forceinline__ float sigmoidf(float x) { return 1.f / (1.f + __expf(-x)); }
__device__ __forceinline__ float siluf(float x) { return x / (1.f + __expf(-x)); }

__device__ __forceinline__ const float* x_row(const Params& p, int row) {
  if (row < MP) { const int b = row / TP, t = row - b * TP; return t < 16 ? p.meta + t * 1024 : p.x_prompt + (size_t)(b * 2048 + t - 16) * 1024; }
  return p.x_sample + (size_t)(row - MP) * 1024;
}

__device__ __forceinline__ void transpose_tiles(const float* __restrict__ src, int K, int N, bf16_t* __restrict__ dst, int rs, int ro, unsigned char* lds) {
  float* tile = (float*)lds;
  const int tid = threadIdx.x;
  const int tk = K / 64, tn = N / 64;
  for (int t = blockIdx.x; t < tk * tn; t += gridDim.x) {
    const int k0 = (t / tn) * 64, n0 = (t % tn) * 64;
    __syncthreads();
    { const int n = tid & 63, kq = tid >> 6;
#pragma unroll
      for (int i = 0; i < 16; ++i) { const int k = kq + 4 * i; tile[k * 65 + n] = src[(size_t)(k0 + k) * N + n0 + n]; } }
    __syncthreads();
    { const int kp = tid & 31, nq = tid >> 5;
#pragma unroll
      for (int i = 0; i < 8; ++i) { const int n = nq + 8 * i; const float v0 = tile[(2 * kp) * 65 + n], v1 = tile[(2 * kp + 1) * 65 + n];
        *(unsigned*)(dst + (size_t)((n0 + n) * rs + ro) * K + k0 + 2 * kp) = pk2(v0, v1); } }
  }
}

template <int SRC, int DST> __device__ __forceinline__ void rmsnorm_phase(const Params& p, const float* __restrict__ g, bf16_t* dstb) {
  const int lane = threadIdx.x & 63, wid = threadIdx.x >> 6;
  const bf16_t* H = (const bf16_t*)(p.ws + OFF_H);
  const float* H3 = (const float*)(p.ws + OFF_H3);
  for (int row = blockIdx.x * 4 + wid; row < M_TOK; row += gridDim.x * 4) {
    float v[16];
    const float* xr = SRC == 0 ? x_row(p, row) : nullptr;
#pragma unroll
    for (int i = 0; i < 4; ++i) {
      const int col = i * 256 + lane * 4;
      if (SRC == 0) { const float4 t = *(const float4*)(xr + col); v[4 * i] = t.x; v[4 * i + 1] = t.y; v[4 * i + 2] = t.z; v[4 * i + 3] = t.w; }
      else if (SRC == 1) { const uint2 u = *(const uint2*)(H + (size_t)row * 1024 + col); float o[4]; unpk4(u, o); v[4 * i] = o[0]; v[4 * i + 1] = o[1]; v[4 * i + 2] = o[2]; v[4 * i + 3] = o[3]; }
      else { const float4 t = *(const float4*)(H3 + (size_t)row * 1024 + col); v[4 * i] = t.x; v[4 * i + 1] = t.y; v[4 * i + 2] = t.z; v[4 * i + 3] = t.w; }
    }
    float ss = 0.f;
#pragma unroll
    for (int i = 0; i < 16; ++i) ss += v[i] * v[i];
    ss = wavesum(ss);
    const float rstd = rsqrtf(ss * (1.f / 1024.f) + 1e-6f);
    float* orow = nullptr;
    if (DST == 1) {
      if (row < MP) { const int b = row / TP, t = row - b * TP; if (t >= 16) orow = p.out + O_YP + (size_t)(b * 2048 + t - 16) * 1024; }
      else orow = p.out + O_YS + (size_t)(row - MP) * 1024;
    }
#pragma unroll
    for (int i = 0; i < 4; ++i) {
      const int col = i * 256 + lane * 4;
      const float4 gv = *(const float4*)(g + col);
      const float y0 = v[4 * i] * rstd * gv.x, y1 = v[4 * i + 1] * rstd * gv.y, y2 = v[4 * i + 2] * rstd * gv.z, y3 = v[4 * i + 3] * rstd * gv.w;
      if (DST == 0) *(uint2*)(dstb + (size_t)row * 1024 + col) = pk4(y0, y1, y2, y3);
      else if (orow) *(float4*)(orow + col) = make_float4(y0, y1, y2, y3);
    }
  }
}

__device__ __forceinline__ void gemm_tile_acc(const bf16_t* __restrict__ A, int lda, const bf16_t* __restrict__ Bt, int ldb, int K, int m0, int n0, f32x4 (&acc)[4][4], unsigned char* lds) {
  const int tid = threadIdx.x, lane = tid & 63, wid = tid >> 6, wm = wid >> 1, wn = wid & 1;
  const int lr = tid >> 3, lc = tid & 7;
  const bf16_t* ag = A + (size_t)(m0 + lr) * lda + lc * 8;
  const bf16_t* bg = Bt + (size_t)(n0 + lr) * ldb + lc * 8;
  u32x4 ra[4], rb[4];
  const int nk = K >> 6;
#pragma unroll
  for (int i = 0; i < 4; ++i) { ra[i] = *(const u32x4*)(ag + (size_t)i * 32 * lda); rb[i] = *(const u32x4*)(bg + (size_t)i * 32 * ldb); }
  __syncthreads();
  const int wofs = lr * 144 + lc * 16;
#pragma unroll
  for (int i = 0; i < 4; ++i) { *(u32x4*)(lds + wofs + i * 4608) = ra[i]; *(u32x4*)(lds + 18432 + wofs + i * 4608) = rb[i]; }
  __syncthreads();
  const int aofs = (wm * 64 + (lane & 15)) * 144 + (lane >> 4) * 16;
  const int bofs = 18432 + (wn * 64 + (lane & 15)) * 144 + (lane >> 4) * 16;
  for (int kt = 0; kt < nk; ++kt) {
    const unsigned char* st = lds + (kt & 1) * 36864;
    if (kt + 1 < nk) {
      const int k0 = (kt + 1) * 64;
#pragma unroll
      for (int i = 0; i < 4; ++i) { ra[i] = *(const u32x4*)(ag + (size_t)i * 32 * lda + k0); rb[i] = *(const u32x4*)(bg + (size_t)i * 32 * ldb + k0); }
    }
#pragma unroll
    for (int kk = 0; kk < 2; ++kk) {
      bf16x8 af[4], bfr[4];
#pragma unroll
      for (int i = 0; i < 4; ++i) { af[i] = *(const bf16x8*)(st + aofs + i * 2304 + kk * 64); bfr[i] = *(const bf16x8*)(st + bofs + i * 2304 + kk * 64); }
#pragma unroll
      for (int mi = 0; mi < 4; ++mi)
#pragma unroll
        for (int ni = 0; ni < 4; ++ni) acc[mi][ni] = __builtin_amdgcn_mfma_f32_16x16x32_bf16(bfr[ni], af[mi], acc[mi][ni], 0, 0, 0);
    }
    if (kt + 1 < nk) {
      unsigned char* sw = lds + ((kt + 1) & 1) * 36864;
#pragma unroll
      for (int i = 0; i < 4; ++i) { *(u32x4*)(sw + wofs + i * 4608) = ra[i]; *(u32x4*)(sw + 18432 + wofs + i * 4608) = rb[i]; }
    }
    __syncthreads();
  }
}

__device__ __forceinline__ void tile_coords(int L, int nM, int nN, int& tm, int& tn) {
  const int nwg = nM * nN, q = nwg / 8, r = nwg % 8, xcd = L % 8, off = L / 8;
  const int wg = (xcd < r ? xcd * (q + 1) : r * (q + 1) + (xcd - r) * q) + off;
  const int nig = 8 * nN, gid = wg / nig, fm = gid * 8, gsz = min(nM - fm, 8);
  tm = fm + (wg % nig) % gsz; tn = (wg % nig) / gsz;
}

#define ZERO_ACC(a) _Pragma("unroll") for (int _i = 0; _i < 4; ++_i) _Pragma("unroll") for (int _j = 0; _j < 4; ++_j) a[_i][_j] = (f32x4){0.f, 0.f, 0.f, 0.f}
#define EPI_VARS const int lane = threadIdx.x & 63, wid = threadIdx.x >> 6, wm = wid >> 1, wn = wid & 1; const int rbase = tm * 128 + wm * 64 + (lane & 15), cbase = tn * 128 + wn * 64 + (lane >> 4) * 4

__device__ __forceinline__ void transpose_jobs(const Params& p, int jlo, int jhi, unsigned char* lds) {
  unsigned char* ws = p.ws;
#pragma unroll 1
  for (int j = jlo; j < jhi; ++j) {
    const float* src; int K, N, rs = 1, ro = 0; size_t off;
    switch (j) {
      case 0: src = p.ffn1_wg; K = 1024; N = 2816; off = OFF_W1GU; rs = 2; break;
      case 1: src = p.ffn1_wu; K = 1024; N = 2816; off = OFF_W1GU; rs = 2; ro = 1; break;
      case 2: src = p.ffn1_wd; K = 2816; N = 1024; off = OFF_W1D; break;
      case 3: src = p.w_in; K = 1024; N = 5376; off = OFF_WIN; break;
      case 4: src = p.w_out_ret; K = 512; N = 1024; off = OFF_WR; break;
      case 5: src = p.w_out_rwkv; K = 512; N = 1024; off = OFF_WW; break;
      case 6: src = p.w_out; K = 1024; N = 1024; off = OFF_WO; break;
      case 7: src = p.ffn2_wg; K = 1024; N = 2816; off = OFF_W1GU; rs = 2; break;
      case 8: src = p.ffn2_wu; K = 1024; N = 2816; off = OFF_W1GU; rs = 2; ro = 1; break;
      default: src = p.ffn2_wd; K = 2816; N = 1024; off = OFF_W1D; break;
    }
    transpose_tiles(src, K, N, (bf16_t*)(ws + off), rs, ro, lds);
  }
}
__device__ __forceinline__ void phase0(const Params& p, unsigned char* lds) {
  transpose_jobs(p, 0, 7, lds);
  rmsnorm_phase<0, 0>(p, p.ffn1_norm, (bf16_t*)(p.ws + OFF_A));
}

__device__ __forceinline__ void phase_ffn_up(const Params& p, unsigned char* lds) {
  const bf16_t* A = (const bf16_t*)(p.ws + OFF_A); const bf16_t* W = (const bf16_t*)(p.ws + OFF_W1GU); bf16_t* HF = (bf16_t*)(p.ws + OFF_HF);
  const int nM = M_TOK / 128, nN = 5632 / 128;
  for (int L = blockIdx.x; L < nM * nN; L += gridDim.x) {
    int tm, tn; tile_coords(L, nM, nN, tm, tn);
    f32x4 acc[4][4]; ZERO_ACC(acc);
    gemm_tile_acc(A, 1024, W, 1024, 1024, tm * 128, tn * 128, acc, lds);
    EPI_VARS;
#pragma unroll
    for (int mi = 0; mi < 4; ++mi)
#pragma unroll
      for (int ni = 0; ni < 4; ++ni) {
        const int row = rbase + mi * 16, c = (cbase + ni * 16) >> 1; const f32x4 a = acc[mi][ni];
        *(unsigned*)(HF + (size_t)row * 2816 + c) = pk2(siluf(a[0]) * a[1], siluf(a[2]) * a[3]);
      }
  }
}

template <bool FIRST> __device__ __forceinline__ void phase_ffn_down(const Params& p, unsigned char* lds) {
  const bf16_t* A = (const bf16_t*)(p.ws + OFF_HF); const bf16_t* W = (const bf16_t*)(p.ws + OFF_W1D);
  bf16_t* H = (bf16_t*)(p.ws + OFF_H); float* H3 = (float*)(p.ws + OFF_H3);
  const int nM = M_TOK / 128, nN = 8;
  for (int L = blockIdx.x; L < nM * nN; L += gridDim.x) {
    int tm, tn; tile_coords(L, nM, nN, tm, tn);
    f32x4 acc[4][4]; ZERO_ACC(acc);
    gemm_tile_acc(A, 2816, W, 2816, 2816, tm * 128, tn * 128, acc, lds);
    EPI_VARS;
#pragma unroll
    for (int mi = 0; mi < 4; ++mi) {
      const int row = rbase + mi * 16;
      const float* xr = FIRST ? x_row(p, row) : nullptr;
#pragma unroll
      for (int ni = 0; ni < 4; ++ni) {
        const int col = cbase + ni * 16; const f32x4 a = acc[mi][ni];
        if (FIRST) { const float4 xv = *(const float4*)(xr + col);
          *(uint2*)(H + (size_t)row * 1024 + col) = pk4(xv.x + 0.5f * a[0], xv.y + 0.5f * a[1], xv.z + 0.5f * a[2], xv.w + 0.5f * a[3]); }
        else { float h[4]; unpk4(*(const uint2*)(H + (size_t)row * 1024 + col), h);
          *(float4*)(H3 + (size_t)row * 1024 + col) = make_float4(h[0] + 0.5f * a[0], h[1] + 0.5f * a[1], h[2] + 0.5f * a[2], h[3] + 0.5f * a[3]); }
      }
    }
  }
}

__device__ __forceinline__ void rope_cs(float ang, float& c, float& s) {
  double rev = (double)ang * 0.15915494309189535; rev -= rint(rev); const float fr = (float)rev;
  s = __builtin_amdgcn_sinf(fr); c = __builtin_amdgcn_cosf(fr);
}
__device__ __forceinline__ void phase_win(const Params& p, unsigned char* lds) {
  const bf16_t* A = (const bf16_t*)(p.ws + OFF_A); const bf16_t* W = (const bf16_t*)(p.ws + OFF_WIN);
  bf16_t* QK = (bf16_t*)(p.ws + OFF_QK); bf16_t* V = (bf16_t*)(p.ws + OFF_V); bf16_t* GR = (bf16_t*)(p.ws + OFF_GR); bf16_t* PR = (bf16_t*)(p.ws + OFF_PR);
  bf16_t* GB = (bf16_t*)(p.ws + OFF_GB); bf16_t* GA = (bf16_t*)((unsigned char*)p.out + OO_GA);
  const int nM = M_TOK / 128, nN = 5376 / 128;
  for (int L = blockIdx.x; L < nM * nN; L += gridDim.x) {
    int tm, tn; tile_coords(L, nM, nN, tm, tn);
    f32x4 acc[4][4]; ZERO_ACC(acc);
    gemm_tile_acc(A, 1024, W, 1024, 1024, tm * 128, tn * 128, acc, lds);
    EPI_VARS;
    const int n0 = tn * 128;
    if (n0 < 512) {
      const float sc = n0 >= 256 ? 0.125f : 1.0f;
      const int hb = n0 + wn * 64;
#pragma unroll
      for (int mi = 0; mi < 4; ++mi) {
        const int row = rbase + mi * 16;
        const float pos = row < MP ? (float)(row % TP) : (float)(PAST + ((row - MP) & 3));
#pragma unroll
        for (int ni = 0; ni < 2; ++ni) {
          float o1[4], o2[4];
#pragma unroll
          for (int jj = 0; jj < 4; ++jj) {
            const int j = ni * 16 + (lane >> 4) * 4 + jj;
            float c, s; rope_cs(pos * p.invf[j], c, s);
            const float x1 = acc[mi][ni][jj], x2 = acc[mi][ni + 2][jj];
            o1[jj] = (x1 * c - x2 * s) * sc; o2[jj] = (x1 * s + x2 * c) * sc;
          }
          const int j0 = ni * 16 + (lane >> 4) * 4;
          *(uint2*)(QK + (size_t)row * 512 + hb + j0) = pk4(o1[0], o1[1], o1[2], o1[3]);
          *(uint2*)(QK + (size_t)row * 512 + hb + 32 + j0) = pk4(o2[0], o2[1], o2[2], o2[3]);
        }
      }
    } else {
#pragma unroll
      for (int mi = 0; mi < 4; ++mi) {
        const int row = rbase + mi * 16;
        float* sh = nullptr;
        if (row < MP) { const int b = row / TP; if (row - b * TP == TP - 1) sh = p.out + O_SHP + (size_t)b * 1792; }
        else { const int r2 = row - MP; if ((r2 & 3) == 3) sh = p.out + O_SHS + (size_t)(r2 >> 2) * 1792; }
#pragma unroll
        for (int ni = 0; ni < 4; ++ni) {
          const int col = cbase + ni * 16; const f32x4 a = acc[mi][ni];
          if (n0 < 1024) *(uint2*)(V + (size_t)row * 512 + (col - 512)) = pk4(a[0], a[1], a[2], a[3]);
          else if (n0 < 1536) *(uint2*)(GR + (size_t)row * 512 + (col - 1024)) = pk4(siluf(a[0]), siluf(a[1]), siluf(a[2]), siluf(a[3]));
          else if (n0 < 3328) { *(uint2*)(PR + (size_t)row * 1792 + (col - 1536)) = pk4(a[0], a[1], a[2], a[3]);
            if (sh) *(float4*)(sh + (col - 1536)) = make_float4(a[0], a[1], a[2], a[3]); }
          else if (n0 < 4352) *(uint2*)(GA + (size_t)row * 1024 + (col - 3328)) = pk4(sigmoidf(a[0]), sigmoidf(a[1]), sigmoidf(a[2]), sigmoidf(a[3]));
          else *(uint2*)(GB + (size_t)row * 1024 + (col - 4352)) = pk4(sigmoidf(a[0]), sigmoidf(a[1]), sigmoidf(a[2]), sigmoidf(a[3]));
        }
      }
    }
  }
}

__device__ __forceinline__ void phase_lora(const Params& p, unsigned char* lds) {
  float* sS = (float*)lds;
  const int tid = threadIdx.x;
  const bf16_t* PR = (const bf16_t*)(p.ws + OFF_PR);
  bf16_t* LD = (bf16_t*)(p.ws + OFF_LD); bf16_t* AA = (bf16_t*)(p.ws + OFF_AA); bf16_t* GG = (bf16_t*)((unsigned char*)p.out + OO_GG);
  const float mu_j = p.mu[1536 + tid];
  for (int tile = blockIdx.x; tile < M_TOK / 16; tile += gridDim.x) {
    const int row0 = tile * 16;
    __syncthreads();
#pragma unroll 4
    for (int tt = 0; tt < 16; ++tt) {
      const int row = row0 + tt;
      const float pc = bf2f(PR[(size_t)row * 1792 + 1536 + tid]);
      float pp;
      if (row < MP) { const int t = row % TP; pp = t == 0 ? 0.f : bf2f(PR[(size_t)(row - 1) * 1792 + 1536 + tid]); }
      else { const int r2 = row - MP; pp = (r2 & 3) == 0 ? p.state_shift[(size_t)(r2 >> 2) * 1792 + 1536 + tid] : bf2f(PR[(size_t)(row - 1) * 1792 + 1536 + tid]); }
      const float pm = pc + (pp - pc) * mu_j;
      sS[tt * 256 + tid] = tid < 64 ? tanhf(pm) : (tid < 128 ? pm : sigmoidf(pm));
    }
    __syncthreads();
#pragma unroll 1
    for (int which = 0; which < 3; ++which) {
      const float* Wm = which == 0 ? p.w2 : (which == 1 ? p.a2 : p.g2);
      const int jb = which == 0 ? 0 : (which == 1 ? 64 : 128), nj = which == 2 ? 128 : 64;
      float acc0[16], acc1[16];
#pragma unroll
      for (int tt = 0; tt < 16; ++tt) { acc0[tt] = 0.f; acc1[tt] = 0.f; }
      for (int j = 0; j < nj; j += 4) {
        float wa[4], wb[4];
#pragma unroll
        for (int e = 0; e < 4; ++e) { wa[e] = Wm[(size_t)(j + e) * 512 + tid]; wb[e] = Wm[(size_t)(j + e) * 512 + tid + 256]; }
#pragma unroll
        for (int tt = 0; tt < 16; ++tt) {
          const float4 s4 = *(const float4*)(sS + tt * 256 + jb + j);
          acc0[tt] += s4.x * wa[0] + s4.y * wa[1] + s4.z * wa[2] + s4.w * wa[3];
          acc1[tt] += s4.x * wb[0] + s4.y * wb[1] + s4.z * wb[2] + s4.w * wb[3];
        }
      }
      if (which == 0) {
        const float b0 = p.w0[tid], b1 = p.w0[tid + 256];
#pragma unroll
        for (int tt = 0; tt < 16; ++tt) {
          const float x0 = -(b0 + acc0[tt]), x1 = -(b1 + acc1[tt]);
          const float sp0 = fmaxf(x0, 0.f) + log1pf(expf(-fabsf(x0))), sp1 = fmaxf(x1, 0.f) + log1pf(expf(-fabsf(x1)));
          LD[(size_t)(row0 + tt) * 512 + tid] = (bf16_t)f2bf(-expf(-sp0 - 0.5f));
          LD[(size_t)(row0 + tt) * 512 + tid + 256] = (bf16_t)f2bf(-expf(-sp1 - 0.5f));
        }
      } else if (which == 1) {
        const float b0 = p.a0[tid], b1 = p.a0[tid + 256];
#pragma unroll
        for (int tt = 0; tt < 16; ++tt) {
          AA[(size_t)(row0 + tt) * 512 + tid] = (bf16_t)f2bf(sigmoidf(b0 + acc0[tt]));
          AA[(size_t)(row0 + tt) * 512 + tid + 256] = (bf16_t)f2bf(sigmoidf(b1 + acc1[tt]));
        }
      } else {
#pragma unroll
        for (int tt = 0; tt < 16; ++tt) {
          GG[(size_t)(row0 + tt) * 512 + tid] = (bf16_t)f2bf(acc0[tt]);
          GG[(size_t)(row0 + tt) * 512 + tid + 256] = (bf16_t)f2bf(acc1[tt]);
        }
      }
    }
  }
}

struct StageRegs { uint2 cr, ck, cv, qr, qk, qv, ld, aa; };

__device__ __forceinline__ void rwkv_item(const Params& p, int rowbase, int T, int h, int rb, const float* shift_prev, const float* S_in, float* S_out, unsigned char* lds) {
  float* stage = (float*)lds;
  float* ybuf = (float*)(lds + 49152);
  const int tid = threadIdx.x, lane = tid & 63, wid = tid >> 6;
  const int t_l = tid >> 4, c4 = tid & 15, ch = h * 64 + c4 * 4;
  const int kg = lane & 15, vloc = wid * 4 + (lane >> 4), vrow = rb * 16 + vloc;
  const bf16_t* PR = (const bf16_t*)(p.ws + OFF_PR); const bf16_t* LD = (const bf16_t*)(p.ws + OFF_LD); const bf16_t* AA = (const bf16_t*)(p.ws + OFF_AA);
  bf16_t* Y = (bf16_t*)(p.ws + OFF_Y); float* RHO = (float*)((unsigned char*)p.out + OO_RHO);
  float mur[4], muk[4], muv[4], kkc[4], kac[4], rkc[4];
#pragma unroll
  for (int e = 0; e < 4; ++e) { mur[e] = p.mu[ch + e]; muk[e] = p.mu[512 + ch + e]; muv[e] = p.mu[1024 + ch + e]; kkc[e] = p.k_k[ch + e]; kac[e] = p.k_a[ch + e]; rkc[e] = p.r_k[ch + e]; }
  f32x4 S;
  if (S_in) S = *(const f32x4*)(S_in + (size_t)vrow * 64 + kg * 4); else S = (f32x4){0.f, 0.f, 0.f, 0.f};
  f32x2 Sa = S.xy, Sb = S.zw;

  auto load = [&](int t0, StageRegs& r) {
    int t = t0 + t_l; if (t > T - 1) t = T - 1;
    const bf16_t* cur = PR + (size_t)(rowbase + t) * 1792 + ch;
    r.cr = *(const uint2*)cur; r.ck = *(const uint2*)(cur + 512); r.cv = *(const uint2*)(cur + 1024);
    if (t > 0) { const bf16_t* pv = cur - 1792; r.qr = *(const uint2*)pv; r.qk = *(const uint2*)(pv + 512); r.qv = *(const uint2*)(pv + 1024); }
    else { r.qr = make_uint2(0, 0); r.qk = r.qr; r.qv = r.qr; }
    r.ld = *(const uint2*)(LD + (size_t)(rowbase + t) * 512 + ch); r.aa = *(const uint2*)(AA + (size_t)(rowbase + t) * 512 + ch);
  };
  auto process = [&](int t0, const StageRegs& r, int buf) {
    float cr[4], ck[4], cv[4], qr[4], qk[4], qv[4], ld[4], aa[4];
    unpk4(r.cr, cr); unpk4(r.ck, ck); unpk4(r.cv, cv); unpk4(r.qr, qr); unpk4(r.qk, qk); unpk4(r.qv, qv); unpk4(r.ld, ld); unpk4(r.aa, aa);
    const int t = t0 + t_l;
    if (t == 0 && shift_prev) {
#pragma unroll
      for (int e = 0; e < 4; ++e) { qr[e] = shift_prev[ch + e]; qk[e] = shift_prev[512 + ch + e]; qv[e] = shift_prev[1024 + ch + e]; }
    }
    float rr[4], k[4], v[4], kk[4], kp[4], bb[4], w[4];
    float ss = 0.f, rho = 0.f;
#pragma unroll
    for (int e = 0; e < 4; ++e) {
      rr[e] = cr[e] + (qr[e] - cr[e]) * mur[e]; k[e] = ck[e] + (qk[e] - ck[e]) * muk[e]; v[e] = cv[e] + (qv[e] - cv[e]) * muv[e];
      kk[e] = k[e] * kkc[e]; ss += kk[e] * kk[e];
      kp[e] = k[e] * (1.f + (aa[e] - 1.f) * kac[e]);
      rho += rr[e] * kp[e] * rkc[e];
      w[e] = expf(ld[e]);
    }
    ss = rowsum16(ss); rho = rowsum16(rho);
    const float inv = rsqrtf(fmaxf(ss, 1e-24f));
#pragma unroll
    for (int e = 0; e < 4; ++e) { kk[e] *= inv; bb[e] = kk[e] * aa[e]; }
    float* sp = stage + (size_t)((buf * 16 + t_l) * 6) * 64 + c4 * 4;
    *(float4*)(sp) = make_float4(rr[0], rr[1], rr[2], rr[3]);
    *(float4*)(sp + 64) = make_float4(w[0], w[1], w[2], w[3]);
    *(float4*)(sp + 128) = make_float4(kp[0], kp[1], kp[2], kp[3]);
    *(float4*)(sp + 192) = make_float4(v[0], v[1], v[2], v[3]);
    *(float4*)(sp + 256) = make_float4(-kk[0], -kk[1], -kk[2], -kk[3]);
    *(float4*)(sp + 320) = make_float4(bb[0], bb[1], bb[2], bb[3]);
    if (rb == 0 && c4 == 0 && t < T) RHO[(size_t)(rowbase + t) * 8 + h] = rho;
  };

  const int nch = (T + 15) >> 4;
  StageRegs rg;
  __syncthreads();
  load(0, rg); process(0, rg, 0);
  __syncthreads();
  for (int c = 0; c < nch; ++c) {
    const int buf = c & 1, t0 = c * 16;
    const int nsteps = min(16, T - t0);
    if (c + 1 < nch) load(t0 + 16, rg);
    const float* st = stage + (size_t)(buf * 16) * 384;
    float* yb = ybuf + buf * 256;
    for (int s0 = 0; s0 < nsteps; s0 += 4) {
#pragma unroll
      for (int u = 0; u < 4; ++u) {
        const int s = s0 + u;
        const float* sp = st + s * 384;
        const f32x4 r4 = *(const f32x4*)(sp + kg * 4), w4 = *(const f32x4*)(sp + 64 + kg * 4), kp4 = *(const f32x4*)(sp + 128 + kg * 4);
        const f32x4 nk4 = *(const f32x4*)(sp + 256 + kg * 4), b4 = *(const f32x4*)(sp + 320 + kg * 4);
        const float vv = sp[192 + vrow];
        f32x2 pa = Sa * nk4.xy; pa = Sb * nk4.zw + pa;
        float sa = rowsum16(pa.x + pa.y);
        const f32x2 sa2 = {sa, sa}, vv2 = {vv, vv};
        const f32x2 Xa = sa2 * b4.xy + vv2 * kp4.xy, Xb = sa2 * b4.zw + vv2 * kp4.zw;
        Sa = Sa * w4.xy + Xa; Sb = Sb * w4.zw + Xb;
        f32x2 ya = Sa * r4.xy; ya = Sb * r4.zw + ya;
        const float y = rowsum16(ya.x + ya.y);
        if (kg == 0) yb[s * 16 + vloc] = y;
      }
    }
    if (c + 1 < nch) process(t0 + 16, rg, buf ^ 1);
    __syncthreads();
    if (t0 + t_l < T) Y[(size_t)(rowbase + t0 + t_l) * 512 + h * 64 + rb * 16 + c4] = (bf16_t)f2bf(yb[t_l * 16 + c4]);
  }
  S.xy = Sa; S.zw = Sb;
  *(f32x4*)(S_out + (size_t)vrow * 64 + kg * 4) = S;
}

__device__ __forceinline__ void ret_item(const Params& p, int rowbase, int T, int h, const float* S_in, float* S_out, unsigned char* lds) {
  unsigned char* sQ = lds; unsigned char* sK = lds + 9216; unsigned char* sKdT = lds + 18432; unsigned char* sVT = lds + 27648; unsigned char* sP = lds + 46080; unsigned char* sST = lds + 55296;
  float* part = (float*)sK;
  const int tid = threadIdx.x, lane = tid & 63, w = tid >> 6, l15 = lane & 15, l4 = lane >> 4;
  const bf16_t* QK = (const bf16_t*)(p.ws + OFF_QK); const bf16_t* V = (const bf16_t*)(p.ws + OFF_V); bf16_t* GR = (bf16_t*)(p.ws + OFF_GR);
  const float lg2 = p.lg2g[h];
  f32x4 ST[2][4];
#pragma unroll
  for (int vt = 0; vt < 2; ++vt)
#pragma unroll
    for (int dt = 0; dt < 4; ++dt) {
      if (S_in) {
#pragma unroll
        for (int jj = 0; jj < 4; ++jj) ST[vt][dt][jj] = 0.f;
        const float4 t4 = *(const float4*)(S_in + (size_t)(dt * 16 + l15) * 128 + 32 * w + vt * 16 + l4 * 4);
        ST[vt][dt][0] = t4.x; ST[vt][dt][1] = t4.y; ST[vt][dt][2] = t4.z; ST[vt][dt][3] = t4.w;
      } else ST[vt][dt] = (f32x4){0.f, 0.f, 0.f, 0.f};
    }
  __syncthreads();
#pragma unroll
  for (int vt = 0; vt < 2; ++vt)
#pragma unroll
    for (int dt = 0; dt < 4; ++dt)
#pragma unroll
      for (int jj = 0; jj < 4; ++jj) *(bf16_t*)(sST + (32 * w + vt * 16 + l4 * 4 + jj) * 144 + (dt * 16 + l15) * 2) = (bf16_t)f2bf(ST[vt][dt][jj]);

  const int nch = (T + 63) >> 6;
  u32x4 pq[2], pk[2], pv[4];
  auto prefetch = [&](int t0n, int tidp) {
    const int Ln = min(64, T - t0n);
#pragma unroll
    for (int i = 0; i < 2; ++i) {
      const int q_ = tidp + i * 256, j = q_ & 63, ck = q_ >> 6;
      pq[i] = (u32x4){0u, 0u, 0u, 0u}; pk[i] = pq[i];
      if (j < Ln) { const bf16_t* src = QK + (size_t)(rowbase + t0n + j) * 512 + h * 64 + ck * 8; pq[i] = *(const u32x4*)src; pk[i] = *(const u32x4*)(src + 256); }
    }
#pragma unroll
    for (int i = 0; i < 4; ++i) {
      const int q_ = tidp + i * 256, j = q_ & 63, cv = q_ >> 6;
      pv[i] = (u32x4){0u, 0u, 0u, 0u};
      if (j < Ln) pv[i] = *(const u32x4*)(V + (size_t)(rowbase + t0n + j) * 512 + h * 128 + cv * 8);
    }
  };
  prefetch(0, threadIdx.x);
  for (int c = 0; c < nch; ++c) {
    const int t0 = c * 64, Lc = min(64, T - t0);
    int tid_o = threadIdx.x; asm volatile("" : "+v"(tid_o));
    const int tid = tid_o, lane = tid & 63, w = tid >> 6, l15 = lane & 15, l4 = lane >> 4;
    __syncthreads();
#pragma unroll
    for (int i = 0; i < 2; ++i) {
      const int q_ = tid + i * 256, j = q_ & 63, ck = q_ >> 6;
      const u32x4 kv = pk[i];
      *(u32x4*)(sQ + j * 144 + ck * 16) = pq[i]; *(u32x4*)(sK + j * 144 + ck * 16) = kv;
      const float kd = __builtin_amdgcn_exp2f((float)(Lc - 1 - j) * lg2);
#pragma unroll
      for (int e = 0; e < 4; ++e) {
        *(bf16_t*)(sKdT + (ck * 8 + 2 * e) * 144 + j * 2) = (bf16_t)f2bf(__uint_as_float(kv[e] << 16) * kd);
        *(bf16_t*)(sKdT + (ck * 8 + 2 * e + 1) * 144 + j * 2) = (bf16_t)f2bf(__uint_as_float(kv[e] & 0xffff0000u) * kd);
      }
    }
#pragma unroll
    for (int i = 0; i < 4; ++i) {
      const int q_ = tid + i * 256, j = q_ & 63, cv = q_ >> 6;
      const u32x4 vv = pv[i];
#pragma unroll
      for (int e = 0; e < 4; ++e) {
        *(bf16_t*)(sVT + (cv * 8 + 2 * e) * 144 + j * 2) = (bf16_t)(vv[e] & 0xffffu);
        *(bf16_t*)(sVT + (cv * 8 + 2 * e + 1) * 144 + j * 2) = (bf16_t)(vv[e] >> 16);
      }
    }
    if (c + 1 < nch) prefetch(t0 + 64, tid);
    __syncthreads();
    {
      f32x4 sc[4];
#pragma unroll
      for (int jt = 0; jt < 4; ++jt) sc[jt] = (f32x4){0.f, 0.f, 0.f, 0.f};
#pragma unroll
      for (int kk = 0; kk < 2; ++kk) {
        const bf16x8 aq = *(const bf16x8*)(sQ + (16 * w + l15) * 144 + kk * 64 + l4 * 16);
#pragma unroll
        for (int jt = 0; jt < 4; ++jt) { const bf16x8 bk = *(const bf16x8*)(sK + (jt * 16 + l15) * 144 + kk * 64 + l4 * 16); sc[jt] = __builtin_amdgcn_mfma_f32_16x16x32_bf16(aq, bk, sc[jt], 0, 0, 0); }
      }
#pragma unroll
      for (int jt = 0; jt < 4; ++jt)
#pragma unroll
        for (int jj = 0; jj < 4; ++jj) {
          const int i = 16 * w + l4 * 4 + jj, j = jt * 16 + l15;
          const float pv = i >= j ? sc[jt][jj] * __builtin_amdgcn_exp2f((float)(i - j) * lg2) : 0.f;
          *(bf16_t*)(sP + i * 144 + j * 2) = (bf16_t)f2bf(pv);
        }
    }
    __syncthreads();
    f32x4 o[4][2];
    {
      bf16x8 bV[2][2], bS[2][2];
#pragma unroll
      for (int vt = 0; vt < 2; ++vt)
#pragma unroll
        for (int kk = 0; kk < 2; ++kk) {
          bV[vt][kk] = *(const bf16x8*)(sVT + (32 * w + vt * 16 + l15) * 144 + kk * 64 + l4 * 16);
          bS[vt][kk] = *(const bf16x8*)(sST + (32 * w + vt * 16 + l15) * 144 + kk * 64 + l4 * 16);
        }
#pragma unroll
      for (int it = 0; it < 4; ++it) {
        bf16x8 aP[2], aQ[2];
#pragma unroll
        for (int kk = 0; kk < 2; ++kk) { aP[kk] = *(const bf16x8*)(sP + (it * 16 + l15) * 144 + kk * 64 + l4 * 16); aQ[kk] = *(const bf16x8*)(sQ + (it * 16 + l15) * 144 + kk * 64 + l4 * 16); }
#pragma unroll
        for (int vt = 0; vt < 2; ++vt) {
          f32x4 a1 = (f32x4){0.f, 0.f, 0.f, 0.f}, a2 = (f32x4){0.f, 0.f, 0.f, 0.f};
#pragma unroll
          for (int kk = 0; kk < 2; ++kk) { a1 = __builtin_amdgcn_mfma_f32_16x16x32_bf16(aP[kk], bV[vt][kk], a1, 0, 0, 0); a2 = __builtin_amdgcn_mfma_f32_16x16x32_bf16(aQ[kk], bS[vt][kk], a2, 0, 0, 0); }
#pragma unroll
          for (int jj = 0; jj < 4; ++jj) { const int i = it * 16 + l4 * 4 + jj; o[it][vt][jj] = a1[jj] + __builtin_amdgcn_exp2f((float)(i + 1) * lg2) * a2[jj]; }
        }
      }
      const float gl = __builtin_amdgcn_exp2f((float)Lc * lg2);
#pragma unroll
      for (int dt = 0; dt < 4; ++dt) {
        bf16x8 bK[2];
#pragma unroll
        for (int kk = 0; kk < 2; ++kk) bK[kk] = *(const bf16x8*)(sKdT + (dt * 16 + l15) * 144 + kk * 64 + l4 * 16);
#pragma unroll
        for (int vt = 0; vt < 2; ++vt) {
          f32x4 a = ST[vt][dt] * gl;
#pragma unroll
          for (int kk = 0; kk < 2; ++kk) a = __builtin_amdgcn_mfma_f32_16x16x32_bf16(bV[vt][kk], bK[kk], a, 0, 0, 0);
          ST[vt][dt] = a;
#pragma unroll
          for (int jj = 0; jj < 4; ++jj) *(bf16_t*)(sST + (32 * w + vt * 16 + l4 * 4 + jj) * 144 + (dt * 16 + l15) * 2) = (bf16_t)f2bf(a[jj]);
        }
      }
    }
    unsigned short grv[4][4][2];
#pragma unroll
    for (int it = 0; it < 4; ++it)
#pragma unroll
      for (int jj = 0; jj < 4; ++jj) {
        const int i = it * 16 + l4 * 4 + jj;
#pragma unroll
        for (int vt = 0; vt < 2; ++vt) grv[it][jj][vt] = i < Lc ? GR[(size_t)(rowbase + t0 + i) * 512 + h * 128 + 32 * w + vt * 16 + l15] : (unsigned short)0;
      }
#pragma unroll
    for (int it = 0; it < 4; ++it)
#pragma unroll
      for (int jj = 0; jj < 4; ++jj) {
        float s1 = o[it][0][jj] + o[it][1][jj], s2 = o[it][0][jj] * o[it][0][jj] + o[it][1][jj] * o[it][1][jj];
        s1 = rowsum16(s1); s2 = rowsum16(s2);
        if (l15 == 0) { const int i = it * 16 + l4 * 4 + jj; part[(w * 64 + i) * 2] = s1; part[(w * 64 + i) * 2 + 1] = s2; }
      }
    const float gn[2] = {p.ret_gn_g[h * 128 + 32 * w + l15], p.ret_gn_g[h * 128 + 32 * w + 16 + l15]};
    __syncthreads();
#pragma unroll
    for (int it = 0; it < 4; ++it)
#pragma unroll
      for (int jj = 0; jj < 4; ++jj) {
        const int i = it * 16 + l4 * 4 + jj;
        float s1 = 0.f, s2 = 0.f;
#pragma unroll
        for (int ww = 0; ww < 4; ++ww) { s1 += part[(ww * 64 + i) * 2]; s2 += part[(ww * 64 + i) * 2 + 1]; }
        const float mean = s1 * (1.f / 128.f), var = fmaxf(s2 * (1.f / 128.f) - mean * mean, 0.f), rstd = rsqrtf(var + 1e-6f);
        if (i < Lc) {
#pragma unroll
          for (int vt = 0; vt < 2; ++vt) {
            const int v = 32 * w + vt * 16 + l15;
            bf16_t* gp = GR + (size_t)(rowbase + t0 + i) * 512 + h * 128 + v;
            *gp = (bf16_t)f2bf((o[it][vt][jj] - mean) * rstd * gn[vt] * bf2f(grv[it][jj][vt]));
          }
        }
      }
  }
#pragma unroll
  for (int vt = 0; vt < 2; ++vt)
#pragma unroll
    for (int dt = 0; dt < 4; ++dt)
      *(float4*)(S_out + (size_t)(dt * 16 + l15) * 128 + 32 * w + vt * 16 + l4 * 4) = make_float4(ST[vt][dt][0], ST[vt][dt][1], ST[vt][dt][2], ST[vt][dt][3]);
}

__device__ __forceinline__ void phase_scan(const Params& p, unsigned char* lds) {
  const int G = gridDim.x;
  int lb, ln;
  if (G >= 352) { lb = (int)blockIdx.x - 288; ln = G - 288; } else { lb = blockIdx.x; ln = G; }
  int hid = blockIdx.x, lid = lb;
  bool heavy = true;
#pragma unroll 1
  while (true) {
    int item;
    if (heavy) { if (hid < 288) { item = hid; hid += G; } else { heavy = false; continue; } }
    else { if (lid >= 0 && lid < 4608) { item = 288 + lid; lid += ln; } else break; }
    bool is_rwkv; int rowbase, T, h, rb = 0; const float* shp = nullptr; const float* sin = nullptr; float* sout;
    if (item < 256) { const int seq = item >> 2, b = seq >> 3; rb = item & 3; h = seq & 7; is_rwkv = true; rowbase = b * TP; T = TP; sout = p.out + O_WKVP + (size_t)seq * 4096; }
    else if (item < 288) { const int bh = item - 256, b = bh >> 2; h = bh & 3; is_rwkv = false; rowbase = b * TP; T = TP; sout = p.out + O_RETP + (size_t)bh * 8192; }
    else if (item < 288 + 4096) { const int it = item - 288, seq = it >> 2, b = seq >> 3; rb = it & 3; h = seq & 7; is_rwkv = true; rowbase = MP + b * 4; T = 4;
      shp = p.state_shift + (size_t)b * 1792; sin = p.state_wkv + (size_t)seq * 4096; sout = p.out + O_WKVS + (size_t)seq * 4096; }
    else { const int bh = item - 288 - 4096, b = bh >> 2; h = bh & 3; is_rwkv = false; rowbase = MP + b * 4; T = 4; sin = p.state_ret + (size_t)bh * 8192; sout = p.out + O_RETS + (size_t)bh * 8192; }
    if (is_rwkv) { rwkv_item(p, rowbase, T, h, rb, shp, sin, sout, lds); if (DUP6) rwkv_item(p, rowbase, T, h, rb, shp, sin, sout, lds); }
    else ret_item(p, rowbase, T, h, sin, sout, lds);
  }
}

__device__ __forceinline__ void phase_post(const Params& p, unsigned char* lds) {
  transpose_jobs(p, 7, 10, lds);
  const int tid = threadIdx.x, h = (tid >> 4) & 7, c4 = tid & 15, ch = h * 64 + c4 * 4;
  bf16_t* Y = (bf16_t*)(p.ws + OFF_Y); const bf16_t* PR = (const bf16_t*)(p.ws + OFF_PR);
  const bf16_t* GG = (const bf16_t*)((unsigned char*)p.out + OO_GG); const float* RHO = (const float*)((unsigned char*)p.out + OO_RHO);
  float muv[4], lg[4], lb[4];
#pragma unroll
  for (int e = 0; e < 4; ++e) { muv[e] = p.mu[1024 + ch + e]; lg[e] = p.lnx_g[ch + e]; lb[e] = p.lnx_b[ch + e]; }
  for (int pr = blockIdx.x; pr < M_TOK / 2; pr += gridDim.x) {
    const int row = pr * 2 + (tid >> 7);
    float y[4], cv[4], qv[4], g[4];
    unpk4(*(const uint2*)(Y + (size_t)row * 512 + ch), y);
    unpk4(*(const uint2*)(PR + (size_t)row * 1792 + 1024 + ch), cv);
    unpk4(*(const uint2*)(GG + (size_t)row * 512 + ch), g);
    bool first; const float* sprev = nullptr;
    if (row < MP) first = (row % TP) == 0; else { const int r2 = row - MP; first = (r2 & 3) == 0; sprev = p.state_shift + (size_t)(r2 >> 2) * 1792 + 1024 + ch; }
    if (!first) unpk4(*(const uint2*)(PR + (size_t)(row - 1) * 1792 + 1024 + ch), qv);
    else {
#pragma unroll
      for (int e = 0; e < 4; ++e) qv[e] = sprev ? sprev[e] : 0.f;
    }
    const float rho = RHO[(size_t)row * 8 + h];
    float s = y[0] + y[1] + y[2] + y[3]; s = rowsum16(s);
    const float mean = s * (1.f / 64.f);
    float d[4], q = 0.f;
#pragma unroll
    for (int e = 0; e < 4; ++e) { d[e] = y[e] - mean; q += d[e] * d[e]; }
    q = rowsum16(q);
    const float rstd = rsqrtf(q * (1.f / 64.f) + 64e-5f);
    float o[4];
#pragma unroll
    for (int e = 0; e < 4; ++e) { const float v = cv[e] + (qv[e] - cv[e]) * muv[e]; o[e] = (d[e] * rstd * lg[e] + lb[e] + rho * v) * g[e]; }
    *(uint2*)(Y + (size_t)row * 512 + ch) = pk4(o[0], o[1], o[2], o[3]);
  }
}

__device__ __forceinline__ void phase_merge(const Params& p, unsigned char* lds) {
  const bf16_t* OR = (const bf16_t*)(p.ws + OFF_GR); const bf16_t* OW = (const bf16_t*)(p.ws + OFF_Y);
  const bf16_t* WR = (const bf16_t*)(p.ws + OFF_WR); const bf16_t* WWp = (const bf16_t*)(p.ws + OFF_WW);
  const bf16_t* GA = (const bf16_t*)((unsigned char*)p.out + OO_GA); const bf16_t* GB = (const bf16_t*)(p.ws + OFF_GB);
  bf16_t* MG = (bf16_t*)(p.ws + OFF_MG);
  const int nM = M_TOK / 128, nN = 8;
  for (int L = blockIdx.x; L < nM * nN; L += gridDim.x) {
    int tm, tn; tile_coords(L, nM, nN, tm, tn);
    f32x4 acc[4][4]; ZERO_ACC(acc);
    gemm_tile_acc(OR, 512, WR, 512, 512, tm * 128, tn * 128, acc, lds);
    EPI_VARS;
#pragma unroll
    for (int mi = 0; mi < 4; ++mi)
#pragma unroll
      for (int ni = 0; ni < 4; ++ni) { float g[4]; unpk4(*(const uint2*)(GA + (size_t)(rbase + mi * 16) * 1024 + cbase + ni * 16), g);
        *(uint2*)(MG + (size_t)(rbase + mi * 16) * 1024 + cbase + ni * 16) = pk4(acc[mi][ni][0] * g[0], acc[mi][ni][1] * g[1], acc[mi][ni][2] * g[2], acc[mi][ni][3] * g[3]); }
    ZERO_ACC(acc);
    gemm_tile_acc(OW, 512, WWp, 512, 512, tm * 128, tn * 128, acc, lds);
#pragma unroll
    for (int mi = 0; mi < 4; ++mi)
#pragma unroll
      for (int ni = 0; ni < 4; ++ni) { float g[4], t[4]; unpk4(*(const uint2*)(GB + (size_t)(rbase + mi * 16) * 1024 + cbase + ni * 16), g);
        uint2* mp = (uint2*)(MG + (size_t)(rbase + mi * 16) * 1024 + cbase + ni * 16); unpk4(*mp, t);
        *mp = pk4(t[0] + acc[mi][ni][0] * g[0], t[1] + acc[mi][ni][1] * g[1], t[2] + acc[mi][ni][2] * g[2], t[3] + acc[mi][ni][3] * g[3]); }
  }
}

__device__ __forceinline__ void phase_wout(const Params& p, unsigned char* lds) {
  const bf16_t* A = (const bf16_t*)(p.ws + OFF_MG); const bf16_t* W = (const bf16_t*)(p.ws + OFF_WO); bf16_t* H = (bf16_t*)(p.ws + OFF_H);
  const int nM = M_TOK / 128, nN = 8;
  for (int L = blockIdx.x; L < nM * nN; L += gridDim.x) {
    int tm, tn; tile_coords(L, nM, nN, tm, tn);
    f32x4 acc[4][4]; ZERO_ACC(acc);
    gemm_tile_acc(A, 1024, W, 1024, 1024, tm * 128, tn * 128, acc, lds);
    EPI_VARS;
#pragma unroll
    for (int mi = 0; mi < 4; ++mi)
#pragma unroll
      for (int ni = 0; ni < 4; ++ni) { bf16_t* hp = H + (size_t)(rbase + mi * 16) * 1024 + cbase + ni * 16; float h[4]; unpk4(*(const uint2*)hp, h); const f32x4 a = acc[mi][ni];
        *(uint2*)hp = pk4(h[0] + a[0], h[1] + a[1], h[2] + a[2], h[3] + a[3]); }
  }
}

__global__ void __launch_bounds__(256, 2) mega(Params p) {
  extern __shared__ __attribute__((aligned(16))) unsigned char lds[];
  cg::grid_group grid = cg::this_grid();
  const int lo = p.phase_lo, hi = p.phase_hi;
  __shared__ uint4 xb_words;
  if (threadIdx.x == 0) xb_words = make_uint4(0u, 0u, 0u, 0u);
  __syncthreads();
  XcdBarrier xb = xcd_barrier_post((unsigned*)(p.ws + OFF_BAR), (volatile LAS unsigned*)&xb_words);
  if (hi > 1000) grid.sync();
#define RUN_PHASE(k, call) if (PEN(k) && lo <= (k) && (k) < hi) { if ((k) > lo) xcd_barrier(xb); call; if (((DUPMASK) >> (k)) & 1) { call; } }
  RUN_PHASE(0, phase0(p, lds))
  RUN_PHASE(1, phase_ffn_up(p, lds))
  RUN_PHASE(2, phase_ffn_down<true>(p, lds))
  RUN_PHASE(3, (rmsnorm_phase<1, 0>(p, p.mix_norm, (bf16_t*)(p.ws + OFF_A))))
  RUN_PHASE(4, phase_win(p, lds))
  RUN_PHASE(5, phase_lora(p, lds))
  RUN_PHASE(6, phase_scan(p, lds))
  RUN_PHASE(7, phase_post(p, lds))
  RUN_PHASE(8, phase_merge(p, lds))
  RUN_PHASE(9, phase_wout(p, lds))
  RUN_PHASE(10, (rmsnorm_phase<1, 0>(p, p.ffn2_norm, (bf16_t*)(p.ws + OFF_A))))
  RUN_PHASE(11, phase_ffn_up(p, lds))
  RUN_PHASE(12, phase_ffn_down<false>(p, lds))
  RUN_PHASE(13, (rmsnorm_phase<2, 1>(p, p.final_norm, nullptr)))
}

extern "C" void kernel_launch(void* const* d_in, const int* in_sizes, int n_in, void* d_out, int out_size, void* d_ws, size_t ws_size, hipStream_t stream) {
  static int grid_blocks = 0;
  if (grid_blocks == 0) {
    if (n_in != 32 || ws_size < WS_NEED || out_size != 26458112) { fprintf(stderr, "kernel_launch: unexpected sizes n_in %d ws %zu out %d\n", n_in, ws_size, out_size); grid_blocks = -1; return; }
    int dev = 0, cus = 0, per_cu = 0;
    hipGetDevice(&dev);
    hipDeviceGetAttribute(&cus, hipDeviceAttributeMultiprocessorCount, dev);
    if (hipFuncSetAttribute((const void*)mega, hipFuncAttributeMaxDynamicSharedMemorySize, LDS_BYTES) != hipSuccess) { fprintf(stderr, "hipFuncSetAttribute failed\n"); grid_blocks = -1; return; }
    hipOccupancyMaxActiveBlocksPerMultiprocessor(&per_cu, (const void*)mega, NT, LDS_BYTES);
    if (per_cu < 1) { fprintf(stderr, "occupancy query returned %d\n", per_cu); grid_blocks = -1; return; }
    if (per_cu > 2) per_cu = 2;
    grid_blocks = cus * per_cu;
  }
  if (grid_blocks < 0) return;
  if (hipMemsetAsync((unsigned char*)d_ws + OFF_BAR, 0, 16384, stream) != hipSuccess) { fprintf(stderr, "memset failed\n"); return; }
  Params p{};
  const float** pp = (const float**)&p;
  for (int i = 0; i < 32; ++i) pp[i] = (const float*)d_in[i];
  p.out = (float*)d_out; p.ws = (unsigned char*)d_ws;
  for (int j = 0; j < 32; ++j) p.invf[j] = (float)pow(10000.0, -(double)j / 32.0);
  for (int h = 0; h < 4; ++h) p.lg2g[h] = (float)log2(1.0 - exp2(-5.0 - (double)h));
#if SINGLE_LAUNCH
  p.phase_lo = 0; p.phase_hi = NPHASE;
  void* args[] = {&p};
  hipError_t e = hipLaunchCooperativeKernel((const void*)mega, dim3(grid_blocks), dim3(NT), args, LDS_BYTES, stream);
  if (e != hipSuccess) fprintf(stderr, "cooperative launch failed: %s (grid %d)\n", hipGetErrorString(e), grid_blocks);
#else
  for (int ph = 0; ph < NPHASE; ++ph) {
    p.phase_lo = ph; p.phase_hi = ph + 1;
    hipLaunchKernelGGL(mega, dim3(grid_blocks), dim3(NT), LDS_BYTES, stream, p);
  }
#endif
}
```

```cpp
#include <hip/hip_runtime.h>
#include <hip/hip_cooperative_groups.h>
#include <cstdio>
#include <cmath>
namespace cg = cooperative_groups;

#ifndef PHMASK
#define PHMASK 0xffff
#endif
#define PEN(k) (((PHMASK) >> (k)) & 1)
#ifndef DUPMASK
#define DUPMASK 0
#endif
#ifndef DUP6
#define DUP6 0
#endif
#ifndef SINGLE_LAUNCH
#define SINGLE_LAUNCH 1
#endif

typedef unsigned short bf16_t;
typedef short bf16x8 __attribute__((ext_vector_type(8)));
typedef float f32x4 __attribute__((ext_vector_type(4)));
typedef unsigned u32x4 __attribute__((ext_vector_type(4)));
typedef float f32x2 __attribute__((ext_vector_type(2)));

constexpr int NT = 256;
constexpr int M_TOK = 17024, MP = 16512, TP = 2064;
constexpr int PAST = 16384;
constexpr int LDS_BYTES = 73728;
constexpr int NPHASE = 14;

constexpr size_t S1024 = (size_t)M_TOK * 1024 * 2;
constexpr size_t S512 = S1024 / 2;
constexpr size_t OFF_W1GU = 0;
constexpr size_t OFF_W1D = OFF_W1GU + 11534336;
constexpr size_t OFF_WIN = OFF_W1D + 5767168;
constexpr size_t OFF_WR = OFF_WIN + 11010048;
constexpr size_t OFF_WW = OFF_WR + 1048576;
constexpr size_t OFF_WO = OFF_WW + 1048576;
constexpr size_t OFF_H = OFF_WO + 2097152;
constexpr size_t OFF_T = OFF_H + S1024;
constexpr size_t OFF_A = OFF_T;
constexpr size_t OFF_HF = OFF_T + S1024;
constexpr size_t OFF_QK = OFF_HF;
constexpr size_t OFF_V = OFF_QK + S512;
constexpr size_t OFF_GR = OFF_V + S512;
constexpr size_t OFF_PR = OFF_GR + S512;
constexpr size_t OFF_GB = OFF_PR + (size_t)M_TOK * 1792 * 2;
constexpr size_t OFF_Y = OFF_GB + S1024;
constexpr size_t OFF_END = OFF_Y + S512;
constexpr size_t OFF_MG = OFF_QK;
constexpr size_t OFF_BAR = OFF_END;
constexpr size_t OFF_W2T = OFF_BAR + 16384, OFF_A2T = OFF_W2T + 65536, OFF_G2T = OFF_A2T + 65536;
constexpr size_t WS_NEED = OFF_G2T + 131072;
constexpr size_t OFF_H3 = OFF_HF + (size_t)M_TOK * 2816 * 2;
constexpr size_t OFF_LD = OFF_A, OFF_AA = OFF_A + S512;
static_assert(OFF_H3 + (size_t)M_TOK * 1024 * 4 == OFF_END, "map");
constexpr size_t OO_GA = 0, OO_GG = S1024, OO_RHO = S1024 + S512;
constexpr size_t O_YP = 0, O_YS = 16777216, O_RETP = 17301504, O_WKVP = 17563648, O_SHP = 17825792, O_RETS = 17840128, O_WKVS = 22034432, O_SHS = 26228736;

struct Params {
  const float *x_prompt, *x_sample, *state_ret, *state_wkv, *state_shift, *meta;
  const float *ffn1_norm, *ffn1_wg, *ffn1_wu, *ffn1_wd, *mix_norm, *w_in, *ret_gn_g, *mu, *w0, *w2, *a0, *a2, *g2, *k_k, *k_a, *r_k, *lnx_g, *lnx_b;
  const float *w_out_ret, *w_out_rwkv, *w_out, *ffn2_norm, *ffn2_wg, *ffn2_wu, *ffn2_wd, *final_norm;
  float* out;
  unsigned char* ws;
  float invf[32];
  float lg2g[4];
  int phase_lo, phase_hi;
};


#define XB_TMO      128
#define XB_XCNT(j)  (256  + 64 * (j))
#define XB_XSUB(j)  (1280 + 64 * (j))
#define XB_XGEN(j)  (2304 + 64 * (j))
#define XB_TOP      3328
#define XB_TOPGEN   3392
#define XCD_BAR_WORDS 3456
#define XB_SPIN_CAP (1u << 18)
#define LAS __attribute__((address_space(3)))
__device__ __forceinline__ unsigned xb_ld(unsigned* p)              { return __hip_atomic_load(p, __ATOMIC_RELAXED, __HIP_MEMORY_SCOPE_AGENT); }
__device__ __forceinline__ unsigned xb_add(unsigned* p, unsigned v) { return __hip_atomic_fetch_add(p, v, __ATOMIC_RELAXED, __HIP_MEMORY_SCOPE_AGENT); }
__device__ __forceinline__ unsigned xb_xcc_id() { return (unsigned)__builtin_amdgcn_s_getreg((3 << 11) | 20) & 0xFu; }
#define XB_SPIN(cond, bar) do { unsigned _sp = 0; while (cond) { __builtin_amdgcn_s_sleep(1); \
    if ((++_sp & 255u) == 0u) { if (xb_ld(&(bar)[XB_TMO])) break; if (_sp > XB_SPIN_CAP) { atomicAdd(&(bar)[XB_TMO], 1u); break; } } } } while (0)
struct XcdBarrier { unsigned* bar; unsigned x; volatile LAS unsigned* st; };
__device__ __forceinline__ XcdBarrier xcd_barrier_post(unsigned* bar, volatile LAS unsigned* st) {
    XcdBarrier b; b.bar = bar; b.x = xb_xcc_id(); b.st = st;
    if (threadIdx.x == 0) (void)xb_add(&bar[XB_XCNT(b.x)], 1u);
    return b;
}
__device__ __forceinline__ void xcd_barrier_complete(unsigned* bar, unsigned x, unsigned& nloc, unsigned& nx) {
    const unsigned G = gridDim.x * gridDim.y * gridDim.z;
    unsigned sum, cnt, mine, sp = 0u;
    for (;;) {
        sum = 0u; cnt = 0u; mine = 0u;
#pragma unroll
        for (unsigned j = 0; j < 16; ++j) { const unsigned c = xb_ld(&bar[XB_XCNT(j)]); sum += c; cnt += (c > 0u) ? 1u : 0u; mine = (j == x) ? c : mine; }
        if (sum == G) break;
        __builtin_amdgcn_s_sleep(1);
        if ((++sp & 255u) == 0u) { if (xb_ld(&bar[XB_TMO])) break; if (sp > XB_SPIN_CAP) { atomicAdd(&bar[XB_TMO], 1u); break; } }
    }
    nloc = mine > 0u ? mine : 1u; nx = cnt > 0u ? cnt : 1u;
}
__device__ __forceinline__ void xcd_barrier(const XcdBarrier& b) {
    asm volatile("s_waitcnt vmcnt(0)" ::: "memory");
    __syncthreads();
    if (threadIdx.x == 0) {
        unsigned* bar = b.bar;
        __builtin_amdgcn_s_waitcnt(0);
        unsigned nloc = b.st[0], nx = b.st[1];
        if (nloc == 0u) { xcd_barrier_complete(bar, b.x, nloc, nx); b.st[0] = nloc; b.st[1] = nx; }
        const unsigned old = xb_add(&bar[XB_XSUB(b.x)], 1u);
        const unsigned gen = old / nloc;
        if (old + 1u == (gen + 1u) * nloc) {
            __builtin_amdgcn_fence(__ATOMIC_RELEASE, "agent");
            asm volatile("s_waitcnt vmcnt(0)" ::: "memory");
            const unsigned og = xb_add(&bar[XB_TOP], 1u);
            const unsigned tg = og / nx;
            if (og + 1u == (tg + 1u) * nx) xb_add(&bar[XB_TOPGEN], 1u);
            else XB_SPIN(xb_ld(&bar[XB_TOPGEN]) == tg, bar);
            __builtin_amdgcn_fence(__ATOMIC_ACQUIRE, "agent");
            xb_add(&bar[XB_XGEN(b.x)], 1u);
            asm volatile("s_waitcnt vmcnt(0)" ::: "memory");
        } else {
            XB_SPIN(xb_ld(&bar[XB_XGEN(b.x)]) == gen, bar);
            __builtin_amdgcn_fence(__ATOMIC_ACQUIRE, "agent");
            asm volatile("s_waitcnt vmcnt(0)" ::: "memory");
        }
    }
    __syncthreads();
}

__device__ __forceinline__ float bf2f(unsigned h) { return __uint_as_float(h << 16); }
__device__ __forceinline__ unsigned f2bf(float f) { unsigned u = __float_as_uint(f); return (u + 0x7fffu + ((u >> 16) & 1u)) >> 16; }
__device__ __forceinline__ unsigned pk2(float a, float b) { return f2bf(a) | (f2bf(b) << 16); }
__device__ __forceinline__ uint2 pk4(float a, float b, float c, float d) { uint2 r; r.x = pk2(a, b); r.y = pk2(c, d); return r; }
__device__ __forceinline__ void unpk4(uint2 u, float (&o)[4]) { o[0] = __uint_as_float(u.x << 16); o[1] = __uint_as_float(u.x & 0xffff0000u); o[2] = __uint_as_float(u.y << 16); o[3] = __uint_as_float(u.y & 0xffff0000u); }
template <int CTRL> __device__ __forceinline__ float dppf(float x) { return __builtin_bit_cast(float, __builtin_amdgcn_update_dpp(0, __builtin_bit_cast(int, x), CTRL, 0xf, 0xf, true)); }
__device__ __forceinline__ float rowsum16(float x) { x += dppf<0xB1>(x); x += dppf<0x4E>(x); x += dppf<0x141>(x); x += dppf<0x140>(x); return x; }
__device__ __forceinline__ float wavesum(float x) {
#pragma unroll
  for (int o = 32; o >= 1; o >>= 1) x += __shfl_xor(x, o);
  return x;
}
__device__ __forceinline__ float sigmoidf(float x) { return 1.f / (1.f + __expf(-x)); }
__device__ __forceinline__ float siluf(float x) { return x / (1.f + __expf(-x)); }

__device__ __forceinline__ const float* x_row(const Params& p, int row) {
  if (row < MP) { const int b = row / TP, t = row - b * TP; return t < 16 ? p.meta + t * 1024 : p.x_prompt + (size_t)(b * 2048 + t - 16) * 1024; }
  return p.x_sample + (size_t)(row - MP) * 1024;
}

__device__ __forceinline__ void transpose_tiles(const float* __restrict__ src, int K, int N, bf16_t* __restrict__ dst, int rs, int ro, unsigned char* lds) {
  float* tile = (float*)lds;
  const int tid = threadIdx.x;
  const int tk = K / 64, tn = N / 64;
  for (int t = blockIdx.x; t < tk * tn; t += gridDim.x) {
    const int k0 = (t / tn) * 64, n0 = (t % tn) * 64;
    __syncthreads();
    { const int n = tid & 63, kq = tid >> 6;
#pragma unroll
      for (int i = 0; i < 16; ++i) { const int k = kq + 4 * i; tile[k * 65 + n] = src[(size_t)(k0 + k) * N + n0 + n]; } }
    __syncthreads();
    { const int kp = tid & 31, nq = tid >> 5;
#pragma unroll
      for (int i = 0; i < 8; ++i) { const int n = nq + 8 * i; const float v0 = tile[(2 * kp) * 65 + n], v1 = tile[(2 * kp + 1) * 65 + n];
        *(unsigned*)(dst + (size_t)((n0 + n) * rs + ro) * K + k0 + 2 * kp) = pk2(v0, v1); } }
  }
}

template <int SRC, int DST> __device__ __forceinline__ void rmsnorm_phase(const Params& p, const float* __restrict__ g, bf16_t* dstb) {
  const int lane = threadIdx.x & 63, wid = threadIdx.x >> 6;
  const bf16_t* H = (const bf16_t*)(p.ws + OFF_H);
  const float* H3 = (const float*)(p.ws + OFF_H3);
  for (int row = blockIdx.x * 4 + wid; row < M_TOK; row += gridDim.x * 4) {
    float v[16];
    const float* xr = SRC == 0 ? x_row(p, row) : nullptr;
#pragma unroll
    for (int i = 0; i < 4; ++i) {
      const int col = i * 256 + lane * 4;
      if (SRC == 0) { const float4 t = *(const float4*)(xr + col); v[4 * i] = t.x; v[4 * i + 1] = t.y; v[4 * i + 2] = t.z; v[4 * i + 3] = t.w; }
      else if (SRC == 1) { const uint2 u = *(const uint2*)(H + (size_t)row * 1024 + col); float o[4]; unpk4(u, o); v[4 * i] = o[0]; v[4 * i + 1] = o[1]; v[4 * i + 2] = o[2]; v[4 * i + 3] = o[3]; }
      else { const float4 t = *(const float4*)(H3 + (size_t)row * 1024 + col); v[4 * i] = t.x; v[4 * i + 1] = t.y; v[4 * i + 2] = t.z; v[4 * i + 3] = t.w; }
    }
    float ss = 0.f;
#pragma unroll
    for (int i = 0; i < 16; ++i) ss += v[i] * v[i];
    ss = wavesum(ss);
    const float rstd = rsqrtf(ss * (1.f / 1024.f) + 1e-6f);
    float* orow = nullptr;
    if (DST == 1) {
      if (row < MP) { const int b = row / TP, t = row - b * TP; if (t >= 16) orow = p.out + O_YP + (size_t)(b * 2048 + t - 16) * 1024; }
      else orow = p.out + O_YS + (size_t)(row - MP) * 1024;
    }
#pragma unroll
    for (int i = 0; i < 4; ++i) {
      const int col = i * 256 + lane * 4;
      const float4 gv = *(const float4*)(g + col);
      const float y0 = v[4 * i] * rstd * gv.x, y1 = v[4 * i + 1] * rstd * gv.y, y2 = v[4 * i + 2] * rstd * gv.z, y3 = v[4 * i + 3] * rstd * gv.w;
      if (DST == 0) *(uint2*)(dstb + (size_t)row * 1024 + col) = pk4(y0, y1, y2, y3);
      else if (orow) *(float4*)(orow + col) = make_float4(y0, y1, y2, y3);
    }
  }
}

__device__ __forceinline__ void gemm_tile_acc(const bf16_t* __restrict__ A, int lda, const bf16_t* __restrict__ Bt, int ldb, int K, int m0, int n0, f32x4 (&acc)[4][4], unsigned char* lds) {
  const int tid = threadIdx.x, lane = tid & 63, wid = tid >> 6, wm = wid >> 1, wn = wid & 1;
  const int lr = tid >> 3, lc = tid & 7;
  const bf16_t* ag = A + (size_t)(m0 + lr) * lda + lc * 8;
  const bf16_t* bg = Bt + (size_t)(n0 + lr) * ldb + lc * 8;
  u32x4 ra[4], rb[4];
  const int nk = K >> 6;
#pragma unroll
  for (int i = 0; i < 4; ++i) { ra[i] = *(const u32x4*)(ag + (size_t)i * 32 * lda); rb[i] = *(const u32x4*)(bg + (size_t)i * 32 * ldb); }
  __syncthreads();
  const int wofs = lr * 144 + lc * 16;
#pragma unroll
  for (int i = 0; i < 4; ++i) { *(u32x4*)(lds + wofs + i * 4608) = ra[i]; *(u32x4*)(lds + 18432 + wofs + i * 4608) = rb[i]; }
  __syncthreads();
  const int aofs = (wm * 64 + (lane & 15)) * 144 + (lane >> 4) * 16;
  const int bofs = 18432 + (wn * 64 + (lane & 15)) * 144 + (lane >> 4) * 16;
  for (int kt = 0; kt < nk; ++kt) {
    const unsigned char* st = lds + (kt & 1) * 36864;
    if (kt + 1 < nk) {
      const int k0 = (kt + 1) * 64;
#pragma unroll
      for (int i = 0; i < 4; ++i) { ra[i] = *(const u32x4*)(ag + (size_t)i * 32 * lda + k0); rb[i] = *(const u32x4*)(bg + (size_t)i * 32 * ldb + k0); }
    }
#pragma unroll
    for (int kk = 0; kk < 2; ++kk) {
      bf16x8 af[4], bfr[4];
#pragma unroll
      for (int i = 0; i < 4; ++i) { af[i] = *(const bf16x8*)(st + aofs + i * 2304 + kk * 64); bfr[i] = *(const bf16x8*)(st + bofs + i * 2304 + kk * 64); }
#pragma unroll
      for (int mi = 0; mi < 4; ++mi)
#pragma unroll
        for (int ni = 0; ni < 4; ++ni) acc[mi][ni] = __builtin_amdgcn_mfma_f32_16x16x32_bf16(bfr[ni], af[mi], acc[mi][ni], 0, 0, 0);
    }
    if (kt + 1 < nk) {
      unsigned char* sw = lds + ((kt + 1) & 1) * 36864;
#pragma unroll
      for (int i = 0; i < 4; ++i) { *(u32x4*)(sw + wofs + i * 4608) = ra[i]; *(u32x4*)(sw + 18432 + wofs + i * 4608) = rb[i]; }
    }
    __syncthreads();
  }
}

__device__ __forceinline__ void tile_coords(int L, int nM, int nN, int& tm, int& tn) {
  const int nwg = nM * nN, q = nwg / 8, r = nwg % 8, xcd = L % 8, off = L / 8;
  const int wg = (xcd < r ? xcd * (q + 1) : r * (q + 1) + (xcd - r) * q) + off;
  const int nig = 8 * nN, gid = wg / nig, fm = gid * 8, gsz = min(nM - fm, 8);
  tm = fm + (wg % nig) % gsz; tn = (wg % nig) / gsz;
}

#define ZERO_ACC(a) _Pragma("unroll") for (int _i = 0; _i < 4; ++_i) _Pragma("unroll") for (int _j = 0; _j < 4; ++_j) a[_i][_j] = (f32x4){0.f, 0.f, 0.f, 0.f}
#define EPI_VARS const int lane = threadIdx.x & 63, wid = threadIdx.x >> 6, wm = wid >> 1, wn = wid & 1; const int rbase = tm * 128 + wm * 64 + (lane & 15), cbase = tn * 128 + wn * 64 + (lane >> 4) * 4

__device__ __forceinline__ void transpose_jobs(const Params& p, int jlo, int jhi, unsigned char* lds) {
  unsigned char* ws = p.ws;
#pragma unroll 1
  for (int j = jlo; j < jhi; ++j) {
    const float* src; int K, N, rs = 1, ro = 0; size_t off;
    switch (j) {
      case 0: src = p.ffn1_wg; K = 1024; N = 2816; off = OFF_W1GU; rs = 2; break;
      case 1: src = p.ffn1_wu; K = 1024; N = 2816; off = OFF_W1GU; rs = 2; ro = 1; break;
      case 2: src = p.ffn1_wd; K = 2816; N = 1024; off = OFF_W1D; break;
      case 3: src = p.w_in; K = 1024; N = 5376; off = OFF_WIN; break;
      case 4: src = p.w_out_ret; K = 512; N = 1024; off = OFF_WR; break;
      case 5: src = p.w_out_rwkv; K = 512; N = 1024; off = OFF_WW; break;
      case 6: src = p.w_out; K = 1024; N = 1024; off = OFF_WO; break;
      case 7: src = p.ffn2_wg; K = 1024; N = 2816; off = OFF_W1GU; rs = 2; break;
      case 8: src = p.ffn2_wu; K = 1024; N = 2816; off = OFF_W1GU; rs = 2; ro = 1; break;
      case 9: src = p.ffn2_wd; K = 2816; N = 1024; off = OFF_W1D; break;
      case 10: src = p.w2; K = 64; N = 512; off = OFF_W2T; break;
      case 11: src = p.a2; K = 64; N = 512; off = OFF_A2T; break;
      default: src = p.g2; K = 128; N = 512; off = OFF_G2T; break;
    }
    transpose_tiles(src, K, N, (bf16_t*)(ws + off), rs, ro, lds);
  }
}
__device__ __forceinline__ void phase0(const Params& p, unsigned char* lds) {
  transpose_jobs(p, 0, 7, lds);
  transpose_jobs(p, 10, 13, lds);
  rmsnorm_phase<0, 0>(p, p.ffn1_norm, (bf16_t*)(p.ws + OFF_A));
}

__device__ __forceinline__ void phase_ffn_up(const Params& p, unsigned char* lds) {
  const bf16_t* A = (const bf16_t*)(p.ws + OFF_A); const bf16_t* W = (const bf16_t*)(p.ws + OFF_W1GU); bf16_t* HF = (bf16_t*)(p.ws + OFF_HF);
  const int nM = M_TOK / 128, nN = 5632 / 128;
  for (int L = blockIdx.x; L < nM * nN; L += gridDim.x) {
    int tm, tn; tile_coords(L, nM, nN, tm, tn);
    f32x4 acc[4][4]; ZERO_ACC(acc);
    gemm_tile_acc(A, 1024, W, 1024, 1024, tm * 128, tn * 128, acc, lds);
    EPI_VARS;
#pragma unroll
    for (int mi = 0; mi < 4; ++mi)
#pragma unroll
      for (int ni = 0; ni < 4; ++ni) {
        const int row = rbase + mi * 16, c = (cbase + ni * 16) >> 1; const f32x4 a = acc[mi][ni];
        *(unsigned*)(HF + (size_t)row * 2816 + c) = pk2(siluf(a[0]) * a[1], siluf(a[2]) * a[3]);
      }
  }
}

template <bool FIRST> __device__ __forceinline__ void phase_ffn_down(const Params& p, unsigned char* lds) {
  const bf16_t* A = (const bf16_t*)(p.ws + OFF_HF); const bf16_t* W = (const bf16_t*)(p.ws + OFF_W1D);
  bf16_t* H = (bf16_t*)(p.ws + OFF_H); float* H3 = (float*)(p.ws + OFF_H3);
  const int nM = M_TOK / 128, nN = 8;
  for (int L = blockIdx.x; L < nM * nN; L += gridDim.x) {
    int tm, tn; tile_coords(L, nM, nN, tm, tn);
    f32x4 acc[4][4]; ZERO_ACC(acc);
    gemm_tile_acc(A, 2816, W, 2816, 2816, tm * 128, tn * 128, acc, lds);
    EPI_VARS;
#pragma unroll
    for (int mi = 0; mi < 4; ++mi) {
      const int row = rbase + mi * 16;
      const float* xr = FIRST ? x_row(p, row) : nullptr;
#pragma unroll
      for (int ni = 0; ni < 4; ++ni) {
        const int col = cbase + ni * 16; const f32x4 a = acc[mi][ni];
        if (FIRST) { const float4 xv = *(const float4*)(xr + col);
          *(uint2*)(H + (size_t)row * 1024 + col) = pk4(xv.x + 0.5f * a[0], xv.y + 0.5f * a[1], xv.z + 0.5f * a[2], xv.w + 0.5f * a[3]); }
        else { float h[4]; unpk4(*(const uint2*)(H + (size_t)row * 1024 + col), h);
          *(float4*)(H3 + (size_t)row * 1024 + col) = make_float4(h[0] + 0.5f * a[0], h[1] + 0.5f * a[1], h[2] + 0.5f * a[2], h[3] + 0.5f * a[3]); }
      }
    }
  }
}

__device__ __forceinline__ void rope_cs(float ang, float& c, float& s) {
  double rev = (double)ang * 0.15915494309189535; rev -= rint(rev); const float fr = (float)rev;
  s = __builtin_amdgcn_sinf(fr); c = __builtin_amdgcn_cosf(fr);
}
__device__ __forceinline__ void phase_win(const Params& p, unsigned char* lds) {
  const bf16_t* A = (const bf16_t*)(p.ws + OFF_A); const bf16_t* W = (const bf16_t*)(p.ws + OFF_WIN);
  bf16_t* QK = (bf16_t*)(p.ws + OFF_QK); bf16_t* V = (bf16_t*)(p.ws + OFF_V); bf16_t* GR = (bf16_t*)(p.ws + OFF_GR); bf16_t* PR = (bf16_t*)(p.ws + OFF_PR);
  bf16_t* GB = (bf16_t*)(p.ws + OFF_GB); bf16_t* GA = (bf16_t*)((unsigned char*)p.out + OO_GA);
  const int nM = M_TOK / 128, nN = 5376 / 128;
  for (int L = blockIdx.x; L < nM * nN; L += gridDim.x) {
    int tm, tn; tile_coords(L, nM, nN, tm, tn);
    f32x4 acc[4][4]; ZERO_ACC(acc);
    gemm_tile_acc(A, 1024, W, 1024, 1024, tm * 128, tn * 128, acc, lds);
    EPI_VARS;
    const int n0 = tn * 128;
    if (n0 < 512) {
      const float sc = n0 >= 256 ? 0.125f : 1.0f;
      const int hb = n0 + wn * 64;
#pragma unroll
      for (int mi = 0; mi < 4; ++mi) {
        const int row = rbase + mi * 16;
        const float pos = row < MP ? (float)(row % TP) : (float)(PAST + ((row - MP) & 3));
#pragma unroll
        for (int ni = 0; ni < 2; ++ni) {
          float o1[4], o2[4];
#pragma unroll
          for (int jj = 0; jj < 4; ++jj) {
            const int j = ni * 16 + (lane >> 4) * 4 + jj;
            float c, s; rope_cs(pos * p.invf[j], c, s);
            const float x1 = acc[mi][ni][jj], x2 = acc[mi][ni + 2][jj];
            o1[jj] = (x1 * c - x2 * s) * sc; o2[jj] = (x1 * s + x2 * c) * sc;
          }
          const int j0 = ni * 16 + (lane >> 4) * 4;
          *(uint2*)(QK + (size_t)row * 512 + hb + j0) = pk4(o1[0], o1[1], o1[2], o1[3]);
          *(uint2*)(QK + (size_t)row * 512 + hb + 32 + j0) = pk4(o2[0], o2[1], o2[2], o2[3]);
        }
      }
    } else {
#pragma unroll
      for (int mi = 0; mi < 4; ++mi) {
        const int row = rbase + mi * 16;
        float* sh = nullptr;
        if (row < MP) { const int b = row / TP; if (row - b * TP == TP - 1) sh = p.out + O_SHP + (size_t)b * 1792; }
        else { const int r2 = row - MP; if ((r2 & 3) == 3) sh = p.out + O_SHS + (size_t)(r2 >> 2) * 1792; }
#pragma unroll
        for (int ni = 0; ni < 4; ++ni) {
          const int col = cbase + ni * 16; const f32x4 a = acc[mi][ni];
          if (n0 < 1024) *(uint2*)(V + (size_t)row * 512 + (col - 512)) = pk4(a[0], a[1], a[2], a[3]);
          else if (n0 < 1536) *(uint2*)(GR + (size_t)row * 512 + (col - 1024)) = pk4(siluf(a[0]), siluf(a[1]), siluf(a[2]), siluf(a[3]));
          else if (n0 < 3328) { *(uint2*)(PR + (size_t)row * 1792 + (col - 1536)) = pk4(a[0], a[1], a[2], a[3]);
            if (sh) *(float4*)(sh + (col - 1536)) = make_float4(a[0], a[1], a[2], a[3]); }
          else if (n0 < 4352) *(uint2*)(GA + (size_t)row * 1024 + (col - 3328)) = pk4(sigmoidf(a[0]), sigmoidf(a[1]), sigmoidf(a[2]), sigmoidf(a[3]));
          else *(uint2*)(GB + (size_t)row * 1024 + (col - 4352)) = pk4(sigmoidf(a[0]), sigmoidf(a[1]), sigmoidf(a[2]), sigmoidf(a[3]));
        }
      }
    }
  }
}

__device__ __forceinline__ void phase_lora(const Params& p, unsigned char* lds) {
  float* sS = (float*)lds;
  const int tid = threadIdx.x;
  const bf16_t* PR = (const bf16_t*)(p.ws + OFF_PR);
  bf16_t* LD = (bf16_t*)(p.ws + OFF_LD); bf16_t* AA = (bf16_t*)(p.ws + OFF_AA); bf16_t* GG = (bf16_t*)((unsigned char*)p.out + OO_GG);
  const float mu_j = p.mu[1536 + tid];
  for (int tile = blockIdx.x; tile < M_TOK / 16; tile += gridDim.x) {
    const int row0 = tile * 16;
    __syncthreads();
#pragma unroll 4
    for (int tt = 0; tt < 16; ++tt) {
      const int row = row0 + tt;
      const float pc = bf2f(PR[(size_t)row * 1792 + 1536 + tid]);
      float pp;
      if (row < MP) { const int t = row % TP; pp = t == 0 ? 0.f : bf2f(PR[(size_t)(row - 1) * 1792 + 1536 + tid]); }
      else { const int r2 = row - MP; pp = (r2 & 3) == 0 ? p.state_shift[(size_t)(r2 >> 2) * 1792 + 1536 + tid] : bf2f(PR[(size_t)(row - 1) * 1792 + 1536 + tid]); }
      const float pm = pc + (pp - pc) * mu_j;
      sS[tt * 256 + tid] = tid < 64 ? tanhf(pm) : (tid < 128 ? pm : sigmoidf(pm));
    }
    __syncthreads();
#pragma unroll 1
    for (int which = 0; which < 3; ++which) {
      const float* Wm = which == 0 ? p.w2 : (which == 1 ? p.a2 : p.g2);
      const int jb = which == 0 ? 0 : (which == 1 ? 64 : 128), nj = which == 2 ? 128 : 64;
      float acc0[16], acc1[16];
#pragma unroll
      for (int tt = 0; tt < 16; ++tt) { acc0[tt] = 0.f; acc1[tt] = 0.f; }
      for (int j = 0; j < nj; j += 4) {
        float wa[4], wb[4];
#pragma unroll
        for (int e = 0; e < 4; ++e) { wa[e] = Wm[(size_t)(j + e) * 512 + tid]; wb[e] = Wm[(size_t)(j + e) * 512 + tid + 256]; }
#pragma unroll
        for (int tt = 0; tt < 16; ++tt) {
          const float4 s4 = *(const float4*)(sS + tt * 256 + jb + j);
          acc0[tt] += s4.x * wa[0] + s4.y * wa[1] + s4.z * wa[2] + s4.w * wa[3];
          acc1[tt] += s4.x * wb[0] + s4.y * wb[1] + s4.z * wb[2] + s4.w * wb[3];
        }
      }
      if (which == 0) {
        const float b0 = p.w0[tid], b1 = p.w0[tid + 256];
#pragma unroll
        for (int tt = 0; tt < 16; ++tt) {
          const float x0 = -(b0 + acc0[tt]), x1 = -(b1 + acc1[tt]);
          const float sp0 = fmaxf(x0, 0.f) + log1pf(expf(-fabsf(x0))), sp1 = fmaxf(x1, 0.f) + log1pf(expf(-fabsf(x1)));
          LD[(size_t)(row0 + tt) * 512 + tid] = (bf16_t)f2bf(-expf(-sp0 - 0.5f));
          LD[(size_t)(row0 + tt) * 512 + tid + 256] = (bf16_t)f2bf(-expf(-sp1 - 0.5f));
        }
      } else if (which == 1) {
        const float b0 = p.a0[tid], b1 = p.a0[tid + 256];
#pragma unroll
        for (int tt = 0; tt < 16; ++tt) {
          AA[(size_t)(row0 + tt) * 512 + tid] = (bf16_t)f2bf(sigmoidf(b0 + acc0[tt]));
          AA[(size_t)(row0 + tt) * 512 + tid + 256] = (bf16_t)f2bf(sigmoidf(b1 + acc1[tt]));
        }
      } else {
#pragma unroll
        for (int tt = 0; tt < 16; ++tt) {
          GG[(size_t)(row0 + tt) * 512 + tid] = (bf16_t)f2bf(acc0[tt]);
          GG[(size_t)(row0 + tt) * 512 + tid + 256] = (bf16_t)f2bf(acc1[tt]);
        }
      }
    }
  }
}


__device__ __forceinline__ void phase_lora_mfma(const Params& p, unsigned char* lds) {
  constexpr int LSTR = 272;
  unsigned char* sA = lds; unsigned char* sB = lds + 128 * LSTR;
  const bf16_t* PR = (const bf16_t*)(p.ws + OFF_PR);
  bf16_t* LD = (bf16_t*)(p.ws + OFF_LD); bf16_t* AA = (bf16_t*)(p.ws + OFF_AA); bf16_t* GG = (bf16_t*)((unsigned char*)p.out + OO_GG);
  for (int grp = blockIdx.x; grp < (M_TOK / 128) * 3; grp += gridDim.x) {
    int tid_o = threadIdx.x; asm volatile("" : "+v"(tid_o));
    const int tid = tid_o, lane = tid & 63, wid = tid >> 6, wm = wid >> 1, wn = wid & 1, l15 = lane & 15, l4 = lane >> 4;
    const int tm = grp / 3, which = grp - tm * 3;
    const int Kc = which == 2 ? 128 : 64, jb = which == 0 ? 0 : (which == 1 ? 64 : 128), cpr = Kc >> 3;
    const bf16_t* Wt = (const bf16_t*)(p.ws + (which == 0 ? OFF_W2T : (which == 1 ? OFF_A2T : OFF_G2T)));
    __syncthreads();
    for (int q = tid; q < 128 * cpr; q += NT) {
      const int r = q / cpr, ck = q - r * cpr, row = tm * 128 + r, col = 1536 + jb + ck * 8;
      const u32x4 cu = *(const u32x4*)(PR + (size_t)row * 1792 + col);
      float pc[8], pp[8];
#pragma unroll
      for (int e = 0; e < 4; ++e) { pc[2 * e] = __uint_as_float(cu[e] << 16); pc[2 * e + 1] = __uint_as_float(cu[e] & 0xffff0000u); }
      bool first; const float* sprev = nullptr;
      if (row < MP) first = (row % TP) == 0; else { const int r2 = row - MP; first = (r2 & 3) == 0; sprev = p.state_shift + (size_t)(r2 >> 2) * 1792 + col; }
      if (!first) { const u32x4 pu = *(const u32x4*)(PR + (size_t)(row - 1) * 1792 + col);
#pragma unroll
        for (int e = 0; e < 4; ++e) { pp[2 * e] = __uint_as_float(pu[e] << 16); pp[2 * e + 1] = __uint_as_float(pu[e] & 0xffff0000u); } }
      else {
#pragma unroll
        for (int e = 0; e < 8; ++e) pp[e] = sprev ? sprev[e] : 0.f;
      }
      float sv[8];
#pragma unroll
      for (int e = 0; e < 8; ++e) {
        const float pm = pc[e] + (pp[e] - pc[e]) * p.mu[col + e];
        float t;
        if (which == 0) { const float ex = __expf(-2.f * fabsf(pm)); t = (1.f - ex) / (1.f + ex); t = pm < 0.f ? -t : t; }
        else if (which == 1) t = pm;
        else t = sigmoidf(pm);
        sv[e] = t;
      }
      u32x4 o; o[0] = pk2(sv[0], sv[1]); o[1] = pk2(sv[2], sv[3]); o[2] = pk2(sv[4], sv[5]); o[3] = pk2(sv[6], sv[7]);
      *(u32x4*)(sA + r * LSTR + ck * 16) = o;
    }
    for (int tn = 0; tn < 4; ++tn) {
      if (tn > 0) __syncthreads();
      for (int q = tid; q < 128 * cpr; q += NT) { const int r = q / cpr, ck = q - r * cpr; *(u32x4*)(sB + r * LSTR + ck * 16) = *(const u32x4*)(Wt + (size_t)(tn * 128 + r) * Kc + ck * 8); }
      __syncthreads();
      f32x4 acc[4][4]; ZERO_ACC(acc);
      for (int kk = 0; kk < (Kc >> 5); ++kk) {
        bf16x8 af[4], bfr[4];
#pragma unroll
        for (int i = 0; i < 4; ++i) { af[i] = *(const bf16x8*)(sA + (wm * 64 + i * 16 + l15) * LSTR + kk * 64 + l4 * 16); bfr[i] = *(const bf16x8*)(sB + (wn * 64 + i * 16 + l15) * LSTR + kk * 64 + l4 * 16); }
#pragma unroll
        for (int mi = 0; mi < 4; ++mi)
#pragma unroll
          for (int ni = 0; ni < 4; ++ni) acc[mi][ni] = __builtin_amdgcn_mfma_f32_16x16x32_bf16(bfr[ni], af[mi], acc[mi][ni], 0, 0, 0);
      }
#pragma unroll
      for (int ni = 0; ni < 4; ++ni) {
        const int col = tn * 128 + wn * 64 + ni * 16 + l4 * 4;
        float bias[4] = {0.f, 0.f, 0.f, 0.f};
        if (which == 0) { const float4 b4 = *(const float4*)(p.w0 + col); bias[0] = b4.x; bias[1] = b4.y; bias[2] = b4.z; bias[3] = b4.w; }
        else if (which == 1) { const float4 b4 = *(const float4*)(p.a0 + col); bias[0] = b4.x; bias[1] = b4.y; bias[2] = b4.z; bias[3] = b4.w; }
#pragma unroll
        for (int mi = 0; mi < 4; ++mi) {
          const int row = tm * 128 + wm * 64 + mi * 16 + l15;
          float o[4];
#pragma unroll
          for (int jj = 0; jj < 4; ++jj) {
            const float a = acc[mi][ni][jj] + bias[jj];
            if (which == 0) o[jj] = -0.60653066f * sigmoidf(a);
            else if (which == 1) o[jj] = sigmoidf(a);
            else o[jj] = a;
          }
          bf16_t* dst = which == 0 ? LD : (which == 1 ? AA : GG);
          *(uint2*)(dst + (size_t)row * 512 + col) = pk4(o[0], o[1], o[2], o[3]);
        }
      }
    }
  }
}

struct StageRegs { uint2 cr, ck, cv, qr, qk, qv, ld, aa; };

__device__ __forceinline__ void rwkv_item(const Params& p, int rowbase, int T, int h, int rb, const float* shift_prev, const float* S_in, float* S_out, unsigned char* lds) {
  float* stage = (float*)lds;
  float* ybuf = (float*)(lds + 49152);
  const int tid = threadIdx.x, lane = tid & 63, wid = tid >> 6;
  const int t_l = tid >> 4, c4 = tid & 15, ch = h * 64 + c4 * 4;
  const int kg = lane & 15, vloc = wid * 4 + (lane >> 4), vrow = rb * 16 + vloc;
  const bf16_t* PR = (const bf16_t*)(p.ws + OFF_PR); const bf16_t* LD = (const bf16_t*)(p.ws + OFF_LD); const bf16_t* AA = (const bf16_t*)(p.ws + OFF_AA);
  bf16_t* Y = (bf16_t*)(p.ws + OFF_Y); float* RHO = (float*)((unsigned char*)p.out + OO_RHO);
  float mur[4], muk[4], muv[4], kkc[4], kac[4], rkc[4];
#pragma unroll
  for (int e = 0; e < 4; ++e) { mur[e] = p.mu[ch + e]; muk[e] = p.mu[512 + ch + e]; muv[e] = p.mu[1024 + ch + e]; kkc[e] = p.k_k[ch + e]; kac[e] = p.k_a[ch + e]; rkc[e] = p.r_k[ch + e]; }
  f32x4 S;
  if (S_in) S = *(const f32x4*)(S_in + (size_t)vrow * 64 + kg * 4); else S = (f32x4){0.f, 0.f, 0.f, 0.f};
  f32x2 Sa = S.xy, Sb = S.zw;

  auto load = [&](int t0, StageRegs& r) {
    int t = t0 + t_l; if (t > T - 1) t = T - 1;
    const bf16_t* cur = PR + (size_t)(rowbase + t) * 1792 + ch;
    r.cr = *(const uint2*)cur; r.ck = *(const uint2*)(cur + 512); r.cv = *(const uint2*)(cur + 1024);
    if (t > 0) { const bf16_t* pv = cur - 1792; r.qr = *(const uint2*)pv; r.qk = *(const uint2*)(pv + 512); r.qv = *(const uint2*)(pv + 1024); }
    else { r.qr = make_uint2(0, 0); r.qk = r.qr; r.qv = r.qr; }
    r.ld = *(const uint2*)(LD + (size_t)(rowbase + t) * 512 + ch); r.aa = *(const uint2*)(AA + (size_t)(rowbase + t) * 512 + ch);
  };
  auto process = [&](int t0, const StageRegs& r, int buf) {
    float cr[4], ck[4], cv[4], qr[4], qk[4], qv[4], ld[4], aa[4];
    unpk4(r.cr, cr); unpk4(r.ck, ck); unpk4(r.cv, cv); unpk4(r.qr, qr); unpk4(r.qk, qk); unpk4(r.qv, qv); unpk4(r.ld, ld); unpk4(r.aa, aa);
    const int t = t0 + t_l;
    if (t == 0 && shift_prev) {
#pragma unroll
      for (int e = 0; e < 4; ++e) { qr[e] = shift_prev[ch + e]; qk[e] = shift_prev[512 + ch + e]; qv[e] = shift_prev[1024 + ch + e]; }
    }
    float rr[4], k[4], v[4], kk[4], kp[4], bb[4], w[4];
    float ss = 0.f, rho = 0.f;
#pragma unroll
    for (int e = 0; e < 4; ++e) {
      rr[e] = cr[e] + (qr[e] - cr[e]) * mur[e]; k[e] = ck[e] + (qk[e] - ck[e]) * muk[e]; v[e] = cv[e] + (qv[e] - cv[e]) * muv[e];
      kk[e] = k[e] * kkc[e]; ss += kk[e] * kk[e];
      kp[e] = k[e] * (1.f + (aa[e] - 1.f) * kac[e]);
      rho += rr[e] * kp[e] * rkc[e];
      w[e] = expf(ld[e]);
    }
    ss = rowsum16(ss); rho = rowsum16(rho);
    const float inv = rsqrtf(fmaxf(ss, 1e-24f));
#pragma unroll
    for (int e = 0; e < 4; ++e) { kk[e] *= inv; bb[e] = kk[e] * aa[e]; }
    float* sp = stage + (size_t)((buf * 16 + t_l) * 6) * 64 + c4 * 4;
    *(float4*)(sp) = make_float4(rr[0], rr[1], rr[2], rr[3]);
    *(float4*)(sp + 64) = make_float4(w[0], w[1], w[2], w[3]);
    *(float4*)(sp + 128) = make_float4(kp[0], kp[1], kp[2], kp[3]);
    *(float4*)(sp + 192) = make_float4(v[0], v[1], v[2], v[3]);
    *(float4*)(sp + 256) = make_float4(-kk[0], -kk[1], -kk[2], -kk[3]);
    *(float4*)(sp + 320) = make_float4(bb[0], bb[1], bb[2], bb[3]);
    if (rb == 0 && c4 == 0 && t < T) RHO[(size_t)(rowbase + t) * 8 + h] = rho;
  };

  const int nch = (T + 15) >> 4;
  StageRegs rg;
  __syncthreads();
  load(0, rg); process(0, rg, 0);
  __syncthreads();
  for (int c = 0; c < nch; ++c) {
    const int buf = c & 1, t0 = c * 16;
    const int nsteps = min(16, T - t0);
    if (c + 1 < nch) load(t0 + 16, rg);
    const float* st = stage + (size_t)(buf * 16) * 384;
    float* yb = ybuf + buf * 256;
    for (int s0 = 0; s0 < nsteps; s0 += 4) {
#pragma unroll
      for (int u = 0; u < 4; ++u) {
        const int s = s0 + u;
        const float* sp = st + s * 384;
        const f32x4 r4 = *(const f32x4*)(sp + kg * 4), w4 = *(const f32x4*)(sp + 64 + kg * 4), kp4 = *(const f32x4*)(sp + 128 + kg * 4);
        const f32x4 nk4 = *(const f32x4*)(sp + 256 + kg * 4), b4 = *(const f32x4*)(sp + 320 + kg * 4);
        const float vv = sp[192 + vrow];
        f32x2 pa = Sa * nk4.xy; pa = Sb * nk4.zw + pa;
        float sa = rowsum16(pa.x + pa.y);
        const f32x2 sa2 = {sa, sa}, vv2 = {vv, vv};
        const f32x2 Xa = sa2 * b4.xy + vv2 * kp4.xy, Xb = sa2 * b4.zw + vv2 * kp4.zw;
        Sa = Sa * w4.xy + Xa; Sb = Sb * w4.zw + Xb;
        f32x2 ya = Sa * r4.xy; ya = Sb * r4.zw + ya;
        const float y = rowsum16(ya.x + ya.y);
        if (kg == 0) yb[s * 16 + vloc] = y;
      }
    }
    if (c + 1 < nch) process(t0 + 16, rg, buf ^ 1);
    __syncthreads();
    if (t0 + t_l < T) Y[(size_t)(rowbase + t0 + t_l) * 512 + h * 64 + rb * 16 + c4] = (bf16_t)f2bf(yb[t_l * 16 + c4]);
  }
  S.xy = Sa; S.zw = Sb;
  *(f32x4*)(S_out + (size_t)vrow * 64 + kg * 4) = S;
}

__device__ __forceinline__ void ret_item(const Params& p, int rowbase, int T, int h, const float* S_in, float* S_out, unsigned char* lds) {
  unsigned char* sQ = lds; unsigned char* sK = lds + 9216; unsigned char* sKdT = lds + 18432; unsigned char* sVT = lds + 27648; unsigned char* sP = lds + 46080; unsigned char* sST = lds + 55296;
  float* part = (float*)sK;
  const int tid = threadIdx.x, lane = tid & 63, w = tid >> 6, l15 = lane & 15, l4 = lane >> 4;
  const bf16_t* QK = (const bf16_t*)(p.ws + OFF_QK); const bf16_t* V = (const bf16_t*)(p.ws + OFF_V); bf16_t* GR = (bf16_t*)(p.ws + OFF_GR);
  const float lg2 = p.lg2g[h];
  f32x4 ST[2][4];
#pragma unroll
  for (int vt = 0; vt < 2; ++vt)
#pragma unroll
    for (int dt = 0; dt < 4; ++dt) {
      if (S_in) {
#pragma unroll
        for (int jj = 0; jj < 4; ++jj) ST[vt][dt][jj] = 0.f;
        const float4 t4 = *(const float4*)(S_in + (size_t)(dt * 16 + l15) * 128 + 32 * w + vt * 16 + l4 * 4);
        ST[vt][dt][0] = t4.x; ST[vt][dt][1] = t4.y; ST[vt][dt][2] = t4.z; ST[vt][dt][3] = t4.w;
      } else ST[vt][dt] = (f32x4){0.f, 0.f, 0.f, 0.f};
    }
  __syncthreads();
#pragma unroll
  for (int vt = 0; vt < 2; ++vt)
#pragma unroll
    for (int dt = 0; dt < 4; ++dt)
#pragma unroll
      for (int jj = 0; jj < 4; ++jj) *(bf16_t*)(sST + (32 * w + vt * 16 + l4 * 4 + jj) * 144 + (dt * 16 + l15) * 2) = (bf16_t)f2bf(ST[vt][dt][jj]);

  const int nch = (T + 63) >> 6;
  u32x4 pq[2], pk[2], pv[4];
  auto prefetch = [&](int t0n, int tidp) {
    const int Ln = min(64, T - t0n);
#pragma unroll
    for (int i = 0; i < 2; ++i) {
      const int q_ = tidp + i * 256, j = q_ & 63, ck = q_ >> 6;
      pq[i] = (u32x4){0u, 0u, 0u, 0u}; pk[i] = pq[i];
      if (j < Ln) { const bf16_t* src = QK + (size_t)(rowbase + t0n + j) * 512 + h * 64 + ck * 8; pq[i] = *(const u32x4*)src; pk[i] = *(const u32x4*)(src + 256); }
    }
#pragma unroll
    for (int i = 0; i < 4; ++i) {
      const int q_ = tidp + i * 256, j = q_ & 63, cv = q_ >> 6;
      pv[i] = (u32x4){0u, 0u, 0u, 0u};
      if (j < Ln) pv[i] = *(const u32x4*)(V + (size_t)(rowbase + t0n + j) * 512 + h * 128 + cv * 8);
    }
  };
  prefetch(0, threadIdx.x);
  for (int c = 0; c < nch; ++c) {
    const int t0 = c * 64, Lc = min(64, T - t0);
    int tid_o = threadIdx.x; asm volatile("" : "+v"(tid_o));
    const int tid = tid_o, lane = tid & 63, w = tid >> 6, l15 = lane & 15, l4 = lane >> 4;
    __syncthreads();
#pragma unroll
    for (int i = 0; i < 2; ++i) {
      const int q_ = tid + i * 256, j = q_ & 63, ck = q_ >> 6;
      const u32x4 kv = pk[i];
      *(u32x4*)(sQ + j * 144 + ck * 16) = pq[i]; *(u32x4*)(sK + j * 144 + ck * 16) = kv;
      const float kd = __builtin_amdgcn_exp2f((float)(Lc - 1 - j) * lg2);
#pragma unroll
      for (int e = 0; e < 4; ++e) {
        *(bf16_t*)(sKdT + (ck * 8 + 2 * e) * 144 + j * 2) = (bf16_t)f2bf(__uint_as_float(kv[e] << 16) * kd);
        *(bf16_t*)(sKdT + (ck * 8 + 2 * e + 1) * 144 + j * 2) = (bf16_t)f2bf(__uint_as_float(kv[e] & 0xffff0000u) * kd);
      }
    }
#pragma unroll
    for (int i = 0; i < 4; ++i) {
      const int q_ = tid + i * 256, j = q_ & 63, cv = q_ >> 6;
      const u32x4 vv = pv[i];
#pragma unroll
      for (int e = 0; e < 4; ++e) {
        *(bf16_t*)(sVT + (cv * 8 + 2 * e) * 144 + j * 2) = (bf16_t)(vv[e] & 0xffffu);
        *(bf16_t*)(sVT + (cv * 8 + 2 * e + 1) * 144 + j * 2) = (bf16_t)(vv[e] >> 16);
      }
    }
    if (c + 1 < nch) prefetch(t0 + 64, tid);
    __syncthreads();
    {
      f32x4 sc[4];
#pragma unroll
      for (int jt = 0; jt < 4; ++jt) sc[jt] = (f32x4){0.f, 0.f, 0.f, 0.f};
#pragma unroll
      for (int kk = 0; kk < 2; ++kk) {
        const bf16x8 aq = *(const bf16x8*)(sQ + (16 * w + l15) * 144 + kk * 64 + l4 * 16);
#pragma unroll
        for (int jt = 0; jt < 4; ++jt) { const bf16x8 bk = *(const bf16x8*)(sK + (jt * 16 + l15) * 144 + kk * 64 + l4 * 16); sc[jt] = __builtin_amdgcn_mfma_f32_16x16x32_bf16(aq, bk, sc[jt], 0, 0, 0); }
      }
#pragma unroll
      for (int jt = 0; jt < 4; ++jt)
#pragma unroll
        for (int jj = 0; jj < 4; ++jj) {
          const int i = 16 * w + l4 * 4 + jj, j = jt * 16 + l15;
          const float pv = i >= j ? sc[jt][jj] * __builtin_amdgcn_exp2f((float)(i - j) * lg2) : 0.f;
          *(bf16_t*)(sP + i * 144 + j * 2) = (bf16_t)f2bf(pv);
        }
    }
    __syncthreads();
    f32x4 o[4][2];
    {
      bf16x8 bV[2][2], bS[2][2];
#pragma unroll
      for (int vt = 0; vt < 2; ++vt)
#pragma unroll
        for (int kk = 0; kk < 2; ++kk) {
          bV[vt][kk] = *(const bf16x8*)(sVT + (32 * w + vt * 16 + l15) * 144 + kk * 64 + l4 * 16);
          bS[vt][kk] = *(const bf16x8*)(sST + (32 * w + vt * 16 + l15) * 144 + kk * 64 + l4 * 16);
        }
#pragma unroll
      for (int it = 0; it < 4; ++it) {
        bf16x8 aP[2], aQ[2];
#pragma unroll
        for (int kk = 0; kk < 2; ++kk) { aP[kk] = *(const bf16x8*)(sP + (it * 16 + l15) * 144 + kk * 64 + l4 * 16); aQ[kk] = *(const bf16x8*)(sQ + (it * 16 + l15) * 144 + kk * 64 + l4 * 16); }
#pragma unroll
        for (int vt = 0; vt < 2; ++vt) {
          f32x4 a1 = (f32x4){0.f, 0.f, 0.f, 0.f}, a2 = (f32x4){0.f, 0.f, 0.f, 0.f};
#pragma unroll
          for (int kk = 0; kk < 2; ++kk) { a1 = __builtin_amdgcn_mfma_f32_16x16x32_bf16(aP[kk], bV[vt][kk], a1, 0, 0, 0); a2 = __builtin_amdgcn_mfma_f32_16x16x32_bf16(aQ[kk], bS[vt][kk], a2, 0, 0, 0); }
#pragma unroll
          for (int jj = 0; jj < 4; ++jj) { const int i = it * 16 + l4 * 4 + jj; o[it][vt][jj] = a1[jj] + __builtin_amdgcn_exp2f((float)(i + 1) * lg2) * a2[jj]; }
        }
      }
      const float gl = __builtin_amdgcn_exp2f((float)Lc * lg2);
#pragma unroll
      for (int dt = 0; dt < 4; ++dt) {
        bf16x8 bK[2];
#pragma unroll
        for (int kk = 0; kk < 2; ++kk) bK[kk] = *(const bf16x8*)(sKdT + (dt * 16 + l15) * 144 + kk * 64 + l4 * 16);
#pragma unroll
        for (int vt = 0; vt < 2; ++vt) {
          f32x4 a = ST[vt][dt] * gl;
#pragma unroll
          for (int kk = 0; kk < 2; ++kk) a = __builtin_amdgcn_mfma_f32_16x16x32_bf16(bV[vt][kk], bK[kk], a, 0, 0, 0);
          ST[vt][dt] = a;
#pragma unroll
          for (int jj = 0; jj < 4; ++jj) *(bf16_t*)(sST + (32 * w + vt * 16 + l4 * 4 + jj) * 144 + (dt * 16 + l15) * 2) = (bf16_t)f2bf(a[jj]);
        }
      }
    }
    unsigned short grv[4][4][2];
#pragma unroll
    for (int it = 0; it < 4; ++it)
#pragma unroll
      for (int jj = 0; jj < 4; ++jj) {
        const int i = it * 16 + l4 * 4 + jj;
#pragma unroll
        for (int vt = 0; vt < 2; ++vt) grv[it][jj][vt] = i < Lc ? GR[(size_t)(rowbase + t0 + i) * 512 + h * 128 + 32 * w + vt * 16 + l15] : (unsigned short)0;
      }
#pragma unroll
    for (int it = 0; it < 4; ++it)
#pragma unroll
      for (int jj = 0; jj < 4; ++jj) {
        float s1 = o[it][0][jj] + o[it][1][jj], s2 = o[it][0][jj] * o[it][0][jj] + o[it][1][jj] * o[it][1][jj];
        s1 = rowsum16(s1); s2 = rowsum16(s2);
        if (l15 == 0) { const int i = it * 16 + l4 * 4 + jj; part[(w * 64 + i) * 2] = s1; part[(w * 64 + i) * 2 + 1] = s2; }
      }
    const float gn[2] = {p.ret_gn_g[h * 128 + 32 * w + l15], p.ret_gn_g[h * 128 + 32 * w + 16 + l15]};
    __syncthreads();
#pragma unroll
    for (int it = 0; it < 4; ++it)
#pragma unroll
      for (int jj = 0; jj < 4; ++jj) {
        const int i = it * 16 + l4 * 4 + jj;
        float s1 = 0.f, s2 = 0.f;
#pragma unroll
        for (int ww = 0; ww < 4; ++ww) { s1 += part[(ww * 64 + i) * 2]; s2 += part[(ww * 64 + i) * 2 + 1]; }
        const float mean = s1 * (1.f / 128.f), var = fmaxf(s2 * (1.f / 128.f) - mean * mean, 0.f), rstd = rsqrtf(var + 1e-6f);
        if (i < Lc) {
#pragma unroll
          for (int vt = 0; vt < 2; ++vt) {
            const int v = 32 * w + vt * 16 + l15;
            bf16_t* gp = GR + (size_t)(rowbase + t0 + i) * 512 + h * 128 + v;
            *gp = (bf16_t)f2bf((o[it][vt][jj] - mean) * rstd * gn[vt] * bf2f(grv[it][jj][vt]));
          }
        }
      }
  }
#pragma unroll
  for (int vt = 0; vt < 2; ++vt)
#pragma unroll
    for (int dt = 0; dt < 4; ++dt)
      *(float4*)(S_out + (size_t)(dt * 16 + l15) * 128 + 32 * w + vt * 16 + l4 * 4) = make_float4(ST[vt][dt][0], ST[vt][dt][1], ST[vt][dt][2], ST[vt][dt][3]);
}

__device__ __forceinline__ void phase_scan(const Params& p, unsigned char* lds) {
  const int G = gridDim.x;
  int lb, ln;
  if (G >= 352) { lb = (int)blockIdx.x - 288; ln = G - 288; } else { lb = blockIdx.x; ln = G; }
  int hid = blockIdx.x, lid = lb;
  bool heavy = true;
#pragma unroll 1
  while (true) {
    int item;
    if (heavy) { if (hid < 288) { item = hid; hid += G; } else { heavy = false; continue; } }
    else { if (lid >= 0 && lid < 4608) { item = 288 + lid; lid += ln; } else break; }
    bool is_rwkv; int rowbase, T, h, rb = 0; const float* shp = nullptr; const float* sin = nullptr; float* sout;
    if (item < 256) { const int seq = item >> 2, b = seq >> 3; rb = item & 3; h = seq & 7; is_rwkv = true; rowbase = b * TP; T = TP; sout = p.out + O_WKVP + (size_t)seq * 4096; }
    else if (item < 288) { const int bh = item - 256, b = bh >> 2; h = bh & 3; is_rwkv = false; rowbase = b * TP; T = TP; sout = p.out + O_RETP + (size_t)bh * 8192; }
    else if (item < 288 + 4096) { const int it = item - 288, seq = it >> 2, b = seq >> 3; rb = it & 3; h = seq & 7; is_rwkv = true; rowbase = MP + b * 4; T = 4;
      shp = p.state_shift + (size_t)b * 1792; sin = p.state_wkv + (size_t)seq * 4096; sout = p.out + O_WKVS + (size_t)seq * 4096; }
    else { const int bh = item - 288 - 4096, b = bh >> 2; h = bh & 3; is_rwkv = false; rowbase = MP + b * 4; T = 4; sin = p.state_ret + (size_t)bh * 8192; sout = p.out + O_RETS + (size_t)bh * 8192; }
    if (is_rwkv) { rwkv_item(p, rowbase, T, h, rb, shp, sin, sout, lds); if (DUP6) rwkv_item(p, rowbase, T, h, rb, shp, sin, sout, lds); }
    else ret_item(p, rowbase, T, h, sin, sout, lds);
  }
}

__device__ __forceinline__ void phase_post(const Params& p, unsigned char* lds) {
  transpose_jobs(p, 7, 10, lds);
  const int tid = threadIdx.x, h = (tid >> 4) & 7, c4 = tid & 15, ch = h * 64 + c4 * 4;
  bf16_t* Y = (bf16_t*)(p.ws + OFF_Y); const bf16_t* PR = (const bf16_t*)(p.ws + OFF_PR);
  const bf16_t* GG = (const bf16_t*)((unsigned char*)p.out + OO_GG); const float* RHO = (const float*)((unsigned char*)p.out + OO_RHO);
  float muv[4], lg[4], lb[4];
#pragma unroll
  for (int e = 0; e < 4; ++e) { muv[e] = p.mu[1024 + ch + e]; lg[e] = p.lnx_g[ch + e]; lb[e] = p.lnx_b[ch + e]; }
  for (int pr = blockIdx.x; pr < M_TOK / 2; pr += gridDim.x) {
    const int row = pr * 2 + (tid >> 7);
    float y[4], cv[4], qv[4], g[4];
    unpk4(*(const uint2*)(Y + (size_t)row * 512 + ch), y);
    unpk4(*(const uint2*)(PR + (size_t)row * 1792 + 1024 + ch), cv);
    unpk4(*(const uint2*)(GG + (size_t)row * 512 + ch), g);
    bool first; const float* sprev = nullptr;
    if (row < MP) first = (row % TP) == 0; else { const int r2 = row - MP; first = (r2 & 3) == 0; sprev = p.state_shift + (size_t)(r2 >> 2) * 1792 + 1024 + ch; }
    if (!first) unpk4(*(const uint2*)(PR + (size_t)(row - 1) * 1792 + 1024 + ch), qv);
    else {
#pragma unroll
      for (int e = 0; e < 4; ++e) qv[e] = sprev ? sprev[e] : 0.f;
    }
    const float rho = RHO[(size_t)row * 8 + h];
    float s = y[0] + y[1] + y[2] + y[3]; s = rowsum16(s);
    const float mean = s * (1.f / 64.f);
    float d[4], q = 0.f;
#pragma unroll
    for (int e = 0; e < 4; ++e) { d[e] = y[e] - mean; q += d[e] * d[e]; }
    q = rowsum16(q);
    const float rstd = rsqrtf(q * (1.f / 64.f) + 64e-5f);
    float o[4];
#pragma unroll
    for (int e = 0; e < 4; ++e) { const float v = cv[e] + (qv[e] - cv[e]) * muv[e]; o[e] = (d[e] * rstd * lg[e] + lb[e] + rho * v) * g[e]; }
    *(uint2*)(Y + (size_t)row * 512 + ch) = pk4(o[0], o[1], o[2], o[3]);
  }
}

__device__ __forceinline__ void phase_merge(const Params& p, unsigned char* lds) {
  const bf16_t* OR = (const bf16_t*)(p.ws + OFF_GR); const bf16_t* OW = (const bf16_t*)(p.ws + OFF_Y);
  const bf16_t* WR = (const bf16_t*)(p.ws + OFF_WR); const bf16_t* WWp = (const bf16_t*)(p.ws + OFF_WW);
  const bf16_t* GA = (const bf16_t*)((unsigned char*)p.out + OO_GA); const bf16_t* GB = (const bf16_t*)(p.ws + OFF_GB);
  bf16_t* MG = (bf16_t*)(p.ws + OFF_MG);
  const int nM = M_TOK / 128, nN = 8;
  for (int L = blockIdx.x; L < nM * nN; L += gridDim.x) {
    int tm, tn; tile_coords(L, nM, nN, tm, tn);
    f32x4 acc[4][4]; ZERO_ACC(acc);
    gemm_tile_acc(OR, 512, WR, 512, 512, tm * 128, tn * 128, acc, lds);
    EPI_VARS;
#pragma unroll
    for (int mi = 0; mi < 4; ++mi)
#pragma unroll
      for (int ni = 0; ni < 4; ++ni) { float g[4]; unpk4(*(const uint2*)(GA + (size_t)(rbase + mi * 16) * 1024 + cbase + ni * 16), g);
        *(uint2*)(MG + (size_t)(rbase + mi * 16) * 1024 + cbase + ni * 16) = pk4(acc[mi][ni][0] * g[0], acc[mi][ni][1] * g[1], acc[mi][ni][2] * g[2], acc[mi][ni][3] * g[3]); }
    ZERO_ACC(acc);
    gemm_tile_acc(OW, 512, WWp, 512, 512, tm * 128, tn * 128, acc, lds);
#pragma unroll
    for (int mi = 0; mi < 4; ++mi)
#pragma unroll
      for (int ni = 0; ni < 4; ++ni) { float g[4], t[4]; unpk4(*(const uint2*)(GB + (size_t)(rbase + mi * 16) * 1024 + cbase + ni * 16), g);
        uint2* mp = (uint2*)(MG + (size_t)(rbase + mi * 16) * 1024 + cbase + ni * 16); unpk4(*mp, t);
        *mp = pk4(t[0] + acc[mi][ni][0] * g[0], t[1] + acc[mi][ni][1] * g[1], t[2] + acc[mi][ni][2] * g[2], t[3] + acc[mi][ni][3] * g[3]); }
  }
}

__device__ __forceinline__ void phase_wout(const Params& p, unsigned char* lds) {
  const bf16_t* A = (const bf16_t*)(p.ws + OFF_MG); const bf16_t* W = (const bf16_t*)(p.ws + OFF_WO); bf16_t* H = (bf16_t*)(p.ws + OFF_H);
  const int nM = M_TOK / 128, nN = 8;
  for (int L = blockIdx.x; L < nM * nN; L += gridDim.x) {
    int tm, tn; tile_coords(L, nM, nN, tm, tn);
    f32x4 acc[4][4]; ZERO_ACC(acc);
    gemm_tile_acc(A, 1024, W, 1024, 1024, tm * 128, tn * 128, acc, lds);
    EPI_VARS;
#pragma unroll
    for (int mi = 0; mi < 4; ++mi)
#pragma unroll
      for (int ni = 0; ni < 4; ++ni) { bf16_t* hp = H + (size_t)(rbase + mi * 16) * 1024 + cbase + ni * 16; float h[4]; unpk4(*(const uint2*)hp, h); const f32x4 a = acc[mi][ni];
        *(uint2*)hp = pk4(h[0] + a[0], h[1] + a[1], h[2] + a[2], h[3] + a[3]); }
  }
}

__global__ void __launch_bounds__(256, 2) mega(Params p) {
  extern __shared__ __attribute__((aligned(16))) unsigned char lds[];
  cg::grid_group grid = cg::this_grid();
  const int lo = p.phase_lo, hi = p.phase_hi;
  __shared__ uint4 xb_words;
  if (threadIdx.x == 0) xb_words = make_uint4(0u, 0u, 0u, 0u);
  __syncthreads();
  XcdBarrier xb = xcd_barrier_post((unsigned*)(p.ws + OFF_BAR), (volatile LAS unsigned*)&xb_words);
  if (hi > 1000) grid.sync();
#define RUN_PHASE(k, call) if (PEN(k) && lo <= (k) && (k) < hi) { if ((k) > lo) xcd_barrier(xb); call; if (((DUPMASK) >> (k)) & 1) { call; } }
  RUN_PHASE(0, phase0(p, lds))
  RUN_PHASE(1, phase_ffn_up(p, lds))
  RUN_PHASE(2, phase_ffn_down<true>(p, lds))
  RUN_PHASE(3, (rmsnorm_phase<1, 0>(p, p.mix_norm, (bf16_t*)(p.ws + OFF_A))))
  RUN_PHASE(4, phase_win(p, lds))
  RUN_PHASE(5, phase_lora_mfma(p, lds))
  RUN_PHASE(6, phase_scan(p, lds))
  RUN_PHASE(7, phase_post(p, lds))
  RUN_PHASE(8, phase_merge(p, lds))
  RUN_PHASE(9, phase_wout(p, lds))
  RUN_PHASE(10, (rmsnorm_phase<1, 0>(p, p.ffn2_norm, (bf16_t*)(p.ws + OFF_A))))
  RUN_PHASE(11, phase_ffn_up(p, lds))
  RUN_PHASE(12, phase_ffn_down<false>(p, lds))
  RUN_PHASE(13, (rmsnorm_phase<2, 1>(p, p.final_norm, nullptr)))
}

extern "C" void kernel_launch(void* const* d_in, const int* in_sizes, int n_in, void* d_out, int out_size, void* d_ws, size_t ws_size, hipStream_t stream) {
  static int grid_blocks = 0;
  if (grid_blocks == 0) {
    if (n_in != 32 || ws_size < WS_NEED || out_size != 26458112) { fprintf(stderr, "kernel_launch: unexpected sizes n_in %d ws %zu out %d\n", n_in, ws_size, out_size); grid_blocks = -1; return; }
    int dev = 0, cus = 0, per_cu = 0;
    hipGetDevice(&dev);
    hipDeviceGetAttribute(&cus, hipDeviceAttributeMultiprocessorCount, dev);
    if (hipFuncSetAttribute((const void*)mega, hipFuncAttributeMaxDynamicSharedMemorySize, LDS_BYTES) != hipSuccess) { fprintf(stderr, "hipFuncSetAttribute failed\n"); grid_blocks = -1; return; }
    hipOccupancyMaxActiveBlocksPerMultiprocessor(&per_cu, (const void*)mega, NT, LDS_BYTES);
    if (per_cu < 1) { fprintf(stderr, "occupancy query returned %d\n", per_cu); grid_blocks = -1; return; }
    if (per_cu > 2) per_cu = 2;
    grid_blocks = cus * per_cu;
  }
  if (grid_blocks < 0) return;
  if (hipMemsetAsync((unsigned char*)d_ws + OFF_BAR, 0, 16384, stream) != hipSuccess) { fprintf(stderr, "memset failed\n"); return; }
  Params p{};
  const float** pp = (const float**)&p;
  for (int i = 0; i < 32; ++i) pp[i] = (const float*)d_in[i];
  p.out = (float*)d_out; p.ws = (unsigned char*)d_ws;
  for (int j = 0; j < 32; ++j) p.invf[j] = (float)pow(10000.0, -(double)j / 32.0);
  for (int h = 0; h < 4; ++h) p.lg2g[h] = (float)log2(1.0 - exp2(-5.0 - (double)h));
#if SINGLE_LAUNCH
  p.phase_lo = 0; p.phase_hi = NPHASE;
  void* args[] = {&p};
  hipError_t e = hipLaunchCooperativeKernel((const void*)mega, dim3(grid_blocks), dim3(NT), args, LDS_BYTES, stream);
  if (e != hipSuccess) fprintf(stderr, "cooperative launch failed: %s (grid %d)\n", hipGetErrorString(e), grid_blocks);
#else
  for (int ph = 0; ph < NPHASE; ++ph) {
    p.phase_lo = ph; p.phase_hi = ph + 1;
    hipLaunchKernelGGL(mega, dim3(grid_blocks), dim3(NT), LDS_BYTES, stream, p);
  }
#endif
}
```

```cpp
#include <hip/hip_runtime.h>
#include <hip/hip_cooperative_groups.h>
#include <cstdio>
#include <cmath>
namespace cg = cooperative_groups;

#ifndef PHMASK
#define PHMASK 0xffff
#endif
#define PEN(k) (((PHMASK) >> (k)) & 1)
#ifndef DUPMASK
#define DUPMASK 0
#endif
#ifndef DUP6
#define DUP6 0
#endif
#ifndef SINGLE_LAUNCH
#define SINGLE_LAUNCH 1
#endif

typedef unsigned short bf16_t;
typedef short bf16x8 __attribute__((ext_vector_type(8)));
typedef float f32x4 __attribute__((ext_vector_type(4)));
typedef unsigned u32x4 __attribute__((ext_vector_type(4)));
typedef float f32x2 __attribute__((ext_vector_type(2)));

constexpr int NT = 256;
constexpr int M_TOK = 17024, MP = 16512, TP = 2064;
constexpr int PAST = 16384;
constexpr int LDS_BYTES = 73728;
constexpr int NPHASE = 14;

constexpr size_t S1024 = (size_t)M_TOK * 1024 * 2;
constexpr size_t S512 = S1024 / 2;
constexpr size_t OFF_W1GU = 0;
constexpr size_t OFF_W1D = OFF_W1GU + 11534336;
constexpr size_t OFF_WIN = OFF_W1D + 5767168;
constexpr size_t OFF_WR = OFF_WIN + 11010048;
constexpr size_t OFF_WW = OFF_WR + 1048576;
constexpr size_t OFF_WO = OFF_WW + 1048576;
constexpr size_t OFF_H = OFF_WO + 2097152;
constexpr size_t OFF_T = OFF_H + S1024;
constexpr size_t OFF_A = OFF_T;
constexpr size_t OFF_HF = OFF_T + S1024;
constexpr size_t OFF_QK = OFF_HF;
constexpr size_t OFF_V = OFF_QK + S512;
constexpr size_t OFF_GR = OFF_V + S512;
constexpr size_t OFF_PR = OFF_GR + S512;
constexpr size_t OFF_GB = OFF_PR + (size_t)M_TOK * 1792 * 2;
constexpr size_t OFF_Y = OFF_GB + S1024;
constexpr size_t OFF_END = OFF_Y + S512;
constexpr size_t OFF_MG = OFF_QK;
constexpr size_t OFF_BAR = OFF_END;
constexpr size_t OFF_W2T = OFF_BAR + 16384, OFF_A2T = OFF_W2T + 65536, OFF_G2T = OFF_A2T + 65536;
constexpr size_t WS_NEED = OFF_G2T + 131072;
constexpr size_t OFF_H3 = OFF_HF + (size_t)M_TOK * 2816 * 2;
constexpr size_t OFF_LD = OFF_A, OFF_AA = OFF_A + S512;
static_assert(OFF_H3 + (size_t)M_TOK * 1024 * 4 == OFF_END, "map");
constexpr size_t OO_GA = 0, OO_GG = S1024, OO_RHO = S1024 + S512;
constexpr size_t O_YP = 0, O_YS = 16777216, O_RETP = 17301504, O_WKVP = 17563648, O_SHP = 17825792, O_RETS = 17840128, O_WKVS = 22034432, O_SHS = 26228736;

struct Params {
  const float *x_prompt, *x_sample, *state_ret, *state_wkv, *state_shift, *meta;
  const float *ffn1_norm, *ffn1_wg, *ffn1_wu, *ffn1_wd, *mix_norm, *w_in, *ret_gn_g, *mu, *w0, *w2, *a0, *a2, *g2, *k_k, *k_a, *r_k, *lnx_g, *lnx_b;
  const float *w_out_ret, *w_out_rwkv, *w_out, *ffn2_norm, *ffn2_wg, *ffn2_wu, *ffn2_wd, *final_norm;
  float* out;
  unsigned char* ws;
  float invf[32];
  float lg2g[4];
  int phase_lo, phase_hi;
};


#define XB_TMO      128
#define XB_XCNT(j)  (256  + 64 * (j))
#define XB_XSUB(j)  (1280 + 64 * (j))
#define XB_XGEN(j)  (2304 + 64 * (j))
#define XB_TOP      3328
#define XB_TOPGEN   3392
#define XCD_BAR_WORDS 3456
#define XB_SPIN_CAP (1u << 18)
#define LAS __attribute__((address_space(3)))
__device__ __forceinline__ unsigned xb_ld(unsigned* p)              { return __hip_atomic_load(p, __ATOMIC_RELAXED, __HIP_MEMORY_SCOPE_AGENT); }
__device__ __forceinline__ unsigned xb_add(unsigned* p, unsigned v) { return __hip_atomic_fetch_add(p, v, __ATOMIC_RELAXED, __HIP_MEMORY_SCOPE_AGENT); }
__device__ __forceinline__ unsigned xb_xcc_id() { return (unsigned)__builtin_amdgcn_s_getreg((3 << 11) | 20) & 0xFu; }
#define XB_SPIN(cond, bar) do { unsigned _sp = 0; while (cond) { __builtin_amdgcn_s_sleep(1); \
    if ((++_sp & 255u) == 0u) { if (xb_ld(&(bar)[XB_TMO])) break; if (_sp > XB_SPIN_CAP) { atomicAdd(&(bar)[XB_TMO], 1u); break; } } } } while (0)
struct XcdBarrier { unsigned* bar; unsigned x; volatile LAS unsigned* st; };
__device__ __forceinline__ XcdBarrier xcd_barrier_post(unsigned* bar, volatile LAS unsigned* st) {
    XcdBarrier b; b.bar = bar; b.x = xb_xcc_id(); b.st = st;
    if (threadIdx.x == 0) (void)xb_add(&bar[XB_XCNT(b.x)], 1u);
    return b;
}
__device__ __forceinline__ void xcd_barrier_complete(unsigned* bar, unsigned x, unsigned& nloc, unsigned& nx) {
    const unsigned G = gridDim.x * gridDim.y * gridDim.z;
    unsigned sum, cnt, mine, sp = 0u;
    for (;;) {
        sum = 0u; cnt = 0u; mine = 0u;
#pragma unroll
        for (unsigned j = 0; j < 16; ++j) { const unsigned c = xb_ld(&bar[XB_XCNT(j)]); sum += c; cnt += (c > 0u) ? 1u : 0u; mine = (j == x) ? c : mine; }
        if (sum == G) break;
        __builtin_amdgcn_s_sleep(1);
        if ((++sp & 255u) == 0u) { if (xb_ld(&bar[XB_TMO])) break; if (sp > XB_SPIN_CAP) { atomicAdd(&bar[XB_TMO], 1u); break; } }
    }
    nloc = mine > 0u ? mine : 1u; nx = cnt > 0u ? cnt : 1u;
}
__device__ __forceinline__ void xcd_barrier(const XcdBarrier& b) {
    asm volatile("s_waitcnt vmcnt(0)" ::: "memory");
    __syncthreads();
    if (threadIdx.x == 0) {
        unsigned* bar = b.bar;
        __builtin_amdgcn_s_waitcnt(0);
        unsigned nloc = b.st[0], nx = b.st[1];
        if (nloc == 0u) { xcd_barrier_complete(bar, b.x, nloc, nx); b.st[0] = nloc; b.st[1] = nx; }
        const unsigned old = xb_add(&bar[XB_XSUB(b.x)], 1u);
        const unsigned gen = old / nloc;
        if (old + 1u == (gen + 1u) * nloc) {
            __builtin_amdgcn_fence(__ATOMIC_RELEASE, "agent");
            asm volatile("s_waitcnt vmcnt(0)" ::: "memory");
            const unsigned og = xb_add(&bar[XB_TOP], 1u);
            const unsigned tg = og / nx;
            if (og + 1u == (tg + 1u) * nx) xb_add(&bar[XB_TOPGEN], 1u);
            else XB_SPIN(xb_ld(&bar[XB_TOPGEN]) == tg, bar);
            __builtin_amdgcn_fence(__ATOMIC_ACQUIRE, "agent");
            xb_add(&bar[XB_XGEN(b.x)], 1u);
            asm volatile("s_waitcnt vmcnt(0)" ::: "memory");
        } else {
            XB_SPIN(xb_ld(&bar[XB_XGEN(b.x)]) == gen, bar);
            __builtin_amdgcn_fence(__ATOMIC_ACQUIRE, "agent");
            asm volatile("s_waitcnt vmcnt(0)" ::: "memory");
        }
    }
    __syncthreads();
}

__device__ __forceinline__ float bf2f(unsigned h) { return __uint_as_float(h << 16); }
__device__ __forceinline__ unsigned f2bf(float f) { unsigned u = __float_as_uint(f); return (u + 0x7fffu + ((u >> 16) & 1u)) >> 16; }
__device__ __forceinline__ unsigned pk2(float a, float b) { return f2bf(a) | (f2bf(b) << 16); }
__device__ __forceinline__ uint2 pk4(float a, float b, float c, float d) { uint2 r; r.x = pk2(a, b); r.y = pk2(c, d); return r; }
__device__ __forceinline__ void unpk4(uint2 u, float (&o)[4]) { o[0] = __uint_as_float(u.x << 16); o[1] = __uint_as_float(u.x & 0xffff0000u); o[2] = __uint_as_float(u.y << 16); o[3] = __uint_as_float(u.y & 0xffff0000u); }
template <int CTRL> __device__ __forceinline__ float dppf(float x) { return __builtin_bit_cast(float, __builtin_amdgcn_update_dpp(0, __builtin_bit_cast(int, x), CTRL, 0xf, 0xf, true)); }
__device__ __forceinline__ float rowsum16(float x) { x += dppf<0xB1>(x); x += dppf<0x4E>(x); x += dppf<0x141>(x); x += dppf<0x140>(x); return x; }
__device__ __forceinline__ float wavesum(float x) {
#pragma unroll
  for (int o = 32; o >= 1; o >>= 1) x += __shfl_xor(x, o);
  return x;
}
__device__ __forceinline__ float sigmoidf(float x) { return 1.f / (1.f + __expf(-x)); }
__device__ __forceinline__ float siluf(float x) { return x / (1.f + __expf(-x)); }

__device__ __forceinline__ const float* x_row(const Params& p, int row) {
  if (row < MP) { const int b = row / TP, t = row - b * TP; return t < 16 ? p.meta + t * 1024 : p.x_prompt + (size_t)(b * 2048 + t - 16) * 1024; }
  return p.x_sample + (size_t)(row - MP) * 1024;
}

__device__ __forceinline__ void transpose_tiles(const float* __restrict__ src, int K, int N, bf16_t* __restrict__ dst, int rs, int ro, unsigned char* lds) {
  float* tile = (float*)lds;
  const int tid = threadIdx.x;
  const int tk = K / 64, tn = N / 64;
  for (int t = blockIdx.x; t < tk * tn; t += gridDim.x) {
    const int k0 = (t / tn) * 64, n0 = (t % tn) * 64;
    __syncthreads();
    { const int n = tid & 63, kq = tid >> 6;
#pragma unroll
      for (int i = 0; i < 16; ++i) { const int k = kq + 4 * i; tile[k * 65 + n] = src[(size_t)(k0 + k) * N + n0 + n]; } }
    __syncthreads();
    { const int kp = tid & 31, nq = tid >> 5;
#pragma unroll
      for (int i = 0; i < 8; ++i) { const int n = nq + 8 * i; const float v0 = tile[(2 * kp) * 65 + n], v1 = tile[(2 * kp + 1) * 65 + n];
        *(unsigned*)(dst + (size_t)((n0 + n) * rs + ro) * K + k0 + 2 * kp) = pk2(v0, v1); } }
  }
}

template <int SRC, int DST> __device__ __forceinline__ void rmsnorm_phase(const Params& p, const float* __restrict__ g, bf16_t* dstb) {
  const int lane = threadIdx.x & 63, wid = threadIdx.x >> 6;
  const bf16_t* H = (const bf16_t*)(p.ws + OFF_H);
  const float* H3 = (const float*)(p.ws + OFF_H3);
  for (int row = blockIdx.x * 4 + wid; row < M_TOK; row += gridDim.x * 4) {
    float v[16];
    const float* xr = SRC == 0 ? x_row(p, row) : nullptr;
#pragma unroll
    for (int i = 0; i < 4; ++i) {
      const int col = i * 256 + lane * 4;
      if (SRC == 0) { const float4 t = *(const float4*)(xr + col); v[4 * i] = t.x; v[4 * i + 1] = t.y; v[4 * i + 2] = t.z; v[4 * i + 3] = t.w; }
      else if (SRC == 1) { const uint2 u = *(const uint2*)(H + (size_t)row * 1024 + col); float o[4]; unpk4(u, o); v[4 * i] = o[0]; v[4 * i + 1] = o[1]; v[4 * i + 2] = o[2]; v[4 * i + 3] = o[3]; }
      else { const float4 t = *(const float4*)(H3 + (size_t)row * 1024 + col); v[4 * i] = t.x; v[4 * i + 1] = t.y; v[4 * i + 2] = t.z; v[4 * i + 3] = t.w; }
    }
    float ss = 0.f;
#pragma unroll
    for (int i = 0; i < 16; ++i) ss += v[i] * v[i];
    ss = wavesum(ss);
    const float rstd = rsqrtf(ss * (1.f / 1024.f) + 1e-6f);
    float* orow = nullptr;
    if (DST == 1) {
      if (row < MP) { const int b = row / TP, t = row - b * TP; if (t >= 16) orow = p.out + O_YP + (size_t)(b * 2048 + t - 16) * 1024; }
      else orow = p.out + O_YS + (size_t)(row - MP) * 1024;
    }
#pragma unroll
    for (int i = 0; i < 4; ++i) {
      const int col = i * 256 + lane * 4;
      const float4 gv = *(const float4*)(g + col);
      const float y0 = v[4 * i] * rstd * gv.x, y1 = v[4 * i + 1] * rstd * gv.y, y2 = v[4 * i + 2] * rstd * gv.z, y3 = v[4 * i + 3] * rstd * gv.w;
      if (DST == 0) *(uint2*)(dstb + (size_t)row * 1024 + col) = pk4(y0, y1, y2, y3);
      else if (orow) *(float4*)(orow + col) = make_float4(y0, y1, y2, y3);
    }
  }
}

#define RAW_BARRIER() do { asm volatile("s_waitcnt lgkmcnt(0)" ::: "memory"); __builtin_amdgcn_s_barrier(); asm volatile("" ::: "memory"); } while (0)
__device__ __forceinline__ void gemm_tile_dma(const bf16_t* __restrict__ A, int lda, const bf16_t* __restrict__ Bt, int ldb, int K, int m0, int n0, f32x4 (&acc)[8][4], unsigned char* lds) {
  const int tid = threadIdx.x, lane = tid & 63, wid = tid >> 6, wm = wid >> 1, wn = wid & 1, l15 = lane & 15, l4 = lane >> 4;
  const int nk = K >> 5;
  const int cs = ((lane & 3) ^ ((lane >> 4) & 3)) * 8;
  const bf16_t* ag[4]; const bf16_t* bg[2];
#pragma unroll
  for (int i = 0; i < 4; ++i) { int row = m0 + (wid * 4 + i) * 16 + (lane >> 2); row = row < M_TOK ? row : M_TOK - 1; ag[i] = A + (size_t)row * lda + cs; }
#pragma unroll
  for (int i = 0; i < 2; ++i) { const int row = n0 + (wid * 2 + i) * 16 + (lane >> 2); bg[i] = Bt + (size_t)row * ldb + cs; }
  auto issue = [&](int kt, int buf) {
    unsigned char* sb = lds + buf * 24576 + lane * 16;
#pragma unroll
    for (int i = 0; i < 4; ++i) __builtin_amdgcn_global_load_lds((const unsigned*)(ag[i] + kt * 32), (LAS unsigned*)(sb + (wid * 4 + i) * 1024), 16, 0, 0);
#pragma unroll
    for (int i = 0; i < 2; ++i) __builtin_amdgcn_global_load_lds((const unsigned*)(bg[i] + kt * 32), (LAS unsigned*)(sb + 16384 + (wid * 2 + i) * 1024), 16, 0, 0);
  };
  const int sw = ((l4 ^ (l15 >> 2)) & 3) * 16;
  const int aofs = (wm * 128 + l15) * 64 + sw, bofs = 16384 + (wn * 64 + l15) * 64 + sw;
  RAW_BARRIER();
  issue(0, 0);
  if (nk > 1) issue(1, 1);
  int bc = 0, bi = 2;
  for (int kt = 0; kt < nk; ++kt) {
    if (kt + 1 < nk) asm volatile("s_waitcnt vmcnt(6)" ::: "memory"); else asm volatile("s_waitcnt vmcnt(0)" ::: "memory");
    RAW_BARRIER();
    if (kt + 2 < nk) issue(kt + 2, bi);
    const unsigned char* st = lds + bc * 24576;
    bf16x8 af[8], bfr[4];
#pragma unroll
    for (int i = 0; i < 8; ++i) af[i] = *(const bf16x8*)(st + aofs + i * 1024);
#pragma unroll
    for (int i = 0; i < 4; ++i) bfr[i] = *(const bf16x8*)(st + bofs + i * 1024);
#pragma unroll
    for (int mi = 0; mi < 8; ++mi)
#pragma unroll
      for (int ni = 0; ni < 4; ++ni) acc[mi][ni] = __builtin_amdgcn_mfma_f32_16x16x32_bf16(bfr[ni], af[mi], acc[mi][ni], 0, 0, 0);
    bc = bc == 2 ? 0 : bc + 1; bi = bi == 2 ? 0 : bi + 1;
  }
}

__device__ __forceinline__ void tile_coords(int L, int nM, int nN, int& tm, int& tn) {
  const int nwg = nM * nN, q = nwg / 8, r = nwg % 8, xcd = L % 8, off = L / 8;
  const int wg = (xcd < r ? xcd * (q + 1) : r * (q + 1) + (xcd - r) * q) + off;
  const int nig = 8 * nN, gid = wg / nig, fm = gid * 8, gsz = min(nM - fm, 8);
  tm = fm + (wg % nig) % gsz; tn = (wg % nig) / gsz;
}

#define ZERO_ACC(a) _Pragma("unroll") for (int _i = 0; _i < 4; ++_i) _Pragma("unroll") for (int _j = 0; _j < 4; ++_j) a[_i][_j] = (f32x4){0.f, 0.f, 0.f, 0.f}
#define ZERO_ACC8(a) _Pragma("unroll") for (int _i = 0; _i < 8; ++_i) _Pragma("unroll") for (int _j = 0; _j < 4; ++_j) a[_i][_j] = (f32x4){0.f, 0.f, 0.f, 0.f}
#define EPI_VARS8 const int lane = threadIdx.x & 63, wid = threadIdx.x >> 6, wm = wid >> 1, wn = wid & 1; const int rbase = tm * 256 + wm * 128 + (lane & 15), cbase = tn * 128 + wn * 64 + (lane >> 4) * 4
#define NMT 67
#define EPI_VARS const int lane = threadIdx.x & 63, wid = threadIdx.x >> 6, wm = wid >> 1, wn = wid & 1; const int rbase = tm * 128 + wm * 64 + (lane & 15), cbase = tn * 128 + wn * 64 + (lane >> 4) * 4

__device__ __forceinline__ void transpose_jobs(const Params& p, int jlo, int jhi, unsigned char* lds) {
  unsigned char* ws = p.ws;
#pragma unroll 1
  for (int j = jlo; j < jhi; ++j) {
    const float* src; int K, N, rs = 1, ro = 0; size_t off;
    switch (j) {
      case 0: src = p.ffn1_wg; K = 1024; N = 2816; off = OFF_W1GU; rs = 2; break;
      case 1: src = p.ffn1_wu; K = 1024; N = 2816; off = OFF_W1GU; rs = 2; ro = 1; break;
      case 2: src = p.ffn1_wd; K = 2816; N = 1024; off = OFF_W1D; break;
      case 3: src = p.w_in; K = 1024; N = 5376; off = OFF_WIN; break;
      case 4: src = p.w_out_ret; K = 512; N = 1024; off = OFF_WR; break;
      case 5: src = p.w_out_rwkv; K = 512; N = 1024; off = OFF_WW; break;
      case 6: src = p.w_out; K = 1024; N = 1024; off = OFF_WO; break;
      case 7: src = p.ffn2_wg; K = 1024; N = 2816; off = OFF_W1GU; rs = 2; break;
      case 8: src = p.ffn2_wu; K = 1024; N = 2816; off = OFF_W1GU; rs = 2; ro = 1; break;
      case 9: src = p.ffn2_wd; K = 2816; N = 1024; off = OFF_W1D; break;
      case 10: src = p.w2; K = 64; N = 512; off = OFF_W2T; break;
      case 11: src = p.a2; K = 64; N = 512; off = OFF_A2T; break;
      default: src = p.g2; K = 128; N = 512; off = OFF_G2T; break;
    }
    transpose_tiles(src, K, N, (bf16_t*)(ws + off), rs, ro, lds);
  }
}
__device__ __forceinline__ void phase0(const Params& p, unsigned char* lds) {
  transpose_jobs(p, 0, 7, lds);
  transpose_jobs(p, 10, 13, lds);
  rmsnorm_phase<0, 0>(p, p.ffn1_norm, (bf16_t*)(p.ws + OFF_A));
}

__device__ __forceinline__ void phase_ffn_up(const Params& p, unsigned char* lds) {
  const bf16_t* A = (const bf16_t*)(p.ws + OFF_A); const bf16_t* W = (const bf16_t*)(p.ws + OFF_W1GU); bf16_t* HF = (bf16_t*)(p.ws + OFF_HF);
  const int nM = NMT, nN = 5632 / 128;
  for (int L = blockIdx.x; L < nM * nN; L += gridDim.x) {
    int tm, tn; tile_coords(L, nM, nN, tm, tn);
    f32x4 acc[8][4]; ZERO_ACC8(acc);
    gemm_tile_dma(A, 1024, W, 1024, 1024, tm * 256, tn * 128, acc, lds);
    EPI_VARS8;
#pragma unroll
    for (int mi = 0; mi < 8; ++mi) {
      const int row = rbase + mi * 16;
      if (row < M_TOK) {
#pragma unroll
        for (int ni = 0; ni < 4; ++ni) {
          const int c = (cbase + ni * 16) >> 1; const f32x4 a = acc[mi][ni];
          *(unsigned*)(HF + (size_t)row * 2816 + c) = pk2(siluf(a[0]) * a[1], siluf(a[2]) * a[3]);
        }
      }
    }
  }
}

template <bool FIRST> __device__ __forceinline__ void phase_ffn_down(const Params& p, unsigned char* lds) {
  const bf16_t* A = (const bf16_t*)(p.ws + OFF_HF); const bf16_t* W = (const bf16_t*)(p.ws + OFF_W1D);
  bf16_t* H = (bf16_t*)(p.ws + OFF_H); float* H3 = (float*)(p.ws + OFF_H3);
  const int nM = NMT, nN = 8;
  for (int L = blockIdx.x; L < nM * nN; L += gridDim.x) {
    int tm, tn; tile_coords(L, nM, nN, tm, tn);
    f32x4 acc[8][4]; ZERO_ACC8(acc);
    gemm_tile_dma(A, 2816, W, 2816, 2816, tm * 256, tn * 128, acc, lds);
    EPI_VARS8;
#pragma unroll
    for (int mi = 0; mi < 8; ++mi) {
      const int row = rbase + mi * 16;
      if (row < M_TOK) {
        const float* xr = FIRST ? x_row(p, row) : nullptr;
#pragma unroll
        for (int ni = 0; ni < 4; ++ni) {
          const int col = cbase + ni * 16; const f32x4 a = acc[mi][ni];
          if (FIRST) { const float4 xv = *(const float4*)(xr + col);
            *(uint2*)(H + (size_t)row * 1024 + col) = pk4(xv.x + 0.5f * a[0], xv.y + 0.5f * a[1], xv.z + 0.5f * a[2], xv.w + 0.5f * a[3]); }
          else { float h[4]; unpk4(*(const uint2*)(H + (size_t)row * 1024 + col), h);
            *(float4*)(H3 + (size_t)row * 1024 + col) = make_float4(h[0] + 0.5f * a[0], h[1] + 0.5f * a[1], h[2] + 0.5f * a[2], h[3] + 0.5f * a[3]); }
        }
      }
    }
  }
}

__device__ __forceinline__ void rope_cs(float ang, float& c, float& s) {
  double rev = (double)ang * 0.15915494309189535; rev -= rint(rev); const float fr = (float)rev;
  s = __builtin_amdgcn_sinf(fr); c = __builtin_amdgcn_cosf(fr);
}
__device__ __forceinline__ void phase_win(const Params& p, unsigned char* lds) {
  const bf16_t* A = (const bf16_t*)(p.ws + OFF_A); const bf16_t* W = (const bf16_t*)(p.ws + OFF_WIN);
  bf16_t* QK = (bf16_t*)(p.ws + OFF_QK); bf16_t* V = (bf16_t*)(p.ws + OFF_V); bf16_t* GR = (bf16_t*)(p.ws + OFF_GR); bf16_t* PR = (bf16_t*)(p.ws + OFF_PR);
  bf16_t* GB = (bf16_t*)(p.ws + OFF_GB); bf16_t* GA = (bf16_t*)((unsigned char*)p.out + OO_GA);
  const int nM = NMT, nN = 5376 / 128;
  for (int L = blockIdx.x; L < nM * nN; L += gridDim.x) {
    int tm, tn; tile_coords(L, nM, nN, tm, tn);
    f32x4 acc[8][4]; ZERO_ACC8(acc);
    gemm_tile_dma(A, 1024, W, 1024, 1024, tm * 256, tn * 128, acc, lds);
    EPI_VARS8;
    const int n0 = tn * 128;
    if (n0 < 512) {
      const float sc = n0 >= 256 ? 0.125f : 1.0f;
      const int hb = n0 + wn * 64;
#pragma unroll
      for (int mi = 0; mi < 8; ++mi) {
        const int row = rbase + mi * 16;
        if (row >= M_TOK) continue;
        const float pos = row < MP ? (float)(row % TP) : (float)(PAST + ((row - MP) & 3));
#pragma unroll
        for (int ni = 0; ni < 2; ++ni) {
          float o1[4], o2[4];
#pragma unroll
          for (int jj = 0; jj < 4; ++jj) {
            const int j = ni * 16 + (lane >> 4) * 4 + jj;
            float c, s; rope_cs(pos * p.invf[j], c, s);
            const float x1 = acc[mi][ni][jj], x2 = acc[mi][ni + 2][jj];
            o1[jj] = (x1 * c - x2 * s) * sc; o2[jj] = (x1 * s + x2 * c) * sc;
          }
          const int j0 = ni * 16 + (lane >> 4) * 4;
          *(uint2*)(QK + (size_t)row * 512 + hb + j0) = pk4(o1[0], o1[1], o1[2], o1[3]);
          *(uint2*)(QK + (size_t)row * 512 + hb + 32 + j0) = pk4(o2[0], o2[1], o2[2], o2[3]);
        }
      }
    } else {
#pragma unroll
      for (int mi = 0; mi < 8; ++mi) {
        const int row = rbase + mi * 16;
        if (row >= M_TOK) continue;
        float* sh = nullptr;
        if (row < MP) { const int b = row / TP; if (row - b * TP == TP - 1) sh = p.out + O_SHP + (size_t)b * 1792; }
        else { const int r2 = row - MP; if ((r2 & 3) == 3) sh = p.out + O_SHS + (size_t)(r2 >> 2) * 1792; }
#pragma unroll
        for (int ni = 0; ni < 4; ++ni) {
          const int col = cbase + ni * 16; const f32x4 a = acc[mi][ni];
          if (n0 < 1024) *(uint2*)(V + (size_t)row * 512 + (col - 512)) = pk4(a[0], a[1], a[2], a[3]);
          else if (n0 < 1536) *(uint2*)(GR + (size_t)row * 512 + (col - 1024)) = pk4(siluf(a[0]), siluf(a[1]), siluf(a[2]), siluf(a[3]));
          else if (n0 < 3328) { *(uint2*)(PR + (size_t)row * 1792 + (col - 1536)) = pk4(a[0], a[1], a[2], a[3]);
            if (sh) *(float4*)(sh + (col - 1536)) = make_float4(a[0], a[1], a[2], a[3]); }
          else if (n0 < 4352) *(uint2*)(GA + (size_t)row * 1024 + (col - 3328)) = pk4(sigmoidf(a[0]), sigmoidf(a[1]), sigmoidf(a[2]), sigmoidf(a[3]));
          else *(uint2*)(GB + (size_t)row * 1024 + (col - 4352)) = pk4(sigmoidf(a[0]), sigmoidf(a[1]), sigmoidf(a[2]), sigmoidf(a[3]));
        }
      }
    }
  }
}

__device__ __forceinline__ void phase_lora(const Params& p, unsigned char* lds) {
  float* sS = (float*)lds;
  const int tid = threadIdx.x;
  const bf16_t* PR = (const bf16_t*)(p.ws + OFF_PR);
  bf16_t* LD = (bf16_t*)(p.ws + OFF_LD); bf16_t* AA = (bf16_t*)(p.ws + OFF_AA); bf16_t* GG = (bf16_t*)((unsigned char*)p.out + OO_GG);
  const float mu_j = p.mu[1536 + tid];
  for (int tile = blockIdx.x; tile < M_TOK / 16; tile += gridDim.x) {
    const int row0 = tile * 16;
    __syncthreads();
#pragma unroll 4
    for (int tt = 0; tt < 16; ++tt) {
      const int row = row0 + tt;
      const float pc = bf2f(PR[(size_t)row * 1792 + 1536 + tid]);
      float pp;
      if (row < MP) { const int t = row % TP; pp = t == 0 ? 0.f : bf2f(PR[(size_t)(row - 1) * 1792 + 1536 + tid]); }
      else { const int r2 = row - MP; pp = (r2 & 3) == 0 ? p.state_shift[(size_t)(r2 >> 2) * 1792 + 1536 + tid] : bf2f(PR[(size_t)(row - 1) * 1792 + 1536 + tid]); }
      const float pm = pc + (pp - pc) * mu_j;
      sS[tt * 256 + tid] = tid < 64 ? tanhf(pm) : (tid < 128 ? pm : sigmoidf(pm));
    }
    __syncthreads();
#pragma unroll 1
    for (int which = 0; which < 3; ++which) {
      const float* Wm = which == 0 ? p.w2 : (which == 1 ? p.a2 : p.g2);
      const int jb = which == 0 ? 0 : (which == 1 ? 64 : 128), nj = which == 2 ? 128 : 64;
      float acc0[16], acc1[16];
#pragma unroll
      for (int tt = 0; tt < 16; ++tt) { acc0[tt] = 0.f; acc1[tt] = 0.f; }
      for (int j = 0; j < nj; j += 4) {
        float wa[4], wb[4];
#pragma unroll
        for (int e = 0; e < 4; ++e) { wa[e] = Wm[(size_t)(j + e) * 512 + tid]; wb[e] = Wm[(size_t)(j + e) * 512 + tid + 256]; }
#pragma unroll
        for (int tt = 0; tt < 16; ++tt) {
          const float4 s4 = *(const float4*)(sS + tt * 256 + jb + j);
          acc0[tt] += s4.x * wa[0] + s4.y * wa[1] + s4.z * wa[2] + s4.w * wa[3];
          acc1[tt] += s4.x * wb[0] + s4.y * wb[1] + s4.z * wb[2] + s4.w * wb[3];
        }
      }
      if (which == 0) {
        const float b0 = p.w0[tid], b1 = p.w0[tid + 256];
#pragma unroll
        for (int tt = 0; tt < 16; ++tt) {
          const float x0 = -(b0 + acc0[tt]), x1 = -(b1 + acc1[tt]);
          const float sp0 = fmaxf(x0, 0.f) + log1pf(expf(-fabsf(x0))), sp1 = fmaxf(x1, 0.f) + log1pf(expf(-fabsf(x1)));
          LD[(size_t)(row0 + tt) * 512 + tid] = (bf16_t)f2bf(-expf(-sp0 - 0.5f));
          LD[(size_t)(row0 + tt) * 512 + tid + 256] = (bf16_t)f2bf(-expf(-sp1 - 0.5f));
        }
      } else if (which == 1) {
        const float b0 = p.a0[tid], b1 = p.a0[tid + 256];
#pragma unroll
        for (int tt = 0; tt < 16; ++tt) {
          AA[(size_t)(row0 + tt) * 512 + tid] = (bf16_t)f2bf(sigmoidf(b0 + acc0[tt]));
          AA[(size_t)(row0 + tt) * 512 + tid + 256] = (bf16_t)f2bf(sigmoidf(b1 + acc1[tt]));
        }
      } else {
#pragma unroll
        for (int tt = 0; tt < 16; ++tt) {
          GG[(size_t)(row0 + tt) * 512 + tid] = (bf16_t)f2bf(acc0[tt]);
          GG[(size_t)(row0 + tt) * 512 + tid + 256] = (bf16_t)f2bf(acc1[tt]);
        }
      }
    }
  }
}


__device__ __forceinline__ void phase_lora_mfma(const Params& p, unsigned char* lds) {
  constexpr int LSTR = 272;
  unsigned char* sA = lds; unsigned char* sB = lds + 128 * LSTR;
  const bf16_t* PR = (const bf16_t*)(p.ws + OFF_PR);
  bf16_t* LD = (bf16_t*)(p.ws + OFF_LD); bf16_t* AA = (bf16_t*)(p.ws + OFF_AA); bf16_t* GG = (bf16_t*)((unsigned char*)p.out + OO_GG);
  for (int grp = blockIdx.x; grp < (M_TOK / 128) * 3; grp += gridDim.x) {
    int tid_o = threadIdx.x; asm volatile("" : "+v"(tid_o));
    const int tid = tid_o, lane = tid & 63, wid = tid >> 6, wm = wid >> 1, wn = wid & 1, l15 = lane & 15, l4 = lane >> 4;
    const int tm = grp / 3, which = grp - tm * 3;
    const int Kc = which == 2 ? 128 : 64, jb = which == 0 ? 0 : (which == 1 ? 64 : 128), cpr = Kc >> 3;
    const bf16_t* Wt = (const bf16_t*)(p.ws + (which == 0 ? OFF_W2T : (which == 1 ? OFF_A2T : OFF_G2T)));
    __syncthreads();
    for (int q = tid; q < 128 * cpr; q += NT) {
      const int r = q / cpr, ck = q - r * cpr, row = tm * 128 + r, col = 1536 + jb + ck * 8;
      const u32x4 cu = *(const u32x4*)(PR + (size_t)row * 1792 + col);
      float pc[8], pp[8];
#pragma unroll
      for (int e = 0; e < 4; ++e) { pc[2 * e] = __uint_as_float(cu[e] << 16); pc[2 * e + 1] = __uint_as_float(cu[e] & 0xffff0000u); }
      bool first; const float* sprev = nullptr;
      if (row < MP) first = (row % TP) == 0; else { const int r2 = row - MP; first = (r2 & 3) == 0; sprev = p.state_shift + (size_t)(r2 >> 2) * 1792 + col; }
      if (!first) { const u32x4 pu = *(const u32x4*)(PR + (size_t)(row - 1) * 1792 + col);
#pragma unroll
        for (int e = 0; e < 4; ++e) { pp[2 * e] = __uint_as_float(pu[e] << 16); pp[2 * e + 1] = __uint_as_float(pu[e] & 0xffff0000u); } }
      else {
#pragma unroll
        for (int e = 0; e < 8; ++e) pp[e] = sprev ? sprev[e] : 0.f;
      }
      float sv[8];
#pragma unroll
      for (int e = 0; e < 8; ++e) {
        const float pm = pc[e] + (pp[e] - pc[e]) * p.mu[col + e];
        float t;
        if (which == 0) { const float ex = __expf(-2.f * fabsf(pm)); t = (1.f - ex) / (1.f + ex); t = pm < 0.f ? -t : t; }
        else if (which == 1) t = pm;
        else t = sigmoidf(pm);
        sv[e] = t;
      }
      u32x4 o; o[0] = pk2(sv[0], sv[1]); o[1] = pk2(sv[2], sv[3]); o[2] = pk2(sv[4], sv[5]); o[3] = pk2(sv[6], sv[7]);
      *(u32x4*)(sA + r * LSTR + ck * 16) = o;
    }
    for (int tn = 0; tn < 4; ++tn) {
      if (tn > 0) __syncthreads();
      for (int q = tid; q < 128 * cpr; q += NT) { const int r = q / cpr, ck = q - r * cpr; *(u32x4*)(sB + r * LSTR + ck * 16) = *(const u32x4*)(Wt + (size_t)(tn * 128 + r) * Kc + ck * 8); }
      __syncthreads();
      f32x4 acc[4][4]; ZERO_ACC(acc);
      for (int kk = 0; kk < (Kc >> 5); ++kk) {
        bf16x8 af[4], bfr[4];
#pragma unroll
        for (int i = 0; i < 4; ++i) { af[i] = *(const bf16x8*)(sA + (wm * 64 + i * 16 + l15) * LSTR + kk * 64 + l4 * 16); bfr[i] = *(const bf16x8*)(sB + (wn * 64 + i * 16 + l15) * LSTR + kk * 64 + l4 * 16); }
#pragma unroll
        for (int mi = 0; mi < 4; ++mi)
#pragma unroll
          for (int ni = 0; ni < 4; ++ni) acc[mi][ni] = __builtin_amdgcn_mfma_f32_16x16x32_bf16(bfr[ni], af[mi], acc[mi][ni], 0, 0, 0);
      }
#pragma unroll
      for (int ni = 0; ni < 4; ++ni) {
        const int col = tn * 128 + wn * 64 + ni * 16 + l4 * 4;
        float bias[4] = {0.f, 0.f, 0.f, 0.f};
        if (which == 0) { const float4 b4 = *(const float4*)(p.w0 + col); bias[0] = b4.x; bias[1] = b4.y; bias[2] = b4.z; bias[3] = b4.w; }
        else if (which == 1) { const float4 b4 = *(const float4*)(p.a0 + col); bias[0] = b4.x; bias[1] = b4.y; bias[2] = b4.z; bias[3] = b4.w; }
#pragma unroll
        for (int mi = 0; mi < 4; ++mi) {
          const int row = tm * 128 + wm * 64 + mi * 16 + l15;
          float o[4];
#pragma unroll
          for (int jj = 0; jj < 4; ++jj) {
            const float a = acc[mi][ni][jj] + bias[jj];
            if (which == 0) o[jj] = -0.60653066f * sigmoidf(a);
            else if (which == 1) o[jj] = sigmoidf(a);
            else o[jj] = a;
          }
          bf16_t* dst = which == 0 ? LD : (which == 1 ? AA : GG);
          *(uint2*)(dst + (size_t)row * 512 + col) = pk4(o[0], o[1], o[2], o[3]);
        }
      }
    }
  }
}

struct StageRegs { uint2 cr, ck, cv, qr, qk, qv, ld, aa; };

__device__ __forceinline__ void rwkv_item(const Params& p, int rowbase, int T, int h, int rb, const float* shift_prev, const float* S_in, float* S_out, unsigned char* lds) {
  float* stage = (float*)lds;
  float* ybuf = (float*)(lds + 49152);
  const int tid = threadIdx.x, lane = tid & 63, wid = tid >> 6;
  const int t_l = tid >> 4, c4 = tid & 15, ch = h * 64 + c4 * 4;
  const int kg = lane & 15, vloc = wid * 4 + (lane >> 4), vrow = rb * 16 + vloc;
  const bf16_t* PR = (const bf16_t*)(p.ws + OFF_PR); const bf16_t* LD = (const bf16_t*)(p.ws + OFF_LD); const bf16_t* AA = (const bf16_t*)(p.ws + OFF_AA);
  bf16_t* Y = (bf16_t*)(p.ws + OFF_Y); float* RHO = (float*)((unsigned char*)p.out + OO_RHO);
  float mur[4], muk[4], muv[4], kkc[4], kac[4], rkc[4];
#pragma unroll
  for (int e = 0; e < 4; ++e) { mur[e] = p.mu[ch + e]; muk[e] = p.mu[512 + ch + e]; muv[e] = p.mu[1024 + ch + e]; kkc[e] = p.k_k[ch + e]; kac[e] = p.k_a[ch + e]; rkc[e] = p.r_k[ch + e]; }
  f32x4 S;
  if (S_in) S = *(const f32x4*)(S_in + (size_t)vrow * 64 + kg * 4); else S = (f32x4){0.f, 0.f, 0.f, 0.f};
  f32x2 Sa = S.xy, Sb = S.zw;

  auto load = [&](int t0, StageRegs& r) {
    int t = t0 + t_l; if (t > T - 1) t = T - 1;
    const bf16_t* cur = PR + (size_t)(rowbase + t) * 1792 + ch;
    r.cr = *(const uint2*)cur; r.ck = *(const uint2*)(cur + 512); r.cv = *(const uint2*)(cur + 1024);
    if (t > 0) { const bf16_t* pv = cur - 1792; r.qr = *(const uint2*)pv; r.qk = *(const uint2*)(pv + 512); r.qv = *(const uint2*)(pv + 1024); }
    else { r.qr = make_uint2(0, 0); r.qk = r.qr; r.qv = r.qr; }
    r.ld = *(const uint2*)(LD + (size_t)(rowbase + t) * 512 + ch); r.aa = *(const uint2*)(AA + (size_t)(rowbase + t) * 512 + ch);
  };
  auto process = [&](int t0, const StageRegs& r, int buf) {
    float cr[4], ck[4], cv[4], qr[4], qk[4], qv[4], ld[4], aa[4];
    unpk4(r.cr, cr); unpk4(r.ck, ck); unpk4(r.cv, cv); unpk4(r.qr, qr); unpk4(r.qk, qk); unpk4(r.qv, qv); unpk4(r.ld, ld); unpk4(r.aa, aa);
    const int t = t0 + t_l;
    if (t == 0 && shift_prev) {
#pragma unroll
      for (int e = 0; e < 4; ++e) { qr[e] = shift_prev[ch + e]; qk[e] = shift_prev[512 + ch + e]; qv[e] = shift_prev[1024 + ch + e]; }
    }
    float rr[4], k[4], v[4], kk[4], kp[4], bb[4], w[4];
    float ss = 0.f, rho = 0.f;
#pragma unroll
    for (int e = 0; e < 4; ++e) {
      rr[e] = cr[e] + (qr[e] - cr[e]) * mur[e]; k[e] = ck[e] + (qk[e] - ck[e]) * muk[e]; v[e] = cv[e] + (qv[e] - cv[e]) * muv[e];
      kk[e] = k[e] * kkc[e]; ss += kk[e] * kk[e];
      kp[e] = k[e] * (1.f + (aa[e] - 1.f) * kac[e]);
      rho += rr[e] * kp[e] * rkc[e];
      w[e] = expf(ld[e]);
    }
    ss = rowsum16(ss); rho = rowsum16(rho);
    const float inv = rsqrtf(fmaxf(ss, 1e-24f));
#pragma unroll
    for (int e = 0; e < 4; ++e) { kk[e] *= inv; bb[e] = kk[e] * aa[e]; }
    float* sp = stage + (size_t)((buf * 16 + t_l) * 6) * 64 + c4 * 4;
    *(float4*)(sp) = make_float4(rr[0], rr[1], rr[2], rr[3]);
    *(float4*)(sp + 64) = make_float4(w[0], w[1], w[2], w[3]);
    *(float4*)(sp + 128) = make_float4(kp[0], kp[1], kp[2], kp[3]);
    *(float4*)(sp + 192) = make_float4(v[0], v[1], v[2], v[3]);
    *(float4*)(sp + 256) = make_float4(-kk[0], -kk[1], -kk[2], -kk[3]);
    *(float4*)(sp + 320) = make_float4(bb[0], bb[1], bb[2], bb[3]);
    if (rb == 0 && c4 == 0 && t < T) RHO[(size_t)(rowbase + t) * 8 + h] = rho;
  };

  const int nch = (T + 15) >> 4;
  StageRegs rg;
  __syncthreads();
  load(0, rg); process(0, rg, 0);
  __syncthreads();
  for (int c = 0; c < nch; ++c) {
    const int buf = c & 1, t0 = c * 16;
    const int nsteps = min(16, T - t0);
    if (c + 1 < nch) load(t0 + 16, rg);
    const float* st = stage + (size_t)(buf * 16) * 384;
    float* yb = ybuf + buf * 256;
    for (int s0 = 0; s0 < nsteps; s0 += 4) {
#pragma unroll
      for (int u = 0; u < 4; ++u) {
        const int s = s0 + u;
        const float* sp = st + s * 384;
        const f32x4 r4 = *(const f32x4*)(sp + kg * 4), w4 = *(const f32x4*)(sp + 64 + kg * 4), kp4 = *(const f32x4*)(sp + 128 + kg * 4);
        const f32x4 nk4 = *(const f32x4*)(sp + 256 + kg * 4), b4 = *(const f32x4*)(sp + 320 + kg * 4);
        const float vv = sp[192 + vrow];
        f32x2 pa = Sa * nk4.xy; pa = Sb * nk4.zw + pa;
        float sa = rowsum16(pa.x + pa.y);
        const f32x2 sa2 = {sa, sa}, vv2 = {vv, vv};
        const f32x2 Xa = sa2 * b4.xy + vv2 * kp4.xy, Xb = sa2 * b4.zw + vv2 * kp4.zw;
        Sa = Sa * w4.xy + Xa; Sb = Sb * w4.zw + Xb;
        f32x2 ya = Sa * r4.xy; ya = Sb * r4.zw + ya;
        const float y = rowsum16(ya.x + ya.y);
        if (kg == 0) yb[s * 16 + vloc] = y;
      }
    }
    if (c + 1 < nch) process(t0 + 16, rg, buf ^ 1);
    __syncthreads();
    if (t0 + t_l < T) Y[(size_t)(rowbase + t0 + t_l) * 512 + h * 64 + rb * 16 + c4] = (bf16_t)f2bf(yb[t_l * 16 + c4]);
  }
  S.xy = Sa; S.zw = Sb;
  *(f32x4*)(S_out + (size_t)vrow * 64 + kg * 4) = S;
}

__device__ __forceinline__ void ret_item(const Params& p, int rowbase, int T, int h, const float* S_in, float* S_out, unsigned char* lds) {
  unsigned char* sQ = lds; unsigned char* sK = lds + 9216; unsigned char* sKdT = lds + 18432; unsigned char* sVT = lds + 27648; unsigned char* sP = lds + 46080; unsigned char* sST = lds + 55296;
  float* part = (float*)sK;
  const int tid = threadIdx.x, lane = tid & 63, w = tid >> 6, l15 = lane & 15, l4 = lane >> 4;
  const bf16_t* QK = (const bf16_t*)(p.ws + OFF_QK); const bf16_t* V = (const bf16_t*)(p.ws + OFF_V); bf16_t* GR = (bf16_t*)(p.ws + OFF_GR);
  const float lg2 = p.lg2g[h];
  f32x4 ST[2][4];
#pragma unroll
  for (int vt = 0; vt < 2; ++vt)
#pragma unroll
    for (int dt = 0; dt < 4; ++dt) {
      if (S_in) {
#pragma unroll
        for (int jj = 0; jj < 4; ++jj) ST[vt][dt][jj] = 0.f;
        const float4 t4 = *(const float4*)(S_in + (size_t)(dt * 16 + l15) * 128 + 32 * w + vt * 16 + l4 * 4);
        ST[vt][dt][0] = t4.x; ST[vt][dt][1] = t4.y; ST[vt][dt][2] = t4.z; ST[vt][dt][3] = t4.w;
      } else ST[vt][dt] = (f32x4){0.f, 0.f, 0.f, 0.f};
    }
  __syncthreads();
#pragma unroll
  for (int vt = 0; vt < 2; ++vt)
#pragma unroll
    for (int dt = 0; dt < 4; ++dt)
#pragma unroll
      for (int jj = 0; jj < 4; ++jj) *(bf16_t*)(sST + (32 * w + vt * 16 + l4 * 4 + jj) * 144 + (dt * 16 + l15) * 2) = (bf16_t)f2bf(ST[vt][dt][jj]);

  const int nch = (T + 63) >> 6;
  u32x4 pq[2], pk[2], pv[4];
  auto prefetch = [&](int t0n, int tidp) {
    const int Ln = min(64, T - t0n);
#pragma unroll
    for (int i = 0; i < 2; ++i) {
      const int q_ = tidp + i * 256, j = q_ & 63, ck = q_ >> 6;
      pq[i] = (u32x4){0u, 0u, 0u, 0u}; pk[i] = pq[i];
      if (j < Ln) { const bf16_t* src = QK + (size_t)(rowbase + t0n + j) * 512 + h * 64 + ck * 8; pq[i] = *(const u32x4*)src; pk[i] = *(const u32x4*)(src + 256); }
    }
#pragma unroll
    for (int i = 0; i < 4; ++i) {
      const int q_ = tidp + i * 256, j = q_ & 63, cv = q_ >> 6;
      pv[i] = (u32x4){0u, 0u, 0u, 0u};
      if (j < Ln) pv[i] = *(const u32x4*)(V + (size_t)(rowbase + t0n + j) * 512 + h * 128 + cv * 8);
    }
  };
  prefetch(0, threadIdx.x);
  for (int c = 0; c < nch; ++c) {
    const int t0 = c * 64, Lc = min(64, T - t0);
    int tid_o = threadIdx.x; asm volatile("" : "+v"(tid_o));
    const int tid = tid_o, lane = tid & 63, w = tid >> 6, l15 = lane & 15, l4 = lane >> 4;
    __syncthreads();
#pragma unroll
    for (int i = 0; i < 2; ++i) {
      const int q_ = tid + i * 256, j = q_ & 63, ck = q_ >> 6;
      const u32x4 kv = pk[i];
      *(u32x4*)(sQ + j * 144 + ck * 16) = pq[i]; *(u32x4*)(sK + j * 144 + ck * 16) = kv;
      const float kd = __builtin_amdgcn_exp2f((float)(Lc - 1 - j) * lg2);
#pragma unroll
      for (int e = 0; e < 4; ++e) {
        *(bf16_t*)(sKdT + (ck * 8 + 2 * e) * 144 + j * 2) = (bf16_t)f2bf(__uint_as_float(kv[e] << 16) * kd);
        *(bf16_t*)(sKdT + (ck * 8 + 2 * e + 1) * 144 + j * 2) = (bf16_t)f2bf(__uint_as_float(kv[e] & 0xffff0000u) * kd);
      }
    }
#pragma unroll
    for (int i = 0; i < 4; ++i) {
      const int q_ = tid + i * 256, j = q_ & 63, cv = q_ >> 6;
      const u32x4 vv = pv[i];
#pragma unroll
      for (int e = 0; e < 4; ++e) {
        *(bf16_t*)(sVT + (cv * 8 + 2 * e) * 144 + j * 2) = (bf16_t)(vv[e] & 0xffffu);
        *(bf16_t*)(sVT + (cv * 8 + 2 * e + 1) * 144 + j * 2) = (bf16_t)(vv[e] >> 16);
      }
    }
    if (c + 1 < nch) prefetch(t0 + 64, tid);
    __syncthreads();
    {
      f32x4 sc[4];
#pragma unroll
      for (int jt = 0; jt < 4; ++jt) sc[jt] = (f32x4){0.f, 0.f, 0.f, 0.f};
#pragma unroll
      for (int kk = 0; kk < 2; ++kk) {
        const bf16x8 aq = *(const bf16x8*)(sQ + (16 * w + l15) * 144 + kk * 64 + l4 * 16);
#pragma unroll
        for (int jt = 0; jt < 4; ++jt) { const bf16x8 bk = *(const bf16x8*)(sK + (jt * 16 + l15) * 144 + kk * 64 + l4 * 16); sc[jt] = __builtin_amdgcn_mfma_f32_16x16x32_bf16(aq, bk, sc[jt], 0, 0, 0); }
      }
#pragma unroll
      for (int jt = 0; jt < 4; ++jt)
#pragma unroll
        for (int jj = 0; jj < 4; ++jj) {
          const int i = 16 * w + l4 * 4 + jj, j = jt * 16 + l15;
          const float pv = i >= j ? sc[jt][jj] * __builtin_amdgcn_exp2f((float)(i - j) * lg2) : 0.f;
          *(bf16_t*)(sP + i * 144 + j * 2) = (bf16_t)f2bf(pv);
        }
    }
    __syncthreads();
    f32x4 o[4][2];
    {
      bf16x8 bV[2][2], bS[2][2];
#pragma unroll
      for (int vt = 0; vt < 2; ++vt)
#pragma unroll
        for (int kk = 0; kk < 2; ++kk) {
          bV[vt][kk] = *(const bf16x8*)(sVT + (32 * w + vt * 16 + l15) * 144 + kk * 64 + l4 * 16);
          bS[vt][kk] = *(const bf16x8*)(sST + (32 * w + vt * 16 + l15) * 144 + kk * 64 + l4 * 16);
        }
#pragma unroll
      for (int it = 0; it < 4; ++it) {
        bf16x8 aP[2], aQ[2];
#pragma unroll
        for (int kk = 0; kk < 2; ++kk) { aP[kk] = *(const bf16x8*)(sP + (it * 16 + l15) * 144 + kk * 64 + l4 * 16); aQ[kk] = *(const bf16x8*)(sQ + (it * 16 + l15) * 144 + kk * 64 + l4 * 16); }
#pragma unroll
        for (int vt = 0; vt < 2; ++vt) {
          f32x4 a1 = (f32x4){0.f, 0.f, 0.f, 0.f}, a2 = (f32x4){0.f, 0.f, 0.f, 0.f};
#pragma unroll
          for (int kk = 0; kk < 2; ++kk) { a1 = __builtin_amdgcn_mfma_f32_16x16x32_bf16(aP[kk], bV[vt][kk], a1, 0, 0, 0); a2 = __builtin_amdgcn_mfma_f32_16x16x32_bf16(aQ[kk], bS[vt][kk], a2, 0, 0, 0); }
#pragma unroll
          for (int jj = 0; jj < 4; ++jj) { const int i = it * 16 + l4 * 4 + jj; o[it][vt][jj] = a1[jj] + __builtin_amdgcn_exp2f((float)(i + 1) * lg2) * a2[jj]; }
        }
      }
      const float gl = __builtin_amdgcn_exp2f((float)Lc * lg2);
#pragma unroll
      for (int dt = 0; dt < 4; ++dt) {
        bf16x8 bK[2];
#pragma unroll
        for (int kk = 0; kk < 2; ++kk) bK[kk] = *(const bf16x8*)(sKdT + (dt * 16 + l15) * 144 + kk * 64 + l4 * 16);
#pragma unroll
        for (int vt = 0; vt < 2; ++vt) {
          f32x4 a = ST[vt][dt] * gl;
#pragma unroll
          for (int kk = 0; kk < 2; ++kk) a = __builtin_amdgcn_mfma_f32_16x16x32_bf16(bV[vt][kk], bK[kk], a, 0, 0, 0);
          ST[vt][dt] = a;
#pragma unroll
          for (int jj = 0; jj < 4; ++jj) *(bf16_t*)(sST + (32 * w + vt * 16 + l4 * 4 + jj) * 144 + (dt * 16 + l15) * 2) = (bf16_t)f2bf(a[jj]);
        }
      }
    }
    unsigned short grv[4][4][2];
#pragma unroll
    for (int it = 0; it < 4; ++it)
#pragma unroll
      for (int jj = 0; jj < 4; ++jj) {
        const int i = it * 16 + l4 * 4 + jj;
#pragma unroll
        for (int vt = 0; vt < 2; ++vt) grv[it][jj][vt] = i < Lc ? GR[(size_t)(rowbase + t0 + i) * 512 + h * 128 + 32 * w + vt * 16 + l15] : (unsigned short)0;
      }
#pragma unroll
    for (int it = 0; it < 4; ++it)
#pragma unroll
      for (int jj = 0; jj < 4; ++jj) {
        float s1 = o[it][0][jj] + o[it][1][jj], s2 = o[it][0][jj] * o[it][0][jj] + o[it][1][jj] * o[it][1][jj];
        s1 = rowsum16(s1); s2 = rowsum16(s2);
        if (l15 == 0) { const int i = it * 16 + l4 * 4 + jj; part[(w * 64 + i) * 2] = s1; part[(w * 64 + i) * 2 + 1] = s2; }
      }
    const float gn[2] = {p.ret_gn_g[h * 128 + 32 * w + l15], p.ret_gn_g[h * 128 + 32 * w + 16 + l15]};
    __syncthreads();
#pragma unroll
    for (int it = 0; it < 4; ++it)
#pragma unroll
      for (int jj = 0; jj < 4; ++jj) {
        const int i = it * 16 + l4 * 4 + jj;
        float s1 = 0.f, s2 = 0.f;
#pragma unroll
        for (int ww = 0; ww < 4; ++ww) { s1 += part[(ww * 64 + i) * 2]; s2 += part[(ww * 64 + i) * 2 + 1]; }
        const float mean = s1 * (1.f / 128.f), var = fmaxf(s2 * (1.f / 128.f) - mean * mean, 0.f), rstd = rsqrtf(var + 1e-6f);
        if (i < Lc) {
#pragma unroll
          for (int vt = 0; vt < 2; ++vt) {
            const int v = 32 * w + vt * 16 + l15;
            bf16_t* gp = GR + (size_t)(rowbase + t0 + i) * 512 + h * 128 + v;
            *gp = (bf16_t)f2bf((o[it][vt][jj] - mean) * rstd * gn[vt] * bf2f(grv[it][jj][vt]));
          }
        }
      }
  }
#pragma unroll
  for (int vt = 0; vt < 2; ++vt)
#pragma unroll
    for (int dt = 0; dt < 4; ++dt)
      *(float4*)(S_out + (size_t)(dt * 16 + l15) * 128 + 32 * w + vt * 16 + l4 * 4) = make_float4(ST[vt][dt][0], ST[vt][dt][1], ST[vt][dt][2], ST[vt][dt][3]);
}

__device__ __forceinline__ void phase_scan(const Params& p, unsigned char* lds) {
  const int G = gridDim.x;
  int lb, ln;
  if (G >= 352) { lb = (int)blockIdx.x - 288; ln = G - 288; } else { lb = blockIdx.x; ln = G; }
  int hid = blockIdx.x, lid = lb;
  bool heavy = true;
#pragma unroll 1
  while (true) {
    int item;
    if (heavy) { if (hid < 288) { item = hid; hid += G; } else { heavy = false; continue; } }
    else { if (lid >= 0 && lid < 4608) { item = 288 + lid; lid += ln; } else break; }
    bool is_rwkv; int rowbase, T, h, rb = 0; const float* shp = nullptr; const float* sin = nullptr; float* sout;
    if (item < 256) { const int seq = item >> 2, b = seq >> 3; rb = item & 3; h = seq & 7; is_rwkv = true; rowbase = b * TP; T = TP; sout = p.out + O_WKVP + (size_t)seq * 4096; }
    else if (item < 288) { const int bh = item - 256, b = bh >> 2; h = bh & 3; is_rwkv = false; rowbase = b * TP; T = TP; sout = p.out + O_RETP + (size_t)bh * 8192; }
    else if (item < 288 + 4096) { const int it = item - 288, seq = it >> 2, b = seq >> 3; rb = it & 3; h = seq & 7; is_rwkv = true; rowbase = MP + b * 4; T = 4;
      shp = p.state_shift + (size_t)b * 1792; sin = p.state_wkv + (size_t)seq * 4096; sout = p.out + O_WKVS + (size_t)seq * 4096; }
    else { const int bh = item - 288 - 4096, b = bh >> 2; h = bh & 3; is_rwkv = false; rowbase = MP + b * 4; T = 4; sin = p.state_ret + (size_t)bh * 8192; sout = p.out + O_RETS + (size_t)bh * 8192; }
    if (is_rwkv) { rwkv_item(p, rowbase, T, h, rb, shp, sin, sout, lds); if (DUP6) rwkv_item(p, rowbase, T, h, rb, shp, sin, sout, lds); }
    else ret_item(p, rowbase, T, h, sin, sout, lds);
  }
}

__device__ __forceinline__ void phase_post(const Params& p, unsigned char* lds) {
  transpose_jobs(p, 7, 10, lds);
  const int tid = threadIdx.x, h = (tid >> 4) & 7, c4 = tid & 15, ch = h * 64 + c4 * 4;
  bf16_t* Y = (bf16_t*)(p.ws + OFF_Y); const bf16_t* PR = (const bf16_t*)(p.ws + OFF_PR);
  const bf16_t* GG = (const bf16_t*)((unsigned char*)p.out + OO_GG); const float* RHO = (const float*)((unsigned char*)p.out + OO_RHO);
  float muv[4], lg[4], lb[4];
#pragma unroll
  for (int e = 0; e < 4; ++e) { muv[e] = p.mu[1024 + ch + e]; lg[e] = p.lnx_g[ch + e]; lb[e] = p.lnx_b[ch + e]; }
  for (int pr = blockIdx.x; pr < M_TOK / 2; pr += gridDim.x) {
    const int row = pr * 2 + (tid >> 7);
    float y[4], cv[4], qv[4], g[4];
    unpk4(*(const uint2*)(Y + (size_t)row * 512 + ch), y);
    unpk4(*(const uint2*)(PR + (size_t)row * 1792 + 1024 + ch), cv);
    unpk4(*(const uint2*)(GG + (size_t)row * 512 + ch), g);
    bool first; const float* sprev = nullptr;
    if (row < MP) first = (row % TP) == 0; else { const int r2 = row - MP; first = (r2 & 3) == 0; sprev = p.state_shift + (size_t)(r2 >> 2) * 1792 + 1024 + ch; }
    if (!first) unpk4(*(const uint2*)(PR + (size_t)(row - 1) * 1792 + 1024 + ch), qv);
    else {
#pragma unroll
      for (int e = 0; e < 4; ++e) qv[e] = sprev ? sprev[e] : 0.f;
    }
    const float rho = RHO[(size_t)row * 8 + h];
    float s = y[0] + y[1] + y[2] + y[3]; s = rowsum16(s);
    const float mean = s * (1.f / 64.f);
    float d[4], q = 0.f;
#pragma unroll
    for (int e = 0; e < 4; ++e) { d[e] = y[e] - mean; q += d[e] * d[e]; }
    q = rowsum16(q);
    const float rstd = rsqrtf(q * (1.f / 64.f) + 64e-5f);
    float o[4];
#pragma unroll
    for (int e = 0; e < 4; ++e) { const float v = cv[e] + (qv[e] - cv[e]) * muv[e]; o[e] = (d[e] * rstd * lg[e] + lb[e] + rho * v) * g[e]; }
    *(uint2*)(Y + (size_t)row * 512 + ch) = pk4(o[0], o[1], o[2], o[3]);
  }
}

__device__ __forceinline__ void phase_merge(const Params& p, unsigned char* lds) {
  const bf16_t* OR = (const bf16_t*)(p.ws + OFF_GR); const bf16_t* OW = (const bf16_t*)(p.ws + OFF_Y);
  const bf16_t* WR = (const bf16_t*)(p.ws + OFF_WR); const bf16_t* WWp = (const bf16_t*)(p.ws + OFF_WW);
  const bf16_t* GA = (const bf16_t*)((unsigned char*)p.out + OO_GA); const bf16_t* GB = (const bf16_t*)(p.ws + OFF_GB);
  bf16_t* MG = (bf16_t*)(p.ws + OFF_MG);
  const int nM = NMT, nN = 8;
  for (int L = blockIdx.x; L < nM * nN; L += gridDim.x) {
    int tm, tn; tile_coords(L, nM, nN, tm, tn);
    f32x4 acc[8][4]; ZERO_ACC8(acc);
    gemm_tile_dma(OR, 512, WR, 512, 512, tm * 256, tn * 128, acc, lds);
    EPI_VARS8;
#pragma unroll
    for (int mi = 0; mi < 8; ++mi) {
      const int row = rbase + mi * 16;
      if (row < M_TOK) {
#pragma unroll
        for (int ni = 0; ni < 4; ++ni) { float g[4]; unpk4(*(const uint2*)(GA + (size_t)row * 1024 + cbase + ni * 16), g);
          *(uint2*)(MG + (size_t)row * 1024 + cbase + ni * 16) = pk4(acc[mi][ni][0] * g[0], acc[mi][ni][1] * g[1], acc[mi][ni][2] * g[2], acc[mi][ni][3] * g[3]); }
      }
    }
    ZERO_ACC8(acc);
    gemm_tile_dma(OW, 512, WWp, 512, 512, tm * 256, tn * 128, acc, lds);
#pragma unroll
    for (int mi = 0; mi < 8; ++mi) {
      const int row = rbase + mi * 16;
      if (row < M_TOK) {
#pragma unroll
        for (int ni = 0; ni < 4; ++ni) { float g[4], t[4]; unpk4(*(const uint2*)(GB + (size_t)row * 1024 + cbase + ni * 16), g);
          uint2* mp = (uint2*)(MG + (size_t)row * 1024 + cbase + ni * 16); unpk4(*mp, t);
          *mp = pk4(t[0] + acc[mi][ni][0] * g[0], t[1] + acc[mi][ni][1] * g[1], t[2] + acc[mi][ni][2] * g[2], t[3] + acc[mi][ni][3] * g[3]); }
      }
    }
  }
}

__device__ __forceinline__ void phase_wout(const Params& p, unsigned char* lds) {
  const bf16_t* A = (const bf16_t*)(p.ws + OFF_MG); const bf16_t* W = (const bf16_t*)(p.ws + OFF_WO); bf16_t* H = (bf16_t*)(p.ws + OFF_H);
  const int nM = NMT, nN = 8;
  for (int L = blockIdx.x; L < nM * nN; L += gridDim.x) {
    int tm, tn; tile_coords(L, nM, nN, tm, tn);
    f32x4 acc[8][4]; ZERO_ACC8(acc);
    gemm_tile_dma(A, 1024, W, 1024, 1024, tm * 256, tn * 128, acc, lds);
    EPI_VARS8;
#pragma unroll
    for (int mi = 0; mi < 8; ++mi) {
      const int row = rbase + mi * 16;
      if (row < M_TOK) {
#pragma unroll
        for (int ni = 0; ni < 4; ++ni) { bf16_t* hp = H + (size_t)row * 1024 + cbase + ni * 16; float h[4]; unpk4(*(const uint2*)hp, h); const f32x4 a = acc[mi][ni];
          *(uint2*)hp = pk4(h[0] + a[0], h[1] + a[1], h[2] + a[2], h[3] + a[3]); }
      }
    }
  }
}

__global__ void __launch_bounds__(256, 2) mega(Params p) {
  extern __shared__ __attribute__((aligned(16))) unsigned char lds[];
  cg::grid_group grid = cg::this_grid();
  const int lo = p.phase_lo, hi = p.phase_hi;
  __shared__ uint4 xb_words;
  if (threadIdx.x == 0) xb_words = make_uint4(0u, 0u, 0u, 0u);
  __syncthreads();
  XcdBarrier xb = xcd_barrier_post((unsigned*)(p.ws + OFF_BAR), (volatile LAS unsigned*)&xb_words);
  if (hi > 1000) grid.sync();
#define RUN_PHASE(k, call) if (PEN(k) && lo <= (k) && (k) < hi) { if ((k) > lo) xcd_barrier(xb); call; if (((DUPMASK) >> (k)) & 1) { call; } }
  RUN_PHASE(0, phase0(p, lds))
  RUN_PHASE(1, phase_ffn_up(p, lds))
  RUN_PHASE(2, phase_ffn_down<true>(p, lds))
  RUN_PHASE(3, (rmsnorm_phase<1, 0>(p, p.mix_norm, (bf16_t*)(p.ws + OFF_A))))
  RUN_PHASE(4, phase_win(p, lds))
  RUN_PHASE(5, phase_lora_mfma(p, lds))
  RUN_PHASE(6, phase_scan(p, lds))
  RUN_PHASE(7, phase_post(p, lds))
  RUN_PHASE(8, phase_merge(p, lds))
  RUN_PHASE(9, phase_wout(p, lds))
  RUN_PHASE(10, (rmsnorm_phase<1, 0>(p, p.ffn2_norm, (bf16_t*)(p.ws + OFF_A))))
  RUN_PHASE(11, phase_ffn_up(p, lds))
  RUN_PHASE(12, phase_ffn_down<false>(p, lds))
  RUN_PHASE(13, (rmsnorm_phase<2, 1>(p, p.final_norm, nullptr)))
}

extern "C" void kernel_launch(void* const* d_in, const int* in_sizes, int n_in, void* d_out, int out_size, void* d_ws, size_t ws_size, hipStream_t stream) {
  static int grid_blocks = 0;
  if (grid_blocks == 0) {
    if (n_in != 32 || ws_size < WS_NEED || out_size != 26458112) { fprintf(stderr, "kernel_launch: unexpected sizes n_in %d ws %zu out %d\n", n_in, ws_size, out_size); grid_blocks = -1; return; }
    int dev = 0, cus = 0, per_cu = 0;
    hipGetDevice(&dev);
    hipDeviceGetAttribute(&cus, hipDeviceAttributeMultiprocessorCount, dev);
    if (hipFuncSetAttribute((const void*)mega, hipFuncAttributeMaxDynamicSharedMemorySize, LDS_BYTES) != hipSuccess) { fprintf(stderr, "hipFuncSetAttribute failed\n"); grid_blocks = -1; return; }
    hipOccupancyMaxActiveBlocksPerMultiprocessor(&per_cu, (const void*)mega, NT, LDS_BYTES);
    if (per_cu < 1) { fprintf(stderr, "occupancy query returned %d\n", per_cu); grid_blocks = -1; return; }
    if (per_cu > 2) per_cu = 2;
    grid_blocks = cus * per_cu;
  }
  if (grid_blocks < 0) return;
  if (hipMemsetAsync((unsigned char*)d_ws + OFF_BAR, 0, 16384, stream) != hipSuccess) { fprintf(stderr, "memset failed\n"); return; }
  Params p{};
  const float** pp = (const float**)&p;
  for (int i = 0; i < 32; ++i) pp[i] = (const float*)d_in[i];
  p.out = (float*)d_out; p.ws = (unsigned char*)d_ws;
  for (int j = 0; j < 32; ++j) p.invf[j] = (float)pow(10000.0, -(double)j / 32.0);
  for (int h = 0; h < 4; ++h) p.lg2g[h] = (float)log2(1.0 - exp2(-5.0 - (double)h));
#if SINGLE_LAUNCH
  p.phase_lo = 0; p.phase_hi = NPHASE;
  void* args[] = {&p};
  hipError_t e = hipLaunchCooperativeKernel((const void*)mega, dim3(grid_blocks), dim3(NT), args, LDS_BYTES, stream);
  if (e != hipSuccess) fprintf(stderr, "cooperative launch failed: %s (grid %d)\n", hipGetErrorString(e), grid_blocks);
#else
  for (int ph = 0; ph < NPHASE; ++ph) {
    p.phase_lo = ph; p.phase_hi = ph + 1;
    hipLaunchKernelGGL(mega, dim3(grid_blocks), dim3(NT), LDS_BYTES, stream, p);
  }
#endif
}
```

```cpp
#include <hip/hip_runtime.h>
#include <hip/hip_cooperative_groups.h>
#include <cstdio>
#include <cmath>
namespace cg = cooperative_groups;

#ifndef PHMASK
#define PHMASK 0xffff
#endif
#define PEN(k) (((PHMASK) >> (k)) & 1)
#ifndef DUPMASK
#define DUPMASK 0
#endif
#ifndef DUP6
#define DUP6 3
#endif
#ifndef SINGLE_LAUNCH
#define SINGLE_LAUNCH 1
#endif

typedef unsigned short bf16_t;
typedef short bf16x8 __attribute__((ext_vector_type(8)));
typedef float f32x4 __attribute__((ext_vector_type(4)));
typedef unsigned u32x4 __attribute__((ext_vector_type(4)));
typedef float f32x2 __attribute__((ext_vector_type(2)));

constexpr int NT = 256;
constexpr int M_TOK = 17024, MP = 16512, TP = 2064;
constexpr int PAST = 16384;
constexpr int LDS_BYTES = 73728;
constexpr int NPHASE = 14;

constexpr size_t S1024 = (size_t)M_TOK * 1024 * 2;
constexpr size_t S512 = S1024 / 2;
constexpr size_t OFF_W1GU = 0;
constexpr size_t OFF_W1D = OFF_W1GU + 11534336;
constexpr size_t OFF_WIN = OFF_W1D + 5767168;
constexpr size_t OFF_WR = OFF_WIN + 11010048;
constexpr size_t OFF_WW = OFF_WR + 1048576;
constexpr size_t OFF_WO = OFF_WW + 1048576;
constexpr size_t OFF_H = OFF_WO + 2097152;
constexpr size_t OFF_T = OFF_H + S1024;
constexpr size_t OFF_A = OFF_T;
constexpr size_t OFF_HF = OFF_T + S1024;
constexpr size_t OFF_QK = OFF_HF;
constexpr size_t OFF_V = OFF_QK + S512;
constexpr size_t OFF_GR = OFF_V + S512;
constexpr size_t OFF_PR = OFF_GR + S512;
constexpr size_t OFF_GB = OFF_PR + (size_t)M_TOK * 1792 * 2;
constexpr size_t OFF_Y = OFF_GB + S1024;
constexpr size_t OFF_END = OFF_Y + S512;
constexpr size_t OFF_MG = OFF_QK;
constexpr size_t OFF_BAR = OFF_END;
constexpr size_t OFF_W2T = OFF_BAR + 16384, OFF_A2T = OFF_W2T + 65536, OFF_G2T = OFF_A2T + 65536;
constexpr size_t WS_NEED = OFF_G2T + 131072;
constexpr size_t OFF_H3 = OFF_HF + (size_t)M_TOK * 2816 * 2;
constexpr size_t OFF_LD = OFF_A, OFF_AA = OFF_A + S512;
static_assert(OFF_H3 + (size_t)M_TOK * 1024 * 4 == OFF_END, "map");
constexpr size_t OO_GA = 0, OO_GG = S1024, OO_RHO = S1024 + S512;
constexpr size_t O_YP = 0, O_YS = 16777216, O_RETP = 17301504, O_WKVP = 17563648, O_SHP = 17825792, O_RETS = 17840128, O_WKVS = 22034432, O_SHS = 26228736;

struct Params {
  const float *x_prompt, *x_sample, *state_ret, *state_wkv, *state_shift, *meta;
  const float *ffn1_norm, *ffn1_wg, *ffn1_wu, *ffn1_wd, *mix_norm, *w_in, *ret_gn_g, *mu, *w0, *w2, *a0, *a2, *g2, *k_k, *k_a, *r_k, *lnx_g, *lnx_b;
  const float *w_out_ret, *w_out_rwkv, *w_out, *ffn2_norm, *ffn2_wg, *ffn2_wu, *ffn2_wd, *final_norm;
  float* out;
  unsigned char* ws;
  float invf[32];
  float lg2g[4];
  int phase_lo, phase_hi;
};


#define XB_TMO      128
#define XB_XCNT(j)  (256  + 64 * (j))
#define XB_XSUB(j)  (1280 + 64 * (j))
#define XB_XGEN(j)  (2304 + 64 * (j))
#define XB_TOP      3328
#define XB_TOPGEN   3392
#define XCD_BAR_WORDS 3456
#define XB_SPIN_CAP (1u << 18)
#define LAS __attribute__((address_space(3)))
__device__ __forceinline__ unsigned xb_ld(unsigned* p)              { return __hip_atomic_load(p, __ATOMIC_RELAXED, __HIP_MEMORY_SCOPE_AGENT); }
__device__ __forceinline__ unsigned xb_add(unsigned* p, unsigned v) { return __hip_atomic_fetch_add(p, v, __ATOMIC_RELAXED, __HIP_MEMORY_SCOPE_AGENT); }
__device__ __forceinline__ unsigned xb_xcc_id() { return (unsigned)__builtin_amdgcn_s_getreg((3 << 11) | 20) & 0xFu; }
#define XB_SPIN(cond, bar) do { unsigned _sp = 0; while (cond) { __builtin_amdgcn_s_sleep(1); \
    if ((++_sp & 255u) == 0u) { if (xb_ld(&(bar)[XB_TMO])) break; if (_sp > XB_SPIN_CAP) { atomicAdd(&(bar)[XB_TMO], 1u); break; } } } } while (0)
struct XcdBarrier { unsigned* bar; unsigned x; volatile LAS unsigned* st; };
__device__ __forceinline__ XcdBarrier xcd_barrier_post(unsigned* bar, volatile LAS unsigned* st) {
    XcdBarrier b; b.bar = bar; b.x = xb_xcc_id(); b.st = st;
    if (threadIdx.x == 0) (void)xb_add(&bar[XB_XCNT(b.x)], 1u);
    return b;
}
__device__ __forceinline__ void xcd_barrier_complete(unsigned* bar, unsigned x, unsigned& nloc, unsigned& nx) {
    const unsigned G = gridDim.x * gridDim.y * gridDim.z;
    unsigned sum, cnt, mine, sp = 0u;
    for (;;) {
        sum = 0u; cnt = 0u; mine = 0u;
#pragma unroll
        for (unsigned j = 0; j < 16; ++j) { const unsigned c = xb_ld(&bar[XB_XCNT(j)]); sum += c; cnt += (c > 0u) ? 1u : 0u; mine = (j == x) ? c : mine; }
        if (sum == G) break;
        __builtin_amdgcn_s_sleep(1);
        if ((++sp & 255u) == 0u) { if (xb_ld(&bar[XB_TMO])) break; if (sp > XB_SPIN_CAP) { atomicAdd(&bar[XB_TMO], 1u); break; } }
    }
    nloc = mine > 0u ? mine : 1u; nx = cnt > 0u ? cnt : 1u;
}
__device__ __forceinline__ void xcd_barrier(const XcdBarrier& b) {
    asm volatile("s_waitcnt vmcnt(0)" ::: "memory");
    __syncthreads();
    if (threadIdx.x == 0) {
        unsigned* bar = b.bar;
        __builtin_amdgcn_s_waitcnt(0);
        unsigned nloc = b.st[0], nx = b.st[1];
        if (nloc == 0u) { xcd_barrier_complete(bar, b.x, nloc, nx); b.st[0] = nloc; b.st[1] = nx; }
        const unsigned old = xb_add(&bar[XB_XSUB(b.x)], 1u);
        const unsigned gen = old / nloc;
        if (old + 1u == (gen + 1u) * nloc) {
            __builtin_amdgcn_fence(__ATOMIC_RELEASE, "agent");
            asm volatile("s_waitcnt vmcnt(0)" ::: "memory");
            const unsigned og = xb_add(&bar[XB_TOP], 1u);
            const unsigned tg = og / nx;
            if (og + 1u == (tg + 1u) * nx) xb_add(&bar[XB_TOPGEN], 1u);
            else XB_SPIN(xb_ld(&bar[XB_TOPGEN]) == tg, bar);
            __builtin_amdgcn_fence(__ATOMIC_ACQUIRE, "agent");
            xb_add(&bar[XB_XGEN(b.x)], 1u);
            asm volatile("s_waitcnt vmcnt(0)" ::: "memory");
        } else {
            XB_SPIN(xb_ld(&bar[XB_XGEN(b.x)]) == gen, bar);
            __builtin_amdgcn_fence(__ATOMIC_ACQUIRE, "agent");
            asm volatile("s_waitcnt vmcnt(0)" ::: "memory");
        }
    }
    __syncthreads();
}

__device__ __forceinline__ float bf2f(unsigned h) { return __uint_as_float(h << 16); }
__device__ __forceinline__ unsigned f2bf(float f) { unsigned u = __float_as_uint(f); return (u + 0x7fffu + ((u >> 16) & 1u)) >> 16; }
__device__ __forceinline__ unsigned pk2(float a, float b) { return f2bf(a) | (f2bf(b) << 16); }
__device__ __forceinline__ uint2 pk4(float a, float b, float c, float d) { uint2 r; r.x = pk2(a, b); r.y = pk2(c, d); return r; }
__device__ __forceinline__ void unpk4(uint2 u, float (&o)[4]) { o[0] = __uint_as_float(u.x << 16); o[1] = __uint_as_float(u.x & 0xffff0000u); o[2] = __uint_as_float(u.y << 16); o[3] = __uint_as_float(u.y & 0xffff0000u); }
template <int CTRL> __device__ __forceinline__ float dppf(float x) { return __builtin_bit_cast(float, __builtin_amdgcn_update_dpp(0, __builtin_bit_cast(int, x), CTRL, 0xf, 0xf, true)); }
__device__ __forceinline__ float rowsum16(float x) { x += dppf<0xB1>(x); x += dppf<0x4E>(x); x += dppf<0x141>(x); x += dppf<0x140>(x); return x; }
__device__ __forceinline__ float wavesum(float x) {
#pragma unroll
  for (int o = 32; o >= 1; o >>= 1) x += __shfl_xor(x, o);
  return x;
}
__device__ __forceinline__ float sigmoidf(float x) { return 1.f / (1.f + __expf(-x)); }
__device__ __forceinline__ float siluf(float x) { return x / (1.f + __expf(-x)); }

__device__ __forceinline__ const float* x_row(const Params& p, int row) {
  if (row < MP) { const int b = row / TP, t = row - b * TP; return t < 16 ? p.meta + t * 1024 : p.x_prompt + (size_t)(b * 2048 + t - 16) * 1024; }
  return p.x_sample + (size_t)(row - MP) * 1024;
}

__device__ __forceinline__ void transpose_tile(const float* __restrict__ src, int K, int N, bf16_t* __restrict__ dst, int rs, int ro, int t, unsigned char* lds) {
  float* tile = (float*)lds;
  const int tid = threadIdx.x;
  const int tn = N / 64;
  const int k0 = (t / tn) * 64, n0 = (t % tn) * 64;
  __syncthreads();
  { const int n = tid & 63, kq = tid >> 6;
#pragma unroll
    for (int i = 0; i < 16; ++i) { const int k = kq + 4 * i; tile[k * 65 + n] = src[(size_t)(k0 + k) * N + n0 + n]; } }
  __syncthreads();
  { const int kp = tid & 31, nq = tid >> 5;
#pragma unroll
    for (int i = 0; i < 8; ++i) { const int n = nq + 8 * i; const float v0 = tile[(2 * kp) * 65 + n], v1 = tile[(2 * kp + 1) * 65 + n];
      *(unsigned*)(dst + (size_t)((n0 + n) * rs + ro) * K + k0 + 2 * kp) = pk2(v0, v1); } }
}
__device__ __forceinline__ void transpose_tiles(const float* __restrict__ src, int K, int N, bf16_t* __restrict__ dst, int rs, int ro, unsigned char* lds) {
  const int nt = (K / 64) * (N / 64);
#pragma unroll 1
  for (int t = blockIdx.x; t < nt; t += gridDim.x) transpose_tile(src, K, N, dst, rs, ro, t, lds);
}

template <int SRC, int DST> __device__ __forceinline__ void rmsnorm_phase(const Params& p, const float* __restrict__ g, bf16_t* dstb) {
  const int lane = threadIdx.x & 63, wid = threadIdx.x >> 6;
  const bf16_t* H = (const bf16_t*)(p.ws + OFF_H);
  const float* H3 = (const float*)(p.ws + OFF_H3);
  for (int row = blockIdx.x * 4 + wid; row < M_TOK; row += gridDim.x * 4) {
    float v[16];
    const float* xr = SRC == 0 ? x_row(p, row) : nullptr;
#pragma unroll
    for (int i = 0; i < 4; ++i) {
      const int col = i * 256 + lane * 4;
      if (SRC == 0) { const float4 t = *(const float4*)(xr + col); v[4 * i] = t.x; v[4 * i + 1] = t.y; v[4 * i + 2] = t.z; v[4 * i + 3] = t.w; }
      else if (SRC == 1) { const uint2 u = *(const uint2*)(H + (size_t)row * 1024 + col); float o[4]; unpk4(u, o); v[4 * i] = o[0]; v[4 * i + 1] = o[1]; v[4 * i + 2] = o[2]; v[4 * i + 3] = o[3]; }
      else { const float4 t = *(const float4*)(H3 + (size_t)row * 1024 + col); v[4 * i] = t.x; v[4 * i + 1] = t.y; v[4 * i + 2] = t.z; v[4 * i + 3] = t.w; }
    }
    float ss = 0.f;
#pragma unroll
    for (int i = 0; i < 16; ++i) ss += v[i] * v[i];
    ss = wavesum(ss);
    const float rstd = rsqrtf(ss * (1.f / 1024.f) + 1e-6f);
    float* orow = nullptr;
    if (DST == 1) {
      if (row < MP) { const int b = row / TP, t = row - b * TP; if (t >= 16) orow = p.out + O_YP + (size_t)(b * 2048 + t - 16) * 1024; }
      else orow = p.out + O_YS + (size_t)(row - MP) * 1024;
    }
#pragma unroll
    for (int i = 0; i < 4; ++i) {
      const int col = i * 256 + lane * 4;
      const float4 gv = *(const float4*)(g + col);
      const float y0 = v[4 * i] * rstd * gv.x, y1 = v[4 * i + 1] * rstd * gv.y, y2 = v[4 * i + 2] * rstd * gv.z, y3 = v[4 * i + 3] * rstd * gv.w;
      if (DST == 0) *(uint2*)(dstb + (size_t)row * 1024 + col) = pk4(y0, y1, y2, y3);
      else if (orow) *(float4*)(orow + col) = make_float4(y0, y1, y2, y3);
    }
  }
}

#define RAW_BARRIER() do { asm volatile("s_waitcnt lgkmcnt(0)" ::: "memory"); __builtin_amdgcn_s_barrier(); asm volatile("" ::: "memory"); } while (0)
__device__ __forceinline__ void gemm_tile_dma(const bf16_t* __restrict__ A, int lda, const bf16_t* __restrict__ Bt, int ldb, int K, int m0, int n0, f32x4 (&acc)[8][4], unsigned char* lds) {
  const int tid = threadIdx.x, lane = tid & 63, wid = tid >> 6, wm = wid >> 1, wn = wid & 1, l15 = lane & 15, l4 = lane >> 4;
  const int nk = K >> 5;
  const int qd = (lane >> 4) & 3, cs = ((lane & 3) ^ (((qd << 1) ^ ((qd >> 1) * 3)) & 3)) * 8;
  const bf16_t* ag[4]; const bf16_t* bg[2];
#pragma unroll
  for (int i = 0; i < 4; ++i) { int row = m0 + (wid * 4 + i) * 16 + (lane >> 2); row = row < M_TOK ? row : M_TOK - 1; ag[i] = A + (size_t)row * lda + cs; }
#pragma unroll
  for (int i = 0; i < 2; ++i) { const int row = n0 + (wid * 2 + i) * 16 + (lane >> 2); bg[i] = Bt + (size_t)row * ldb + cs; }
  auto issue = [&](int kt, int buf) {
    unsigned char* sb = lds + buf * 24576 + lane * 16;
#pragma unroll
    for (int i = 0; i < 4; ++i) __builtin_amdgcn_global_load_lds((const unsigned*)(ag[i] + kt * 32), (LAS unsigned*)(sb + (wid * 4 + i) * 1024), 16, 0, 0);
#pragma unroll
    for (int i = 0; i < 2; ++i) __builtin_amdgcn_global_load_lds((const unsigned*)(bg[i] + kt * 32), (LAS unsigned*)(sb + 16384 + (wid * 2 + i) * 1024), 16, 0, 0);
  };
  const int qr = (l15 >> 2) & 3, sw = ((l4 ^ ((qr << 1) ^ ((qr >> 1) * 3))) & 3) * 16;
  const int aofs = (wm * 128 + l15) * 64 + sw, bofs = 16384 + (wn * 64 + l15) * 64 + sw;
  RAW_BARRIER();
  issue(0, 0);
  if (nk > 1) issue(1, 1);
  int bc = 0, bi = 2;
  for (int kt = 0; kt < nk; ++kt) {
    if (kt + 1 < nk) asm volatile("s_waitcnt vmcnt(6)" ::: "memory"); else asm volatile("s_waitcnt vmcnt(0)" ::: "memory");
    RAW_BARRIER();
    if (kt + 2 < nk) issue(kt + 2, bi);
    const unsigned char* st = lds + bc * 24576;
    bf16x8 af[8], bfr[4];
#pragma unroll
    for (int i = 0; i < 8; ++i) af[i] = *(const bf16x8*)(st + aofs + i * 1024);
#pragma unroll
    for (int i = 0; i < 4; ++i) bfr[i] = *(const bf16x8*)(st + bofs + i * 1024);
#pragma unroll
    for (int mi = 0; mi < 8; ++mi)
#pragma unroll
      for (int ni = 0; ni < 4; ++ni) acc[mi][ni] = __builtin_amdgcn_mfma_f32_16x16x32_bf16(bfr[ni], af[mi], acc[mi][ni], 0, 0, 0);
    bc = bc == 2 ? 0 : bc + 1; bi = bi == 2 ? 0 : bi + 1;
  }
}

#ifndef GMT
#define GMT 4
#endif
__device__ __forceinline__ void tile_coords(int L, int nM, int nN, int& tm, int& tn) {
  const int nwg = nM * nN, q = nwg / 8, r = nwg % 8, xcd = L % 8, off = L / 8;
  const int wg = (xcd < r ? xcd * (q + 1) : r * (q + 1) + (xcd - r) * q) + off;
  const int nig = GMT * nN, gid = wg / nig, fm = gid * GMT, gsz = min(nM - fm, GMT);
  tm = fm + (wg % nig) % gsz; tn = (wg % nig) / gsz;
}

#define ZERO_ACC(a) _Pragma("unroll") for (int _i = 0; _i < 4; ++_i) _Pragma("unroll") for (int _j = 0; _j < 4; ++_j) a[_i][_j] = (f32x4){0.f, 0.f, 0.f, 0.f}
#define ZERO_ACC8(a) _Pragma("unroll") for (int _i = 0; _i < 8; ++_i) _Pragma("unroll") for (int _j = 0; _j < 4; ++_j) a[_i][_j] = (f32x4){0.f, 0.f, 0.f, 0.f}
#define EPI_VARS8 const int lane = threadIdx.x & 63, wid = threadIdx.x >> 6, wm = wid >> 1, wn = wid & 1; const int rbase = tm * 256 + wm * 128 + (lane & 15), cbase = tn * 128 + wn * 64 + (lane >> 4) * 4
#define NMT 67
#define EPI_VARS const int lane = threadIdx.x & 63, wid = threadIdx.x >> 6, wm = wid >> 1, wn = wid & 1; const int rbase = tm * 128 + wm * 64 + (lane & 15), cbase = tn * 128 + wn * 64 + (lane >> 4) * 4

__device__ __forceinline__ void transpose_jobs(const Params& p, int jlo, int jhi, unsigned char* lds) {
  unsigned char* ws = p.ws;
#pragma unroll 1
  for (int j = jlo; j < jhi; ++j) {
    const float* src; int K, N, rs = 1, ro = 0; size_t off;
    switch (j) {
      case 0: src = p.ffn1_wg; K = 1024; N = 2816; off = OFF_W1GU; rs = 2; break;
      case 1: src = p.ffn1_wu; K = 1024; N = 2816; off = OFF_W1GU; rs = 2; ro = 1; break;
      case 2: src = p.ffn1_wd; K = 2816; N = 1024; off = OFF_W1D; break;
      case 3: src = p.w_in; K = 1024; N = 5376; off = OFF_WIN; break;
      case 4: src = p.w_out_ret; K = 512; N = 1024; off = OFF_WR; break;
      case 5: src = p.w_out_rwkv; K = 512; N = 1024; off = OFF_WW; break;
      case 6: src = p.w_out; K = 1024; N = 1024; off = OFF_WO; break;
      case 7: src = p.ffn2_wg; K = 1024; N = 2816; off = OFF_W1GU; rs = 2; break;
      case 8: src = p.ffn2_wu; K = 1024; N = 2816; off = OFF_W1GU; rs = 2; ro = 1; break;
      case 9: src = p.ffn2_wd; K = 2816; N = 1024; off = OFF_W1D; break;
      case 10: src = p.w2; K = 64; N = 512; off = OFF_W2T; break;
      case 11: src = p.a2; K = 64; N = 512; off = OFF_A2T; break;
      default: src = p.g2; K = 128; N = 512; off = OFF_G2T; break;
    }
    transpose_tiles(src, K, N, (bf16_t*)(ws + off), rs, ro, lds);
  }
}
__device__ __forceinline__ void phase0(const Params& p, unsigned char* lds) {
  transpose_jobs(p, 0, 7, lds);
  transpose_jobs(p, 10, 13, lds);
  rmsnorm_phase<0, 0>(p, p.ffn1_norm, (bf16_t*)(p.ws + OFF_A));
}

__device__ __forceinline__ void phase_ffn_up(const Params& p, unsigned char* lds) {
  const bf16_t* A = (const bf16_t*)(p.ws + OFF_A); const bf16_t* W = (const bf16_t*)(p.ws + OFF_W1GU); bf16_t* HF = (bf16_t*)(p.ws + OFF_HF);
  const int nM = NMT, nN = 5632 / 128;
  for (int L = blockIdx.x; L < nM * nN; L += gridDim.x) {
    int tm, tn; tile_coords(L, nM, nN, tm, tn);
    f32x4 acc[8][4]; ZERO_ACC8(acc);
    gemm_tile_dma(A, 1024, W, 1024, 1024, tm * 256, tn * 128, acc, lds);
    EPI_VARS8;
#pragma unroll
    for (int mi = 0; mi < 8; ++mi) {
      const int row = rbase + mi * 16;
      if (row < M_TOK) {
#pragma unroll
        for (int ni = 0; ni < 4; ++ni) {
          const int c = (cbase + ni * 16) >> 1; const f32x4 a = acc[mi][ni];
          *(unsigned*)(HF + (size_t)row * 2816 + c) = pk2(siluf(a[0]) * a[1], siluf(a[2]) * a[3]);
        }
      }
    }
  }
}

template <bool FIRST> __device__ __forceinline__ void phase_ffn_down(const Params& p, unsigned char* lds) {
  const bf16_t* A = (const bf16_t*)(p.ws + OFF_HF); const bf16_t* W = (const bf16_t*)(p.ws + OFF_W1D);
  bf16_t* H = (bf16_t*)(p.ws + OFF_H); float* H3 = (float*)(p.ws + OFF_H3);
  const int nM = NMT, nN = 8;
  for (int L = blockIdx.x; L < nM * nN; L += gridDim.x) {
    int tm, tn; tile_coords(L, nM, nN, tm, tn);
    f32x4 acc[8][4]; ZERO_ACC8(acc);
    gemm_tile_dma(A, 2816, W, 2816, 2816, tm * 256, tn * 128, acc, lds);
    EPI_VARS8;
#pragma unroll
    for (int mi = 0; mi < 8; ++mi) {
      const int row = rbase + mi * 16;
      if (row < M_TOK) {
        const float* xr = FIRST ? x_row(p, row) : nullptr;
#pragma unroll
        for (int ni = 0; ni < 4; ++ni) {
          const int col = cbase + ni * 16; const f32x4 a = acc[mi][ni];
          if (FIRST) { const float4 xv = *(const float4*)(xr + col);
            *(uint2*)(H + (size_t)row * 1024 + col) = pk4(xv.x + 0.5f * a[0], xv.y + 0.5f * a[1], xv.z + 0.5f * a[2], xv.w + 0.5f * a[3]); }
          else { float h[4]; unpk4(*(const uint2*)(H + (size_t)row * 1024 + col), h);
            *(float4*)(H3 + (size_t)row * 1024 + col) = make_float4(h[0] + 0.5f * a[0], h[1] + 0.5f * a[1], h[2] + 0.5f * a[2], h[3] + 0.5f * a[3]); }
        }
      }
    }
  }
}

__device__ __forceinline__ void rope_cs(float ang, float& c, float& s) {
  double rev = (double)ang * 0.15915494309189535; rev -= rint(rev); const float fr = (float)rev;
  s = __builtin_amdgcn_sinf(fr); c = __builtin_amdgcn_cosf(fr);
}
__device__ __forceinline__ void phase_win(const Params& p, unsigned char* lds) {
  const bf16_t* A = (const bf16_t*)(p.ws + OFF_A); const bf16_t* W = (const bf16_t*)(p.ws + OFF_WIN);
  bf16_t* QK = (bf16_t*)(p.ws + OFF_QK); bf16_t* V = (bf16_t*)(p.ws + OFF_V); bf16_t* GR = (bf16_t*)(p.ws + OFF_GR); bf16_t* PR = (bf16_t*)(p.ws + OFF_PR);
  bf16_t* GB = (bf16_t*)(p.ws + OFF_GB); bf16_t* GA = (bf16_t*)((unsigned char*)p.out + OO_GA);
  const int nM = NMT, nN = 5376 / 128;
  for (int L = blockIdx.x; L < nM * nN; L += gridDim.x) {
    int tm, tn; tile_coords(L, nM, nN, tm, tn);
    f32x4 acc[8][4]; ZERO_ACC8(acc);
    gemm_tile_dma(A, 1024, W, 1024, 1024, tm * 256, tn * 128, acc, lds);
    EPI_VARS8;
    const int n0 = tn * 128;
    if (n0 < 512) {
      const float sc = n0 >= 256 ? 0.125f : 1.0f;
      const int hb = n0 + wn * 64;
#pragma unroll
      for (int mi = 0; mi < 8; ++mi) {
        const int row = rbase + mi * 16;
        if (row >= M_TOK) continue;
        const float pos = row < MP ? (float)(row % TP) : (float)(PAST + ((row - MP) & 3));
#pragma unroll
        for (int ni = 0; ni < 2; ++ni) {
          float o1[4], o2[4];
#pragma unroll
          for (int jj = 0; jj < 4; ++jj) {
            const int j = ni * 16 + (lane >> 4) * 4 + jj;
            float c, s; rope_cs(pos * p.invf[j], c, s);
            const float x1 = acc[mi][ni][jj], x2 = acc[mi][ni + 2][jj];
            o1[jj] = (x1 * c - x2 * s) * sc; o2[jj] = (x1 * s + x2 * c) * sc;
          }
          const int j0 = ni * 16 + (lane >> 4) * 4;
          *(uint2*)(QK + (size_t)row * 512 + hb + j0) = pk4(o1[0], o1[1], o1[2], o1[3]);
          *(uint2*)(QK + (size_t)row * 512 + hb + 32 + j0) = pk4(o2[0], o2[1], o2[2], o2[3]);
        }
      }
    } else {
#pragma unroll
      for (int mi = 0; mi < 8; ++mi) {
        const int row = rbase + mi * 16;
        if (row >= M_TOK) continue;
        float* sh = nullptr;
        if (row < MP) { const int b = row / TP; if (row - b * TP == TP - 1) sh = p.out + O_SHP + (size_t)b * 1792; }
        else { const int r2 = row - MP; if ((r2 & 3) == 3) sh = p.out + O_SHS + (size_t)(r2 >> 2) * 1792; }
#pragma unroll
        for (int ni = 0; ni < 4; ++ni) {
          const int col = cbase + ni * 16; const f32x4 a = acc[mi][ni];
          if (n0 < 1024) *(uint2*)(V + (size_t)row * 512 + (col - 512)) = pk4(a[0], a[1], a[2], a[3]);
          else if (n0 < 1536) *(uint2*)(GR + (size_t)row * 512 + (col - 1024)) = pk4(siluf(a[0]), siluf(a[1]), siluf(a[2]), siluf(a[3]));
          else if (n0 < 3328) { *(uint2*)(PR + (size_t)row * 1792 + (col - 1536)) = pk4(a[0], a[1], a[2], a[3]);
            if (sh) *(float4*)(sh + (col - 1536)) = make_float4(a[0], a[1], a[2], a[3]); }
          else if (n0 < 4352) *(uint2*)(GA + (size_t)row * 1024 + (col - 3328)) = pk4(sigmoidf(a[0]), sigmoidf(a[1]), sigmoidf(a[2]), sigmoidf(a[3]));
          else *(uint2*)(GB + (size_t)row * 1024 + (col - 4352)) = pk4(sigmoidf(a[0]), sigmoidf(a[1]), sigmoidf(a[2]), sigmoidf(a[3]));
        }
      }
    }
  }
}

__device__ __forceinline__ void phase_lora(const Params& p, unsigned char* lds) {
  float* sS = (float*)lds;
  const int tid = threadIdx.x;
  const bf16_t* PR = (const bf16_t*)(p.ws + OFF_PR);
  bf16_t* LD = (bf16_t*)(p.ws + OFF_LD); bf16_t* AA = (bf16_t*)(p.ws + OFF_AA); bf16_t* GG = (bf16_t*)((unsigned char*)p.out + OO_GG);
  const float mu_j = p.mu[1536 + tid];
  for (int tile = blockIdx.x; tile < M_TOK / 16; tile += gridDim.x) {
    const int row0 = tile * 16;
    __syncthreads();
#pragma unroll 4
    for (int tt = 0; tt < 16; ++tt) {
      const int row = row0 + tt;
      const float pc = bf2f(PR[(size_t)row * 1792 + 1536 + tid]);
      float pp;
      if (row < MP) { const int t = row % TP; pp = t == 0 ? 0.f : bf2f(PR[(size_t)(row - 1) * 1792 + 1536 + tid]); }
      else { const int r2 = row - MP; pp = (r2 & 3) == 0 ? p.state_shift[(size_t)(r2 >> 2) * 1792 + 1536 + tid] : bf2f(PR[(size_t)(row - 1) * 1792 + 1536 + tid]); }
      const float pm = pc + (pp - pc) * mu_j;
      sS[tt * 256 + tid] = tid < 64 ? tanhf(pm) : (tid < 128 ? pm : sigmoidf(pm));
    }
    __syncthreads();
#pragma unroll 1
    for (int which = 0; which < 3; ++which) {
      const float* Wm = which == 0 ? p.w2 : (which == 1 ? p.a2 : p.g2);
      const int jb = which == 0 ? 0 : (which == 1 ? 64 : 128), nj = which == 2 ? 128 : 64;
      float acc0[16], acc1[16];
#pragma unroll
      for (int tt = 0; tt < 16; ++tt) { acc0[tt] = 0.f; acc1[tt] = 0.f; }
      for (int j = 0; j < nj; j += 4) {
        float wa[4], wb[4];
#pragma unroll
        for (int e = 0; e < 4; ++e) { wa[e] = Wm[(size_t)(j + e) * 512 + tid]; wb[e] = Wm[(size_t)(j + e) * 512 + tid + 256]; }
#pragma unroll
        for (int tt = 0; tt < 16; ++tt) {
          const float4 s4 = *(const float4*)(sS + tt * 256 + jb + j);
          acc0[tt] += s4.x * wa[0] + s4.y * wa[1] + s4.z * wa[2] + s4.w * wa[3];
          acc1[tt] += s4.x * wb[0] + s4.y * wb[1] + s4.z * wb[2] + s4.w * wb[3];
        }
      }
      if (which == 0) {
        const float b0 = p.w0[tid], b1 = p.w0[tid + 256];
#pragma unroll
        for (int tt = 0; tt < 16; ++tt) {
          const float x0 = -(b0 + acc0[tt]), x1 = -(b1 + acc1[tt]);
          const float sp0 = fmaxf(x0, 0.f) + log1pf(expf(-fabsf(x0))), sp1 = fmaxf(x1, 0.f) + log1pf(expf(-fabsf(x1)));
          LD[(size_t)(row0 + tt) * 512 + tid] = (bf16_t)f2bf(-expf(-sp0 - 0.5f));
          LD[(size_t)(row0 + tt) * 512 + tid + 256] = (bf16_t)f2bf(-expf(-sp1 - 0.5f));
        }
      } else if (which == 1) {
        const float b0 = p.a0[tid], b1 = p.a0[tid + 256];
#pragma unroll
        for (int tt = 0; tt < 16; ++tt) {
          AA[(size_t)(row0 + tt) * 512 + tid] = (bf16_t)f2bf(sigmoidf(b0 + acc0[tt]));
          AA[(size_t)(row0 + tt) * 512 + tid + 256] = (bf16_t)f2bf(sigmoidf(b1 + acc1[tt]));
        }
      } else {
#pragma unroll
        for (int tt = 0; tt < 16; ++tt) {
          GG[(size_t)(row0 + tt) * 512 + tid] = (bf16_t)f2bf(acc0[tt]);
          GG[(size_t)(row0 + tt) * 512 + tid + 256] = (bf16_t)f2bf(acc1[tt]);
        }
      }
    }
  }
}


__device__ __forceinline__ void phase_lora_mfma(const Params& p, unsigned char* lds) {
  constexpr int LSTR = 272;
  unsigned char* sA = lds; unsigned char* sB = lds + 128 * LSTR;
  const bf16_t* PR = (const bf16_t*)(p.ws + OFF_PR);
  bf16_t* LD = (bf16_t*)(p.ws + OFF_LD); bf16_t* AA = (bf16_t*)(p.ws + OFF_AA); bf16_t* GG = (bf16_t*)((unsigned char*)p.out + OO_GG);
  for (int grp = blockIdx.x; grp < (M_TOK / 128) * 3; grp += gridDim.x) {
    int tid_o = threadIdx.x; asm volatile("" : "+v"(tid_o));
    const int tid = tid_o, lane = tid & 63, wid = tid >> 6, wm = wid >> 1, wn = wid & 1, l15 = lane & 15, l4 = lane >> 4;
    const int tm = grp / 3, which = grp - tm * 3;
    const int Kc = which == 2 ? 128 : 64, jb = which == 0 ? 0 : (which == 1 ? 64 : 128), cpr = Kc >> 3;
    const bf16_t* Wt = (const bf16_t*)(p.ws + (which == 0 ? OFF_W2T : (which == 1 ? OFF_A2T : OFF_G2T)));
    __syncthreads();
    for (int q = tid; q < 128 * cpr; q += NT) {
      const int r = q / cpr, ck = q - r * cpr, row = tm * 128 + r, col = 1536 + jb + ck * 8;
      const u32x4 cu = *(const u32x4*)(PR + (size_t)row * 1792 + col);
      float pc[8], pp[8];
#pragma unroll
      for (int e = 0; e < 4; ++e) { pc[2 * e] = __uint_as_float(cu[e] << 16); pc[2 * e + 1] = __uint_as_float(cu[e] & 0xffff0000u); }
      bool first; const float* sprev = nullptr;
      if (row < MP) first = (row % TP) == 0; else { const int r2 = row - MP; first = (r2 & 3) == 0; sprev = p.state_shift + (size_t)(r2 >> 2) * 1792 + col; }
      if (!first) { const u32x4 pu = *(const u32x4*)(PR + (size_t)(row - 1) * 1792 + col);
#pragma unroll
        for (int e = 0; e < 4; ++e) { pp[2 * e] = __uint_as_float(pu[e] << 16); pp[2 * e + 1] = __uint_as_float(pu[e] & 0xffff0000u); } }
      else {
#pragma unroll
        for (int e = 0; e < 8; ++e) pp[e] = sprev ? sprev[e] : 0.f;
      }
      float sv[8];
#pragma unroll
      for (int e = 0; e < 8; ++e) {
        const float pm = pc[e] + (pp[e] - pc[e]) * p.mu[col + e];
        float t;
        if (which == 0) { const float ex = __expf(-2.f * fabsf(pm)); t = (1.f - ex) / (1.f + ex); t = pm < 0.f ? -t : t; }
        else if (which == 1) t = pm;
        else t = sigmoidf(pm);
        sv[e] = t;
      }
      u32x4 o; o[0] = pk2(sv[0], sv[1]); o[1] = pk2(sv[2], sv[3]); o[2] = pk2(sv[4], sv[5]); o[3] = pk2(sv[6], sv[7]);
      *(u32x4*)(sA + r * LSTR + ck * 16) = o;
    }
    for (int tn = 0; tn < 4; ++tn) {
      if (tn > 0) __syncthreads();
      for (int q = tid; q < 128 * cpr; q += NT) { const int r = q / cpr, ck = q - r * cpr; *(u32x4*)(sB + r * LSTR + ck * 16) = *(const u32x4*)(Wt + (size_t)(tn * 128 + r) * Kc + ck * 8); }
      __syncthreads();
      f32x4 acc[4][4]; ZERO_ACC(acc);
      for (int kk = 0; kk < (Kc >> 5); ++kk) {
        bf16x8 af[4], bfr[4];
#pragma unroll
        for (int i = 0; i < 4; ++i) { af[i] = *(const bf16x8*)(sA + (wm * 64 + i * 16 + l15) * LSTR + kk * 64 + l4 * 16); bfr[i] = *(const bf16x8*)(sB + (wn * 64 + i * 16 + l15) * LSTR + kk * 64 + l4 * 16); }
#pragma unroll
        for (int mi = 0; mi < 4; ++mi)
#pragma unroll
          for (int ni = 0; ni < 4; ++ni) acc[mi][ni] = __builtin_amdgcn_mfma_f32_16x16x32_bf16(bfr[ni], af[mi], acc[mi][ni], 0, 0, 0);
      }
#pragma unroll
      for (int ni = 0; ni < 4; ++ni) {
        const int col = tn * 128 + wn * 64 + ni * 16 + l4 * 4;
        float bias[4] = {0.f, 0.f, 0.f, 0.f};
        if (which == 0) { const float4 b4 = *(const float4*)(p.w0 + col); bias[0] = b4.x; bias[1] = b4.y; bias[2] = b4.z; bias[3] = b4.w; }
        else if (which == 1) { const float4 b4 = *(const float4*)(p.a0 + col); bias[0] = b4.x; bias[1] = b4.y; bias[2] = b4.z; bias[3] = b4.w; }
#pragma unroll
        for (int mi = 0; mi < 4; ++mi) {
          const int row = tm * 128 + wm * 64 + mi * 16 + l15;
          float o[4];
#pragma unroll
          for (int jj = 0; jj < 4; ++jj) {
            const float a = acc[mi][ni][jj] + bias[jj];
            if (which == 0) o[jj] = -0.60653066f * sigmoidf(a);
            else if (which == 1) o[jj] = sigmoidf(a);
            else o[jj] = a;
          }
          bf16_t* dst = which == 0 ? LD : (which == 1 ? AA : GG);
          *(uint2*)(dst + (size_t)row * 512 + col) = pk4(o[0], o[1], o[2], o[3]);
        }
      }
    }
  }
}

struct StageRegs { uint2 cr, ck, cv, qr, qk, qv, ld, aa; };

__device__ __forceinline__ void rwkv_item(const Params& p, int rowbase, int T, int h, int rb, const float* shift_prev, const float* S_in, float* S_out, unsigned char* lds) {
  float* stage = (float*)lds;
  float* ybuf = (float*)(lds + 49152);
  const int tid = threadIdx.x, lane = tid & 63, wid = tid >> 6;
  const int t_l = tid >> 4, c4 = tid & 15, ch = h * 64 + c4 * 4;
  const int kg = lane & 15, vloc = wid * 4 + (lane >> 4), vrow = rb * 16 + vloc;
  const bf16_t* PR = (const bf16_t*)(p.ws + OFF_PR); const bf16_t* LD = (const bf16_t*)(p.ws + OFF_LD); const bf16_t* AA = (const bf16_t*)(p.ws + OFF_AA);
  bf16_t* Y = (bf16_t*)(p.ws + OFF_Y); float* RHO = (float*)((unsigned char*)p.out + OO_RHO);
  float mur[4], muk[4], muv[4], kkc[4], kac[4], rkc[4];
#pragma unroll
  for (int e = 0; e < 4; ++e) { mur[e] = p.mu[ch + e]; muk[e] = p.mu[512 + ch + e]; muv[e] = p.mu[1024 + ch + e]; kkc[e] = p.k_k[ch + e]; kac[e] = p.k_a[ch + e]; rkc[e] = p.r_k[ch + e]; }
  f32x4 S;
  if (S_in) S = *(const f32x4*)(S_in + (size_t)vrow * 64 + kg * 4); else S = (f32x4){0.f, 0.f, 0.f, 0.f};
  f32x2 Sa = S.xy, Sb = S.zw;

  auto load = [&](int t0, StageRegs& r) {
    int t = t0 + t_l; if (t > T - 1) t = T - 1;
    const bf16_t* cur = PR + (size_t)(rowbase + t) * 1792 + ch;
    r.cr = *(const uint2*)cur; r.ck = *(const uint2*)(cur + 512); r.cv = *(const uint2*)(cur + 1024);
    if (t > 0) { const bf16_t* pv = cur - 1792; r.qr = *(const uint2*)pv; r.qk = *(const uint2*)(pv + 512); r.qv = *(const uint2*)(pv + 1024); }
    else { r.qr = make_uint2(0, 0); r.qk = r.qr; r.qv = r.qr; }
    r.ld = *(const uint2*)(LD + (size_t)(rowbase + t) * 512 + ch); r.aa = *(const uint2*)(AA + (size_t)(rowbase + t) * 512 + ch);
  };
  auto process = [&](int t0, const StageRegs& r, int buf) {
    float cr[4], ck[4], cv[4], qr[4], qk[4], qv[4], ld[4], aa[4];
    unpk4(r.cr, cr); unpk4(r.ck, ck); unpk4(r.cv, cv); unpk4(r.qr, qr); unpk4(r.qk, qk); unpk4(r.qv, qv); unpk4(r.ld, ld); unpk4(r.aa, aa);
    const int t = t0 + t_l;
    if (t == 0 && shift_prev) {
#pragma unroll
      for (int e = 0; e < 4; ++e) { qr[e] = shift_prev[ch + e]; qk[e] = shift_prev[512 + ch + e]; qv[e] = shift_prev[1024 + ch + e]; }
    }
    float rr[4], k[4], v[4], kk[4], kp[4], bb[4], w[4];
    float ss = 0.f, rho = 0.f;
#pragma unroll
    for (int e = 0; e < 4; ++e) {
      rr[e] = cr[e] + (qr[e] - cr[e]) * mur[e]; k[e] = ck[e] + (qk[e] - ck[e]) * muk[e]; v[e] = cv[e] + (qv[e] - cv[e]) * muv[e];
      kk[e] = k[e] * kkc[e]; ss += kk[e] * kk[e];
      kp[e] = k[e] * (1.f + (aa[e] - 1.f) * kac[e]);
      rho += rr[e] * kp[e] * rkc[e];
      w[e] = expf(ld[e]);
    }
    ss = rowsum16(ss); rho = rowsum16(rho);
    const float inv = rsqrtf(fmaxf(ss, 1e-24f));
#pragma unroll
    for (int e = 0; e < 4; ++e) { kk[e] *= inv; bb[e] = kk[e] * aa[e]; }
    float* sp = stage + (size_t)((buf * 16 + t_l) * 6) * 64 + c4 * 4;
    *(float4*)(sp) = make_float4(rr[0], rr[1], rr[2], rr[3]);
    *(float4*)(sp + 64) = make_float4(w[0], w[1], w[2], w[3]);
    *(float4*)(sp + 128) = make_float4(kp[0], kp[1], kp[2], kp[3]);
    *(float4*)(sp + 192) = make_float4(v[0], v[1], v[2], v[3]);
    *(float4*)(sp + 256) = make_float4(-kk[0], -kk[1], -kk[2], -kk[3]);
    *(float4*)(sp + 320) = make_float4(bb[0], bb[1], bb[2], bb[3]);
    if (rb == 0 && c4 == 0 && t < T) RHO[(size_t)(rowbase + t) * 8 + h] = rho;
  };

  const int nch = (T + 15) >> 4;
  StageRegs rg;
  __syncthreads();
  load(0, rg); process(0, rg, 0);
  __syncthreads();
  for (int c = 0; c < nch; ++c) {
    const int buf = c & 1, t0 = c * 16;
    const int nsteps = min(16, T - t0);
    if (c + 1 < nch) load(t0 + 16, rg);
    const float* st = stage + (size_t)(buf * 16) * 384;
    float* yb = ybuf + buf * 256;
    for (int s0 = 0; s0 < nsteps; s0 += 4) {
#pragma unroll
      for (int u = 0; u < 4; ++u) {
        const int s = s0 + u;
        const float* sp = st + s * 384;
        const f32x4 r4 = *(const f32x4*)(sp + kg * 4), w4 = *(const f32x4*)(sp + 64 + kg * 4), kp4 = *(const f32x4*)(sp + 128 + kg * 4);
        const f32x4 nk4 = *(const f32x4*)(sp + 256 + kg * 4), b4 = *(const f32x4*)(sp + 320 + kg * 4);
        const float vv = sp[192 + vrow];
        f32x2 pa = Sa * nk4.xy; pa = Sb * nk4.zw + pa;
        float sa = rowsum16(pa.x + pa.y);
        const f32x2 sa2 = {sa, sa}, vv2 = {vv, vv};
        const f32x2 Xa = sa2 * b4.xy + vv2 * kp4.xy, Xb = sa2 * b4.zw + vv2 * kp4.zw;
        Sa = Sa * w4.xy + Xa; Sb = Sb * w4.zw + Xb;
        f32x2 ya = Sa * r4.xy; ya = Sb * r4.zw + ya;
        const float y = rowsum16(ya.x + ya.y);
        if (kg == 0) yb[s * 16 + vloc] = y;
      }
    }
    if (c + 1 < nch) process(t0 + 16, rg, buf ^ 1);
    __syncthreads();
    if (t0 + t_l < T) Y[(size_t)(rowbase + t0 + t_l) * 512 + h * 64 + rb * 16 + c4] = (bf16_t)f2bf(yb[t_l * 16 + c4]);
  }
  S.xy = Sa; S.zw = Sb;
  *(f32x4*)(S_out + (size_t)vrow * 64 + kg * 4) = S;
}

__device__ __forceinline__ void ret_item(const Params& p, int rowbase, int T, int h, const float* S_in, float* S_out, unsigned char* lds, int cb, int ce, int seg, float* loc, unsigned* flags) {
  unsigned char* sQ = lds; unsigned char* sK = lds + 9216; unsigned char* sKdT = lds + 18432; unsigned char* sVT = lds + 27648; unsigned char* sP = lds + 46080; unsigned char* sST = lds + 55296;
  float* part = (float*)sK;
  const int tid = threadIdx.x, lane = tid & 63, w = tid >> 6, l15 = lane & 15, l4 = lane >> 4;
  const bf16_t* QK = (const bf16_t*)(p.ws + OFF_QK); const bf16_t* V = (const bf16_t*)(p.ws + OFF_V); bf16_t* GR = (bf16_t*)(p.ws + OFF_GR);
  const float lg2 = p.lg2g[h];
  f32x4 ST[2][4];
#pragma unroll
  for (int vt = 0; vt < 2; ++vt)
#pragma unroll
    for (int dt = 0; dt < 4; ++dt) ST[vt][dt] = (f32x4){0.f, 0.f, 0.f, 0.f};
  u32x4 pq[2], pk[2], pv[4];
  auto prefetch = [&](int t0n, int tidp) {
    const int Ln = min(64, T - t0n);
#pragma unroll
    for (int i = 0; i < 2; ++i) {
      const int q_ = tidp + i * 256, j = q_ & 63, ck = q_ >> 6;
      pq[i] = (u32x4){0u, 0u, 0u, 0u}; pk[i] = pq[i];
      if (j < Ln) { const bf16_t* src = QK + (size_t)(rowbase + t0n + j) * 512 + h * 64 + ck * 8; pq[i] = *(const u32x4*)src; pk[i] = *(const u32x4*)(src + 256); }
    }
#pragma unroll
    for (int i = 0; i < 4; ++i) {
      const int q_ = tidp + i * 256, j = q_ & 63, cv = q_ >> 6;
      pv[i] = (u32x4){0u, 0u, 0u, 0u};
      if (j < Ln) pv[i] = *(const u32x4*)(V + (size_t)(rowbase + t0n + j) * 512 + h * 128 + cv * 8);
    }
  };
  if (seg >= 0 && seg < 3) {
    prefetch(cb * 64, threadIdx.x);
    for (int c = cb; c < ce; ++c) {
      const int t0 = c * 64, Lc = min(64, T - t0);
      int tid_o = threadIdx.x; asm volatile("" : "+v"(tid_o));
      const int tid = tid_o, lane = tid & 63, w = tid >> 6, l15 = lane & 15, l4 = lane >> 4;
      __syncthreads();
#pragma unroll
      for (int i = 0; i < 2; ++i) {
        const int q_ = tid + i * 256, j = q_ & 63, ck = q_ >> 6;
        const u32x4 kv = pk[i];
        const float kd = __builtin_amdgcn_exp2f((float)(Lc - 1 - j) * lg2);
#pragma unroll
        for (int e = 0; e < 4; ++e) {
          *(bf16_t*)(sKdT + (ck * 8 + 2 * e) * 144 + j * 2) = (bf16_t)f2bf(__uint_as_float(kv[e] << 16) * kd);
          *(bf16_t*)(sKdT + (ck * 8 + 2 * e + 1) * 144 + j * 2) = (bf16_t)f2bf(__uint_as_float(kv[e] & 0xffff0000u) * kd);
        }
      }
#pragma unroll
      for (int i = 0; i < 4; ++i) {
        const int q_ = tid + i * 256, j = q_ & 63, cv = q_ >> 6;
        const u32x4 vv = pv[i];
#pragma unroll
        for (int e = 0; e < 4; ++e) {
          *(bf16_t*)(sVT + (cv * 8 + 2 * e) * 144 + j * 2) = (bf16_t)(vv[e] & 0xffffu);
          *(bf16_t*)(sVT + (cv * 8 + 2 * e + 1) * 144 + j * 2) = (bf16_t)(vv[e] >> 16);
        }
      }
      if (c + 1 < ce) prefetch(t0 + 64, tid);
      __syncthreads();
      const float gl = __builtin_amdgcn_exp2f((float)Lc * lg2);
      bf16x8 bV[2][2];
#pragma unroll
      for (int vt = 0; vt < 2; ++vt)
#pragma unroll
        for (int kk = 0; kk < 2; ++kk) bV[vt][kk] = *(const bf16x8*)(sVT + (32 * w + vt * 16 + l15) * 144 + kk * 64 + l4 * 16);
#pragma unroll
      for (int dt = 0; dt < 4; ++dt) {
        bf16x8 bK[2];
#pragma unroll
        for (int kk = 0; kk < 2; ++kk) bK[kk] = *(const bf16x8*)(sKdT + (dt * 16 + l15) * 144 + kk * 64 + l4 * 16);
#pragma unroll
        for (int vt = 0; vt < 2; ++vt) {
          f32x4 a = ST[vt][dt] * gl;
#pragma unroll
          for (int kk = 0; kk < 2; ++kk) a = __builtin_amdgcn_mfma_f32_16x16x32_bf16(bV[vt][kk], bK[kk], a, 0, 0, 0);
          ST[vt][dt] = a;
        }
      }
    }
    float* lp = loc + (size_t)seg * 8192;
#pragma unroll
    for (int vt = 0; vt < 2; ++vt)
#pragma unroll
      for (int dt = 0; dt < 4; ++dt)
        *(float4*)(lp + (size_t)(dt * 16 + l15) * 128 + 32 * w + vt * 16 + l4 * 4) = make_float4(ST[vt][dt][0], ST[vt][dt][1], ST[vt][dt][2], ST[vt][dt][3]);
    __threadfence();
    __syncthreads();
    if (threadIdx.x == 0) { asm volatile("s_waitcnt vmcnt(0)" ::: "memory"); __hip_atomic_store(flags + seg, 1u, __ATOMIC_RELAXED, __HIP_MEMORY_SCOPE_AGENT); }
  }
#pragma unroll
  for (int vt = 0; vt < 2; ++vt)
#pragma unroll
    for (int dt = 0; dt < 4; ++dt) ST[vt][dt] = (f32x4){0.f, 0.f, 0.f, 0.f};
  if (seg > 0) {
    if (threadIdx.x == 0) {
      for (int s2 = 0; s2 < seg; ++s2) { unsigned sp = 0; while (__hip_atomic_load(flags + s2, __ATOMIC_RELAXED, __HIP_MEMORY_SCOPE_AGENT) == 0u) { __builtin_amdgcn_s_sleep(2); if (++sp > (1u << 22)) break; } }
      __builtin_amdgcn_fence(__ATOMIC_ACQUIRE, "agent");
      asm volatile("s_waitcnt vmcnt(0)" ::: "memory");
    }
    __syncthreads();
    for (int s2 = 0; s2 < seg; ++s2) {
      const float dk = __builtin_amdgcn_exp2f((float)(64 * (cb - 8 * (s2 + 1))) * lg2);
      const float* lp = loc + (size_t)s2 * 8192;
#pragma unroll
      for (int vt = 0; vt < 2; ++vt)
#pragma unroll
        for (int dt = 0; dt < 4; ++dt) {
          const float4 t4 = *(const float4*)(lp + (size_t)(dt * 16 + l15) * 128 + 32 * w + vt * 16 + l4 * 4);
          ST[vt][dt][0] += dk * t4.x; ST[vt][dt][1] += dk * t4.y; ST[vt][dt][2] += dk * t4.z; ST[vt][dt][3] += dk * t4.w;
        }
    }
  } else if (S_in) {
#pragma unroll
    for (int vt = 0; vt < 2; ++vt)
#pragma unroll
      for (int dt = 0; dt < 4; ++dt) {
        const float4 t4 = *(const float4*)(S_in + (size_t)(dt * 16 + l15) * 128 + 32 * w + vt * 16 + l4 * 4);
        ST[vt][dt][0] = t4.x; ST[vt][dt][1] = t4.y; ST[vt][dt][2] = t4.z; ST[vt][dt][3] = t4.w;
      }
  }
  __syncthreads();
#pragma unroll
  for (int vt = 0; vt < 2; ++vt)
#pragma unroll
    for (int dt = 0; dt < 4; ++dt)
#pragma unroll
      for (int jj = 0; jj < 4; ++jj) *(bf16_t*)(sST + (32 * w + vt * 16 + l4 * 4 + jj) * 144 + (dt * 16 + l15) * 2) = (bf16_t)f2bf(ST[vt][dt][jj]);
  prefetch(cb * 64, threadIdx.x);
  for (int c = cb; c < ce; ++c) {
    const int t0 = c * 64, Lc = min(64, T - t0);
    int tid_o = threadIdx.x; asm volatile("" : "+v"(tid_o));
    const int tid = tid_o, lane = tid & 63, w = tid >> 6, l15 = lane & 15, l4 = lane >> 4;
    __syncthreads();
#pragma unroll
    for (int i = 0; i < 2; ++i) {
      const int q_ = tid + i * 256, j = q_ & 63, ck = q_ >> 6;
      const u32x4 kv = pk[i];
      *(u32x4*)(sQ + j * 144 + ck * 16) = pq[i]; *(u32x4*)(sK + j * 144 + ck * 16) = kv;
      const float kd = __builtin_amdgcn_exp2f((float)(Lc - 1 - j) * lg2);
#pragma unroll
      for (int e = 0; e < 4; ++e) {
        *(bf16_t*)(sKdT + (ck * 8 + 2 * e) * 144 + j * 2) = (bf16_t)f2bf(__uint_as_float(kv[e] << 16) * kd);
        *(bf16_t*)(sKdT + (ck * 8 + 2 * e + 1) * 144 + j * 2) = (bf16_t)f2bf(__uint_as_float(kv[e] & 0xffff0000u) * kd);
      }
    }
#pragma unroll
    for (int i = 0; i < 4; ++i) {
      const int q_ = tid + i * 256, j = q_ & 63, cv = q_ >> 6;
      const u32x4 vv = pv[i];
#pragma unroll
      for (int e = 0; e < 4; ++e) {
        *(bf16_t*)(sVT + (cv * 8 + 2 * e) * 144 + j * 2) = (bf16_t)(vv[e] & 0xffffu);
        *(bf16_t*)(sVT + (cv * 8 + 2 * e + 1) * 144 + j * 2) = (bf16_t)(vv[e] >> 16);
      }
    }
    if (c + 1 < ce) prefetch(t0 + 64, tid);
    __syncthreads();
    {
      f32x4 sc[4];
#pragma unroll
      for (int jt = 0; jt < 4; ++jt) sc[jt] = (f32x4){0.f, 0.f, 0.f, 0.f};
#pragma unroll
      for (int kk = 0; kk < 2; ++kk) {
        const bf16x8 aq = *(const bf16x8*)(sQ + (16 * w + l15) * 144 + kk * 64 + l4 * 16);
#pragma unroll
        for (int jt = 0; jt < 4; ++jt) { const bf16x8 bk = *(const bf16x8*)(sK + (jt * 16 + l15) * 144 + kk * 64 + l4 * 16); sc[jt] = __builtin_amdgcn_mfma_f32_16x16x32_bf16(aq, bk, sc[jt], 0, 0, 0); }
      }
#pragma unroll
      for (int jt = 0; jt < 4; ++jt)
#pragma unroll
        for (int jj = 0; jj < 4; ++jj) {
          const int i = 16 * w + l4 * 4 + jj, j = jt * 16 + l15;
          const float pv = i >= j ? sc[jt][jj] * __builtin_amdgcn_exp2f((float)(i - j) * lg2) : 0.f;
          *(bf16_t*)(sP + i * 144 + j * 2) = (bf16_t)f2bf(pv);
        }
    }
    __syncthreads();
    f32x4 o[4][2];
    {
      bf16x8 bV[2][2], bS[2][2];
#pragma unroll
      for (int vt = 0; vt < 2; ++vt)
#pragma unroll
        for (int kk = 0; kk < 2; ++kk) {
          bV[vt][kk] = *(const bf16x8*)(sVT + (32 * w + vt * 16 + l15) * 144 + kk * 64 + l4 * 16);
          bS[vt][kk] = *(const bf16x8*)(sST + (32 * w + vt * 16 + l15) * 144 + kk * 64 + l4 * 16);
        }
#pragma unroll
      for (int it = 0; it < 4; ++it) {
        bf16x8 aP[2], aQ[2];
#pragma unroll
        for (int kk = 0; kk < 2; ++kk) { aP[kk] = *(const bf16x8*)(sP + (it * 16 + l15) * 144 + kk * 64 + l4 * 16); aQ[kk] = *(const bf16x8*)(sQ + (it * 16 + l15) * 144 + kk * 64 + l4 * 16); }
#pragma unroll
        for (int vt = 0; vt < 2; ++vt) {
          f32x4 a1 = (f32x4){0.f, 0.f, 0.f, 0.f}, a2 = (f32x4){0.f, 0.f, 0.f, 0.f};
#pragma unroll
          for (int kk = 0; kk < 2; ++kk) { a1 = __builtin_amdgcn_mfma_f32_16x16x32_bf16(aP[kk], bV[vt][kk], a1, 0, 0, 0); a2 = __builtin_amdgcn_mfma_f32_16x16x32_bf16(aQ[kk], bS[vt][kk], a2, 0, 0, 0); }
#pragma unroll
          for (int jj = 0; jj < 4; ++jj) { const int i = it * 16 + l4 * 4 + jj; o[it][vt][jj] = a1[jj] + __builtin_amdgcn_exp2f((float)(i + 1) * lg2) * a2[jj]; }
        }
      }
      const float gl = __builtin_amdgcn_exp2f((float)Lc * lg2);
#pragma unroll
      for (int dt = 0; dt < 4; ++dt) {
        bf16x8 bK[2];
#pragma unroll
        for (int kk = 0; kk < 2; ++kk) bK[kk] = *(const bf16x8*)(sKdT + (dt * 16 + l15) * 144 + kk * 64 + l4 * 16);
#pragma unroll
        for (int vt = 0; vt < 2; ++vt) {
          f32x4 a = ST[vt][dt] * gl;
#pragma unroll
          for (int kk = 0; kk < 2; ++kk) a = __builtin_amdgcn_mfma_f32_16x16x32_bf16(bV[vt][kk], bK[kk], a, 0, 0, 0);
          ST[vt][dt] = a;
#pragma unroll
          for (int jj = 0; jj < 4; ++jj) *(bf16_t*)(sST + (32 * w + vt * 16 + l4 * 4 + jj) * 144 + (dt * 16 + l15) * 2) = (bf16_t)f2bf(a[jj]);
        }
      }
    }
    unsigned short grv[4][4][2];
#pragma unroll
    for (int it = 0; it < 4; ++it)
#pragma unroll
      for (int jj = 0; jj < 4; ++jj) {
        const int i = it * 16 + l4 * 4 + jj;
#pragma unroll
        for (int vt = 0; vt < 2; ++vt) grv[it][jj][vt] = i < Lc ? GR[(size_t)(rowbase + t0 + i) * 512 + h * 128 + 32 * w + vt * 16 + l15] : (unsigned short)0;
      }
#pragma unroll
    for (int it = 0; it < 4; ++it)
#pragma unroll
      for (int jj = 0; jj < 4; ++jj) {
        float s1 = o[it][0][jj] + o[it][1][jj], s2 = o[it][0][jj] * o[it][0][jj] + o[it][1][jj] * o[it][1][jj];
        s1 = rowsum16(s1); s2 = rowsum16(s2);
        if (l15 == 0) { const int i = it * 16 + l4 * 4 + jj; part[(w * 64 + i) * 2] = s1; part[(w * 64 + i) * 2 + 1] = s2; }
      }
    const float gn[2] = {p.ret_gn_g[h * 128 + 32 * w + l15], p.ret_gn_g[h * 128 + 32 * w + 16 + l15]};
    __syncthreads();
#pragma unroll
    for (int it = 0; it < 4; ++it)
#pragma unroll
      for (int jj = 0; jj < 4; ++jj) {
        const int i = it * 16 + l4 * 4 + jj;
        float s1 = 0.f, s2 = 0.f;
#pragma unroll
        for (int ww = 0; ww < 4; ++ww) { s1 += part[(ww * 64 + i) * 2]; s2 += part[(ww * 64 + i) * 2 + 1]; }
        const float mean = s1 * (1.f / 128.f), var = fmaxf(s2 * (1.f / 128.f) - mean * mean, 0.f), rstd = rsqrtf(var + 1e-6f);
        if (i < Lc) {
#pragma unroll
          for (int vt = 0; vt < 2; ++vt) {
            const int v = 32 * w + vt * 16 + l15;
            bf16_t* gp = GR + (size_t)(rowbase + t0 + i) * 512 + h * 128 + v;
            *gp = (bf16_t)f2bf((o[it][vt][jj] - mean) * rstd * gn[vt] * bf2f(grv[it][jj][vt]));
          }
        }
      }
  }
  if (S_out)
#pragma unroll
  for (int vt = 0; vt < 2; ++vt)
#pragma unroll
    for (int dt = 0; dt < 4; ++dt)
      *(float4*)(S_out + (size_t)(dt * 16 + l15) * 128 + 32 * w + vt * 16 + l4 * 4) = make_float4(ST[vt][dt][0], ST[vt][dt][1], ST[vt][dt][2], ST[vt][dt][3]);
}

constexpr size_t OO_LOC = 56000000;
constexpr int NQ_LIGHT = 4608, NQ_TOTAL = 4608 + 3 * 704;
__device__ __forceinline__ void phase_scan(const Params& p, unsigned char* lds, volatile LAS unsigned* qslot) {
  const int G = gridDim.x;
  unsigned* flags_all = (unsigned*)(p.ws + OFF_BAR + 14336);
  unsigned* qctr = (unsigned*)(p.ws + OFF_BAR + 15360);
  float* loc_all = (float*)((unsigned char*)p.out + OO_LOC);
  int hid = blockIdx.x;
  bool heavy = true;
#pragma unroll 1
  while (true) {
    int item;
    if (heavy) { if (hid < 384) { item = hid; hid += G; } else { heavy = false; continue; } }
    else {
      __syncthreads();
      if (threadIdx.x == 0) *qslot = atomicAdd(qctr, 1u);
      __syncthreads();
      const int qi = (int)*qslot;
      if (qi >= NQ_TOTAL) break;
      item = 384 + qi;
    }
    int kind; int rowbase = 0, T = 0, h = 0, rb = 0, cb = 0, ce = 0, seg = -1; const float* shp = nullptr; const float* sin = nullptr; float* sout = nullptr; float* loc = nullptr; unsigned* flg = nullptr;
    if (item < 256) { const int seq = item >> 2, b = seq >> 3; rb = item & 3; h = seq & 7; kind = 0; rowbase = b * TP; T = TP; sout = p.out + O_WKVP + (size_t)seq * 4096; }
    else if (item < 384) { const int idx = item - 256, bh = idx >> 2, b = bh >> 2; seg = idx & 3; h = bh & 3; kind = 1; rowbase = b * TP; T = TP; cb = seg * 8; ce = seg == 3 ? 33 : cb + 8;
      sout = seg == 3 ? p.out + O_RETP + (size_t)bh * 8192 : nullptr; loc = loc_all + (size_t)bh * 3 * 8192; flg = flags_all + bh * 4; }
    else if (item < 384 + 4096) { const int it = item - 384, seq = it >> 2, b = seq >> 3; rb = it & 3; h = seq & 7; kind = 0; rowbase = MP + b * 4; T = 4;
      shp = p.state_shift + (size_t)b * 1792; sin = p.state_wkv + (size_t)seq * 4096; sout = p.out + O_WKVS + (size_t)seq * 4096; }
    else if (item < 384 + NQ_LIGHT) { const int bh = item - 384 - 4096, b = bh >> 2; h = bh & 3; kind = 1; rowbase = MP + b * 4; T = 4; cb = 0; ce = 1; sin = p.state_ret + (size_t)bh * 8192; sout = p.out + O_RETS + (size_t)bh * 8192; }
    else kind = 2;
    if (kind == 0) rwkv_item(p, rowbase, T, h, rb, shp, sin, sout, lds);
    else if (kind == 1) ret_item(p, rowbase, T, h, sin, sout, lds, cb, ce, seg, loc, flg);
    else {
      const int tt = item - 384 - NQ_LIGHT, job = tt / 704, t = tt - job * 704;
      const float* src = job == 0 ? p.ffn2_wg : (job == 1 ? p.ffn2_wu : p.ffn2_wd);
      transpose_tile(src, job == 2 ? 2816 : 1024, job == 2 ? 1024 : 2816, (bf16_t*)(p.ws + (job == 2 ? OFF_W1D : OFF_W1GU)), job == 2 ? 1 : 2, job == 1 ? 1 : 0, t, lds);
    }
  }
}

__device__ __forceinline__ void phase_post(const Params& p, unsigned char* lds) {
  const int tid = threadIdx.x, h = (tid >> 4) & 7, c4 = tid & 15, ch = h * 64 + c4 * 4;
  bf16_t* Y = (bf16_t*)(p.ws + OFF_Y); const bf16_t* PR = (const bf16_t*)(p.ws + OFF_PR);
  const bf16_t* GG = (const bf16_t*)((unsigned char*)p.out + OO_GG); const float* RHO = (const float*)((unsigned char*)p.out + OO_RHO);
  float muv[4], lg[4], lb[4];
#pragma unroll
  for (int e = 0; e < 4; ++e) { muv[e] = p.mu[1024 + ch + e]; lg[e] = p.lnx_g[ch + e]; lb[e] = p.lnx_b[ch + e]; }
  for (int pr = blockIdx.x; pr < M_TOK / 2; pr += gridDim.x) {
    const int row = pr * 2 + (tid >> 7);
    float y[4], cv[4], qv[4], g[4];
    unpk4(*(const uint2*)(Y + (size_t)row * 512 + ch), y);
    unpk4(*(const uint2*)(PR + (size_t)row * 1792 + 1024 + ch), cv);
    unpk4(*(const uint2*)(GG + (size_t)row * 512 + ch), g);
    bool first; const float* sprev = nullptr;
    if (row < MP) first = (row % TP) == 0; else { const int r2 = row - MP; first = (r2 & 3) == 0; sprev = p.state_shift + (size_t)(r2 >> 2) * 1792 + 1024 + ch; }
    if (!first) unpk4(*(const uint2*)(PR + (size_t)(row - 1) * 1792 + 1024 + ch), qv);
    else {
#pragma unroll
      for (int e = 0; e < 4; ++e) qv[e] = sprev ? sprev[e] : 0.f;
    }
    const float rho = RHO[(size_t)row * 8 + h];
    float s = y[0] + y[1] + y[2] + y[3]; s = rowsum16(s);
    const float mean = s * (1.f / 64.f);
    float d[4], q = 0.f;
#pragma unroll
    for (int e = 0; e < 4; ++e) { d[e] = y[e] - mean; q += d[e] * d[e]; }
    q = rowsum16(q);
    const float rstd = rsqrtf(q * (1.f / 64.f) + 64e-5f);
    float o[4];
#pragma unroll
    for (int e = 0; e < 4; ++e) { const float v = cv[e] + (qv[e] - cv[e]) * muv[e]; o[e] = (d[e] * rstd * lg[e] + lb[e] + rho * v) * g[e]; }
    *(uint2*)(Y + (size_t)row * 512 + ch) = pk4(o[0], o[1], o[2], o[3]);
  }
}

__device__ __forceinline__ void phase_merge(const Params& p, unsigned char* lds) {
  const bf16_t* OR = (const bf16_t*)(p.ws + OFF_GR); const bf16_t* OW = (const bf16_t*)(p.ws + OFF_Y);
  const bf16_t* WR = (const bf16_t*)(p.ws + OFF_WR); const bf16_t* WWp = (const bf16_t*)(p.ws + OFF_WW);
  const bf16_t* GA = (const bf16_t*)((unsigned char*)p.out + OO_GA); const bf16_t* GB = (const bf16_t*)(p.ws + OFF_GB);
  bf16_t* MG = (bf16_t*)(p.ws + OFF_MG);
  const int nM = NMT, nN = 8;
  for (int L = blockIdx.x; L < nM * nN; L += gridDim.x) {
    int tm, tn; tile_coords(L, nM, nN, tm, tn);
    f32x4 acc[8][4]; ZERO_ACC8(acc);
    gemm_tile_dma(OR, 512, WR, 512, 512, tm * 256, tn * 128, acc, lds);
    EPI_VARS8;
#pragma unroll
    for (int mi = 0; mi < 8; ++mi) {
      const int row = rbase + mi * 16;
      if (row < M_TOK) {
#pragma unroll
        for (int ni = 0; ni < 4; ++ni) { float g[4]; unpk4(*(const uint2*)(GA + (size_t)row * 1024 + cbase + ni * 16), g);
          *(uint2*)(MG + (size_t)row * 1024 + cbase + ni * 16) = pk4(acc[mi][ni][0] * g[0], acc[mi][ni][1] * g[1], acc[mi][ni][2] * g[2], acc[mi][ni][3] * g[3]); }
      }
    }
    ZERO_ACC8(acc);
    gemm_tile_dma(OW, 512, WWp, 512, 512, tm * 256, tn * 128, acc, lds);
#pragma unroll
    for (int mi = 0; mi < 8; ++mi) {
      const int row = rbase + mi * 16;
      if (row < M_TOK) {
#pragma unroll
        for (int ni = 0; ni < 4; ++ni) { float g[4], t[4]; unpk4(*(const uint2*)(GB + (size_t)row * 1024 + cbase + ni * 16), g);
          uint2* mp = (uint2*)(MG + (size_t)row * 1024 + cbase + ni * 16); unpk4(*mp, t);
          *mp = pk4(t[0] + acc[mi][ni][0] * g[0], t[1] + acc[mi][ni][1] * g[1], t[2] + acc[mi][ni][2] * g[2], t[3] + acc[mi][ni][3] * g[3]); }
      }
    }
  }
}

__device__ __forceinline__ void phase_wout(const Params& p, unsigned char* lds) {
  const bf16_t* A = (const bf16_t*)(p.ws + OFF_MG); const bf16_t* W = (const bf16_t*)(p.ws + OFF_WO); bf16_t* H = (bf16_t*)(p.ws + OFF_H);
  const int nM = NMT, nN = 8;
  for (int L = blockIdx.x; L < nM * nN; L += gridDim.x) {
    int tm, tn; tile_coords(L, nM, nN, tm, tn);
    f32x4 acc[8][4]; ZERO_ACC8(acc);
    gemm_tile_dma(A, 1024, W, 1024, 1024, tm * 256, tn * 128, acc, lds);
    EPI_VARS8;
#pragma unroll
    for (int mi = 0; mi < 8; ++mi) {
      const int row = rbase + mi * 16;
      if (row < M_TOK) {
#pragma unroll
        for (int ni = 0; ni < 4; ++ni) { bf16_t* hp = H + (size_t)row * 1024 + cbase + ni * 16; float h[4]; unpk4(*(const uint2*)hp, h); const f32x4 a = acc[mi][ni];
          *(uint2*)hp = pk4(h[0] + a[0], h[1] + a[1], h[2] + a[2], h[3] + a[3]); }
      }
    }
  }
}

__global__ void __launch_bounds__(256, 2) mega(Params p) {
  extern __shared__ __attribute__((aligned(16))) unsigned char lds[];
  cg::grid_group grid = cg::this_grid();
  const int lo = p.phase_lo, hi = p.phase_hi;
  __shared__ uint4 xb_words;
  if (threadIdx.x == 0) xb_words = make_uint4(0u, 0u, 0u, 0u);
  __syncthreads();
  XcdBarrier xb = xcd_barrier_post((unsigned*)(p.ws + OFF_BAR), (volatile LAS unsigned*)&xb_words);
  if (hi > 1000) grid.sync();
#define RUN_PHASE(k, call) if (PEN(k) && lo <= (k) && (k) < hi) { if ((k) > lo) xcd_barrier(xb); call; if (((DUPMASK) >> (k)) & 1) { call; } }
  RUN_PHASE(0, phase0(p, lds))
  RUN_PHASE(1, phase_ffn_up(p, lds))
  RUN_PHASE(2, phase_ffn_down<true>(p, lds))
  RUN_PHASE(3, (rmsnorm_phase<1, 0>(p, p.mix_norm, (bf16_t*)(p.ws + OFF_A))))
  RUN_PHASE(4, phase_win(p, lds))
  RUN_PHASE(5, phase_lora_mfma(p, lds))
  RUN_PHASE(6, phase_scan(p, lds, ((volatile LAS unsigned*)&xb_words) + 2))
  RUN_PHASE(7, phase_post(p, lds))
  RUN_PHASE(8, phase_merge(p, lds))
  RUN_PHASE(9, phase_wout(p, lds))
  RUN_PHASE(10, (rmsnorm_phase<1, 0>(p, p.ffn2_norm, (bf16_t*)(p.ws + OFF_A))))
  RUN_PHASE(11, phase_ffn_up(p, lds))
  RUN_PHASE(12, phase_ffn_down<false>(p, lds))
  RUN_PHASE(13, (rmsnorm_phase<2, 1>(p, p.final_norm, nullptr)))
}

extern "C" void kernel_launch(void* const* d_in, const int* in_sizes, int n_in, void* d_out, int out_size, void* d_ws, size_t ws_size, hipStream_t stream) {
  static int grid_blocks = 0;
  if (grid_blocks == 0) {
    if (n_in != 32 || ws_size < WS_NEED || out_size != 26458112) { fprintf(stderr, "kernel_launch: unexpected sizes n_in %d ws %zu out %d\n", n_in, ws_size, out_size); grid_blocks = -1; return; }
    int dev = 0, cus = 0, per_cu = 0;
    hipGetDevice(&dev);
    hipDeviceGetAttribute(&cus, hipDeviceAttributeMultiprocessorCount, dev);
    if (hipFuncSetAttribute((const void*)mega, hipFuncAttributeMaxDynamicSharedMemorySize, LDS_BYTES) != hipSuccess) { fprintf(stderr, "hipFuncSetAttribute failed\n"); grid_blocks = -1; return; }
    hipOccupancyMaxActiveBlocksPerMultiprocessor(&per_cu, (const void*)mega, NT, LDS_BYTES);
    if (per_cu < 1) { fprintf(stderr, "occupancy query returned %d\n", per_cu); grid_blocks = -1; return; }
    if (per_cu > 2) per_cu = 2;
    grid_blocks = cus * per_cu;
  }
  if (grid_blocks < 0) return;
  if (hipMemsetAsync((unsigned char*)d_ws + OFF_BAR, 0, 16384, stream) != hipSuccess) { fprintf(stderr, "memset failed\n"); return; }
  Params p{};
  const float** pp = (const float**)&p;
  for (int i = 0; i < 32; ++i) pp[i] = (const float*)d_in[i];
  p.out = (float*)d_out; p.ws = (unsigned char*)d_ws;
  for (int j = 0; j < 32; ++j) p.invf[j] = (float)pow(10000.0, -(double)j / 32.0);
  for (int h = 0; h < 4; ++h) p.lg2g[h] = (float)log2(1.0 - exp2(-5.0 - (double)h));
#if SINGLE_LAUNCH
  p.phase_lo = 0; p.phase_hi = NPHASE;
  void* args[] = {&p};
  hipError_t e = hipLaunchCooperativeKernel((const void*)mega, dim3(grid_blocks), dim3(NT), args, LDS_BYTES, stream);
  if (e != hipSuccess) fprintf(stderr, "cooperative launch failed: %s (grid %d)\n", hipGetErrorString(e), grid_blocks);
#else
  for (int ph = 0; ph < NPHASE; ++ph) {
    p.phase_lo = ph; p.phase_hi = ph + 1;
    hipLaunchKernelGGL(mega, dim3(grid_blocks), dim3(NT), LDS_BYTES, stream, p);
  }
#endif
}
```

```cpp
#include <hip/hip_runtime.h>
#include <hip/hip_cooperative_groups.h>
#include <cstdio>
#include <cmath>
namespace cg = cooperative_groups;

#ifndef PHMASK
#define PHMASK 0xffff
#endif
#define PEN(k) (((PHMASK) >> (k)) & 1)
#ifndef DUPMASK
#define DUPMASK 0
#endif
#ifndef DUP6
#define DUP6 0
#endif
#ifndef PROBE_PHASE
#define PROBE_PHASE (-1)
#endif
#ifndef SINGLE_LAUNCH
#define SINGLE_LAUNCH 1
#endif

typedef unsigned short bf16_t;
typedef short bf16x8 __attribute__((ext_vector_type(8)));
typedef float f32x4 __attribute__((ext_vector_type(4)));
typedef unsigned u32x4 __attribute__((ext_vector_type(4)));
typedef float f32x2 __attribute__((ext_vector_type(2)));

constexpr int NT = 256;
constexpr int M_TOK = 17024, MP = 16512, TP = 2064;
constexpr int PAST = 16384;
constexpr int LDS_BYTES = 73728;
constexpr int NPHASE = 14;

constexpr size_t S1024 = (size_t)M_TOK * 1024 * 2;
constexpr size_t S512 = S1024 / 2;
constexpr size_t OFF_W1GU = 0;
constexpr size_t OFF_W1D = OFF_W1GU + 11534336;
constexpr size_t OFF_WIN = OFF_W1D + 5767168;
constexpr size_t OFF_WR = OFF_WIN + 11010048;
constexpr size_t OFF_WW = OFF_WR + 1048576;
constexpr size_t OFF_WO = OFF_WW + 1048576;
constexpr size_t OFF_H = OFF_WO + 2097152;
constexpr size_t OFF_T = OFF_H + S1024;
constexpr size_t OFF_A = OFF_T;
constexpr size_t OFF_HF = OFF_T + S1024;
constexpr size_t OFF_QK = OFF_HF;
constexpr size_t OFF_V = OFF_QK + S512;
constexpr size_t OFF_GR = OFF_V + S512;
constexpr size_t OFF_PR = OFF_GR + S512;
constexpr size_t OFF_GB = OFF_PR + (size_t)M_TOK * 1792 * 2;
constexpr size_t OFF_Y = OFF_GB + S1024;
constexpr size_t OFF_END = OFF_Y + S512;
constexpr size_t OFF_MG = OFF_QK;
constexpr size_t OFF_BAR = OFF_END;
constexpr size_t OFF_W2T = OFF_BAR + 16384, OFF_A2T = OFF_W2T + 65536, OFF_G2T = OFF_A2T + 65536;
constexpr size_t WS_NEED = OFF_G2T + 131072;
constexpr size_t OFF_H3 = OFF_HF + (size_t)M_TOK * 2816 * 2;
constexpr size_t OFF_LD = OFF_A, OFF_AA = OFF_A + S512;
static_assert(OFF_H3 + (size_t)M_TOK * 1024 * 4 == OFF_END, "map");
constexpr size_t OO_GA = 0, OO_GG = S1024, OO_RHO = S1024 + S512;
constexpr size_t O_YP = 0, O_YS = 16777216, O_RETP = 17301504, O_WKVP = 17563648, O_SHP = 17825792, O_RETS = 17840128, O_WKVS = 22034432, O_SHS = 26228736;

struct Params {
  const float *x_prompt, *x_sample, *state_ret, *state_wkv, *state_shift, *meta;
  const float *ffn1_norm, *ffn1_wg, *ffn1_wu, *ffn1_wd, *mix_norm, *w_in, *ret_gn_g, *mu, *w0, *w2, *a0, *a2, *g2, *k_k, *k_a, *r_k, *lnx_g, *lnx_b;
  const float *w_out_ret, *w_out_rwkv, *w_out, *ffn2_norm, *ffn2_wg, *ffn2_wu, *ffn2_wd, *final_norm;
  float* out;
  unsigned char* ws;
  float invf[32];
  float lg2g[4];
  int phase_lo, phase_hi;
};


#define XB_TMO      128
#define XB_XCNT(j)  (256  + 64 * (j))
#define XB_XSUB(j)  (1280 + 64 * (j))
#define XB_XGEN(j)  (2304 + 64 * (j))
#define XB_TOP      3328
#define XB_TOPGEN   3392
#define XCD_BAR_WORDS 3456
#define XB_SPIN_CAP (1u << 18)
#define LAS __attribute__((address_space(3)))
__device__ __forceinline__ unsigned xb_ld(unsigned* p)              { return __hip_atomic_load(p, __ATOMIC_RELAXED, __HIP_MEMORY_SCOPE_AGENT); }
__device__ __forceinline__ unsigned xb_add(unsigned* p, unsigned v) { return __hip_atomic_fetch_add(p, v, __ATOMIC_RELAXED, __HIP_MEMORY_SCOPE_AGENT); }
__device__ __forceinline__ unsigned xb_xcc_id() { return (unsigned)__builtin_amdgcn_s_getreg((3 << 11) | 20) & 0xFu; }
#define XB_SPIN(cond, bar) do { unsigned _sp = 0; while (cond) { __builtin_amdgcn_s_sleep(1); \
    if ((++_sp & 255u) == 0u) { if (xb_ld(&(bar)[XB_TMO])) break; if (_sp > XB_SPIN_CAP) { atomicAdd(&(bar)[XB_TMO], 1u); break; } } } } while (0)
struct XcdBarrier { unsigned* bar; unsigned x; volatile LAS unsigned* st; };
__device__ __forceinline__ XcdBarrier xcd_barrier_post(unsigned* bar, volatile LAS unsigned* st) {
    XcdBarrier b; b.bar = bar; b.x = xb_xcc_id(); b.st = st;
    if (threadIdx.x == 0) (void)xb_add(&bar[XB_XCNT(b.x)], 1u);
    return b;
}
__device__ __forceinline__ void xcd_barrier_complete(unsigned* bar, unsigned x, unsigned& nloc, unsigned& nx) {
    const unsigned G = gridDim.x * gridDim.y * gridDim.z;
    unsigned sum, cnt, mine, sp = 0u;
    for (;;) {
        sum = 0u; cnt = 0u; mine = 0u;
#pragma unroll
        for (unsigned j = 0; j < 16; ++j) { const unsigned c = xb_ld(&bar[XB_XCNT(j)]); sum += c; cnt += (c > 0u) ? 1u : 0u; mine = (j == x) ? c : mine; }
        if (sum == G) break;
        __builtin_amdgcn_s_sleep(1);
        if ((++sp & 255u) == 0u) { if (xb_ld(&bar[XB_TMO])) break; if (sp > XB_SPIN_CAP) { atomicAdd(&bar[XB_TMO], 1u); break; } }
    }
    nloc = mine > 0u ? mine : 1u; nx = cnt > 0u ? cnt : 1u;
}
__device__ __forceinline__ void xcd_barrier(const XcdBarrier& b) {
    asm volatile("s_waitcnt vmcnt(0)" ::: "memory");
    __syncthreads();
    if (threadIdx.x == 0) {
        unsigned* bar = b.bar;
        __builtin_amdgcn_s_waitcnt(0);
        unsigned nloc = b.st[0], nx = b.st[1];
        if (nloc == 0u) { xcd_barrier_complete(bar, b.x, nloc, nx); b.st[0] = nloc; b.st[1] = nx; }
        const unsigned old = xb_add(&bar[XB_XSUB(b.x)], 1u);
        const unsigned gen = old / nloc;
        if (old + 1u == (gen + 1u) * nloc) {
            __builtin_amdgcn_fence(__ATOMIC_RELEASE, "agent");
            asm volatile("s_waitcnt vmcnt(0)" ::: "memory");
            const unsigned og = xb_add(&bar[XB_TOP], 1u);
            const unsigned tg = og / nx;
            if (og + 1u == (tg + 1u) * nx) xb_add(&bar[XB_TOPGEN], 1u);
            else XB_SPIN(xb_ld(&bar[XB_TOPGEN]) == tg, bar);
            __builtin_amdgcn_fence(__ATOMIC_ACQUIRE, "agent");
            xb_add(&bar[XB_XGEN(b.x)], 1u);
            asm volatile("s_waitcnt vmcnt(0)" ::: "memory");
        } else {
            XB_SPIN(xb_ld(&bar[XB_XGEN(b.x)]) == gen, bar);
            __builtin_amdgcn_fence(__ATOMIC_ACQUIRE, "agent");
            asm volatile("s_waitcnt vmcnt(0)" ::: "memory");
        }
    }
    __syncthreads();
}

__device__ __forceinline__ float bf2f(unsigned h) { return __uint_as_float(h << 16); }
__device__ __forceinline__ unsigned f2bf(float f) { unsigned u = __float_as_uint(f); return (u + 0x7fffu + ((u >> 16) & 1u)) >> 16; }
__device__ __forceinline__ unsigned pk2(float a, float b) { return f2bf(a) | (f2bf(b) << 16); }
__device__ __forceinline__ uint2 pk4(float a, float b, float c, float d) { uint2 r; r.x = pk2(a, b); r.y = pk2(c, d); return r; }
__device__ __forceinline__ void unpk4(uint2 u, float (&o)[4]) { o[0] = __uint_as_float(u.x << 16); o[1] = __uint_as_float(u.x & 0xffff0000u); o[2] = __uint_as_float(u.y << 16); o[3] = __uint_as_float(u.y & 0xffff0000u); }
template <int CTRL> __device__ __forceinline__ float dppf(float x) { return __builtin_bit_cast(float, __builtin_amdgcn_update_dpp(0, __builtin_bit_cast(int, x), CTRL, 0xf, 0xf, true)); }
__device__ __forceinline__ float rowsum16(float x) { x += dppf<0xB1>(x); x += dppf<0x4E>(x); x += dppf<0x141>(x); x += dppf<0x140>(x); return x; }
__device__ __forceinline__ float wavesum(float x) {
#pragma unroll
  for (int o = 32; o >= 1; o >>= 1) x += __shfl_xor(x, o);
  return x;
}
__device__ __forceinline__ float sigmoidf(float x) { return 1.f / (1.f + __expf(-x)); }
__device__ __forceinline__ float siluf(float x) { return x / (1.f + __expf(-x)); }

__device__ __forceinline__ const float* x_row(const Params& p, int row) {
  if (row < MP) { const int b = row / TP, t = row - b * TP; return t < 16 ? p.meta + t * 1024 : p.x_prompt + (size_t)(b * 2048 + t - 16) * 1024; }
  return p.x_sample + (size_t)(row - MP) * 1024;
}

__device__ __forceinline__ void transpose_tile(const float* __restrict__ src, int K, int N, bf16_t* __restrict__ dst, int rs, int ro, int t, unsigned char* lds) {
  float* tile = (float*)lds;
  const int tid = threadIdx.x;
  const int tn = N / 64;
  const int k0 = (t / tn) * 64, n0 = (t % tn) * 64;
  __syncthreads();
  { const int n = tid & 63, kq = tid >> 6;
#pragma unroll
    for (int i = 0; i < 16; ++i) { const int k = kq + 4 * i; tile[k * 65 + n] = src[(size_t)(k0 + k) * N + n0 + n]; } }
  __syncthreads();
  { const int kp = tid & 31, nq = tid >> 5;
#pragma unroll
    for (int i = 0; i < 8; ++i) { const int n = nq + 8 * i; const float v0 = tile[(2 * kp) * 65 + n], v1 = tile[(2 * kp + 1) * 65 + n];
      *(unsigned*)(dst + (size_t)((n0 + n) * rs + ro) * K + k0 + 2 * kp) = pk2(v0, v1); } }
}
__device__ __forceinline__ void transpose_tiles(const float* __restrict__ src, int K, int N, bf16_t* __restrict__ dst, int rs, int ro, unsigned char* lds) {
  const int nt = (K / 64) * (N / 64);
#pragma unroll 1
  for (int t = blockIdx.x; t < nt; t += gridDim.x) transpose_tile(src, K, N, dst, rs, ro, t, lds);
}

template <int SRC, int DST> __device__ __forceinline__ void rmsnorm_phase(const Params& p, const float* __restrict__ g, bf16_t* dstb) {
  const int lane = threadIdx.x & 63, wid = threadIdx.x >> 6;
  const bf16_t* H = (const bf16_t*)(p.ws + OFF_H);
  const float* H3 = (const float*)(p.ws + OFF_H3);
  for (int row = blockIdx.x * 4 + wid; row < M_TOK; row += gridDim.x * 4) {
    float v[16];
    const float* xr = SRC == 0 ? x_row(p, row) : nullptr;
#pragma unroll
    for (int i = 0; i < 4; ++i) {
      const int col = i * 256 + lane * 4;
      if (SRC == 0) { const float4 t = *(const float4*)(xr + col); v[4 * i] = t.x; v[4 * i + 1] = t.y; v[4 * i + 2] = t.z; v[4 * i + 3] = t.w; }
      else if (SRC == 1) { const uint2 u = *(const uint2*)(H + (size_t)row * 1024 + col); float o[4]; unpk4(u, o); v[4 * i] = o[0]; v[4 * i + 1] = o[1]; v[4 * i + 2] = o[2]; v[4 * i + 3] = o[3]; }
      else { const float4 t = *(const float4*)(H3 + (size_t)row * 1024 + col); v[4 * i] = t.x; v[4 * i + 1] = t.y; v[4 * i + 2] = t.z; v[4 * i + 3] = t.w; }
    }
    float ss = 0.f;
#pragma unroll
    for (int i = 0; i < 16; ++i) ss += v[i] * v[i];
    ss = wavesum(ss);
    const float rstd = rsqrtf(ss * (1.f / 1024.f) + 1e-6f);
    float* orow = nullptr;
    if (DST == 1) {
      if (row < MP) { const int b = row / TP, t = row - b * TP; if (t >= 16) orow = p.out + O_YP + (size_t)(b * 2048 + t - 16) * 1024; }
      else orow = p.out + O_YS + (size_t)(row - MP) * 1024;
    }
#pragma unroll
    for (int i = 0; i < 4; ++i) {
      const int col = i * 256 + lane * 4;
      const float4 gv = *(const float4*)(g + col);
      const float y0 = v[4 * i] * rstd * gv.x, y1 = v[4 * i + 1] * rstd * gv.y, y2 = v[4 * i + 2] * rstd * gv.z, y3 = v[4 * i + 3] * rstd * gv.w;
      if (DST == 0) *(uint2*)(dstb + (size_t)row * 1024 + col) = pk4(y0, y1, y2, y3);
      else if (orow) *(float4*)(orow + col) = make_float4(y0, y1, y2, y3);
    }
  }
}

#define RAW_BARRIER() do { asm volatile("s_waitcnt lgkmcnt(0)" ::: "memory"); __builtin_amdgcn_s_barrier(); asm volatile("" ::: "memory"); } while (0)
template <int MI> __device__ __forceinline__ void gemm_tile_dma(const bf16_t* __restrict__ A, int lda, const bf16_t* __restrict__ Bt, int ldb, int K, int m0, int n0, f32x4 (&acc)[MI][4], unsigned char* lds) {
  constexpr int BMT = 32 * MI, NA = 2 * MI, NAW = (NA + 3) / 4, STG = (BMT + 128) * 64;
  static_assert(3 * STG <= LDS_BYTES, "ring does not fit");
  const int tid = threadIdx.x, lane = tid & 63, wid = tid >> 6, wm = wid >> 1, wn = wid & 1, l15 = lane & 15, l4 = lane >> 4;
  const int nk = K >> 5;
  const int qd = (lane >> 4) & 3, cs = ((lane & 3) ^ (((qd << 1) ^ ((qd >> 1) * 3)) & 3)) * 8;
  const bf16_t* ag[NAW]; const bf16_t* bg[2];
#pragma unroll
  for (int i = 0; i < NAW; ++i) { int row = m0 + (wid + 4 * i) * 16 + (lane >> 2); row = row < M_TOK ? row : M_TOK - 1; ag[i] = A + (size_t)row * lda + cs; }
#pragma unroll
  for (int i = 0; i < 2; ++i) { const int row = n0 + (wid * 2 + i) * 16 + (lane >> 2); bg[i] = Bt + (size_t)row * ldb + cs; }
  auto issue = [&](int kt, int buf) {
    unsigned char* sb = lds + buf * STG + lane * 16;
#pragma unroll
    for (int i = 0; i < NAW; ++i) if (wid + 4 * i < NA) __builtin_amdgcn_global_load_lds((const unsigned*)(ag[i] + kt * 32), (LAS unsigned*)(sb + (wid + 4 * i) * 1024), 16, 0, 0);
#pragma unroll
    for (int i = 0; i < 2; ++i) __builtin_amdgcn_global_load_lds((const unsigned*)(bg[i] + kt * 32), (LAS unsigned*)(sb + BMT * 64 + (wid * 2 + i) * 1024), 16, 0, 0);
  };
  const int qr = (l15 >> 2) & 3, sw = ((l4 ^ ((qr << 1) ^ ((qr >> 1) * 3))) & 3) * 16;
  const int aofs = (wm * 16 * MI + l15) * 64 + sw, bofs = BMT * 64 + (wn * 64 + l15) * 64 + sw;
  const bool big = (NA % 4 == 0) || (wid < NA % 4);
  RAW_BARRIER();
  issue(0, 0);
  if (nk > 1) issue(1, 1);
  int bc = 0, bi = 2;
  for (int kt = 0; kt < nk; ++kt) {
    if (kt + 1 < nk) {
      if (MI == 8) asm volatile("s_waitcnt vmcnt(6)" ::: "memory");
      else if (big) asm volatile("s_waitcnt vmcnt(5)" ::: "memory");
      else asm volatile("s_waitcnt vmcnt(4)" ::: "memory");
    } else asm volatile("s_waitcnt vmcnt(0)" ::: "memory");
    RAW_BARRIER();
    if (kt + 2 < nk) issue(kt + 2, bi);
    const unsigned char* st = lds + bc * STG;
    bf16x8 af[MI], bfr[4];
#pragma unroll
    for (int i = 0; i < MI; ++i) af[i] = *(const bf16x8*)(st + aofs + i * 1024);
#pragma unroll
    for (int i = 0; i < 4; ++i) bfr[i] = *(const bf16x8*)(st + bofs + i * 1024);
#pragma unroll
    for (int mi = 0; mi < MI; ++mi)
#pragma unroll
      for (int ni = 0; ni < 4; ++ni) acc[mi][ni] = __builtin_amdgcn_mfma_f32_16x16x32_bf16(bfr[ni], af[mi], acc[mi][ni], 0, 0, 0);
    bc = bc == 2 ? 0 : bc + 1; bi = bi == 2 ? 0 : bi + 1;
  }
}

#ifndef GMT
#define GMT 4
#endif
__device__ __forceinline__ void tile_coords(int L, int nM, int nN, int& tm, int& tn) {
  const int nwg = nM * nN, q = nwg / 8, r = nwg % 8, xcd = L % 8, off = L / 8;
  const int wg = (xcd < r ? xcd * (q + 1) : r * (q + 1) + (xcd - r) * q) + off;
  const int nig = GMT * nN, gid = wg / nig, fm = gid * GMT, gsz = min(nM - fm, GMT);
  tm = fm + (wg % nig) % gsz; tn = (wg % nig) / gsz;
}

#define ZERO_ACC(a) _Pragma("unroll") for (int _i = 0; _i < 4; ++_i) _Pragma("unroll") for (int _j = 0; _j < 4; ++_j) a[_i][_j] = (f32x4){0.f, 0.f, 0.f, 0.f}
#define ZERO_ACC8(a) _Pragma("unroll") for (int _i = 0; _i < 8; ++_i) _Pragma("unroll") for (int _j = 0; _j < 4; ++_j) a[_i][_j] = (f32x4){0.f, 0.f, 0.f, 0.f}
#define EPI_VARS8 const int lane = threadIdx.x & 63, wid = threadIdx.x >> 6, wm = wid >> 1, wn = wid & 1; const int rbase = tm * 256 + wm * 128 + (lane & 15), cbase = tn * 128 + wn * 64 + (lane >> 4) * 4
#define NMT 67
#define PIN_U2_ROW(arr, mi) asm volatile("" : "+v"(arr[mi][0].x), "+v"(arr[mi][0].y), "+v"(arr[mi][1].x), "+v"(arr[mi][1].y), "+v"(arr[mi][2].x), "+v"(arr[mi][2].y), "+v"(arr[mi][3].x), "+v"(arr[mi][3].y))
#define PIN_U2(arr) do { PIN_U2_ROW(arr, 0); PIN_U2_ROW(arr, 1); PIN_U2_ROW(arr, 2); PIN_U2_ROW(arr, 3); PIN_U2_ROW(arr, 4); } while (0)
#define PIN_F4_ROW(arr, mi) asm volatile("" : "+v"(arr[mi][0]), "+v"(arr[mi][1]), "+v"(arr[mi][2]), "+v"(arr[mi][3]))
#define PIN_F4(arr) do { PIN_F4_ROW(arr, 0); PIN_F4_ROW(arr, 1); PIN_F4_ROW(arr, 2); PIN_F4_ROW(arr, 3); PIN_F4_ROW(arr, 4); } while (0)
#define NMT5 107
#define ZERO_ACC5(a) _Pragma("unroll") for (int _i = 0; _i < 5; ++_i) _Pragma("unroll") for (int _j = 0; _j < 4; ++_j) a[_i][_j] = (f32x4){0.f, 0.f, 0.f, 0.f}
#define EPI_VARS5 const int lane = threadIdx.x & 63, wid = threadIdx.x >> 6, wm = wid >> 1, wn = wid & 1; const int rbase = tm * 160 + wm * 80 + (lane & 15), cbase = tn * 128 + wn * 64 + (lane >> 4) * 4
#define EPI_VARS const int lane = threadIdx.x & 63, wid = threadIdx.x >> 6, wm = wid >> 1, wn = wid & 1; const int rbase = tm * 128 + wm * 64 + (lane & 15), cbase = tn * 128 + wn * 64 + (lane >> 4) * 4

__device__ __forceinline__ void transpose_jobs(const Params& p, int jlo, int jhi, unsigned char* lds) {
  unsigned char* ws = p.ws;
#pragma unroll 1
  for (int j = jlo; j < jhi; ++j) {
    const float* src; int K, N, rs = 1, ro = 0; size_t off;
    switch (j) {
      case 0: src = p.ffn1_wg; K = 1024; N = 2816; off = OFF_W1GU; rs = 2; break;
      case 1: src = p.ffn1_wu; K = 1024; N = 2816; off = OFF_W1GU; rs = 2; ro = 1; break;
      case 2: src = p.ffn1_wd; K = 2816; N = 1024; off = OFF_W1D; break;
      case 3: src = p.w_in; K = 1024; N = 5376; off = OFF_WIN; break;
      case 4: src = p.w_out_ret; K = 512; N = 1024; off = OFF_WR; break;
      case 5: src = p.w_out_rwkv; K = 512; N = 1024; off = OFF_WW; break;
      case 6: src = p.w_out; K = 1024; N = 1024; off = OFF_WO; break;
      case 7: src = p.ffn2_wg; K = 1024; N = 2816; off = OFF_W1GU; rs = 2; break;
      case 8: src = p.ffn2_wu; K = 1024; N = 2816; off = OFF_W1GU; rs = 2; ro = 1; break;
      case 9: src = p.ffn2_wd; K = 2816; N = 1024; off = OFF_W1D; break;
      case 10: src = p.w2; K = 64; N = 512; off = OFF_W2T; break;
      case 11: src = p.a2; K = 64; N = 512; off = OFF_A2T; break;
      default: src = p.g2; K = 128; N = 512; off = OFF_G2T; break;
    }
    transpose_tiles(src, K, N, (bf16_t*)(ws + off), rs, ro, lds);
  }
}
__device__ __forceinline__ void phase0(const Params& p, unsigned char* lds) {
  transpose_jobs(p, 0, 7, lds);
  transpose_jobs(p, 10, 13, lds);
  rmsnorm_phase<0, 0>(p, p.ffn1_norm, (bf16_t*)(p.ws + OFF_A));
}

__device__ __forceinline__ void phase_ffn_up(const Params& p, unsigned char* lds) {
  const bf16_t* A = (const bf16_t*)(p.ws + OFF_A); const bf16_t* W = (const bf16_t*)(p.ws + OFF_W1GU); bf16_t* HF = (bf16_t*)(p.ws + OFF_HF);
  const int nM = NMT, nN = 5632 / 128;
  for (int L = blockIdx.x; L < nM * nN; L += gridDim.x) {
    int tm, tn; tile_coords(L, nM, nN, tm, tn);
    f32x4 acc[8][4]; ZERO_ACC8(acc);
    gemm_tile_dma<8>(A, 1024, W, 1024, 1024, tm * 256, tn * 128, acc, lds);
    EPI_VARS8;
#pragma unroll
    for (int mi = 0; mi < 8; ++mi) {
      const int row = rbase + mi * 16;
      if (row < M_TOK) {
#pragma unroll
        for (int ni = 0; ni < 4; ++ni) {
          const int c = (cbase + ni * 16) >> 1; const f32x4 a = acc[mi][ni];
          *(unsigned*)(HF + (size_t)row * 2816 + c) = pk2(siluf(a[0]) * a[1], siluf(a[2]) * a[3]);
        }
      }
    }
  }
}

template <bool FIRST> __device__ __forceinline__ void phase_ffn_down(const Params& p, unsigned char* lds) {
  const bf16_t* A = (const bf16_t*)(p.ws + OFF_HF); const bf16_t* W = (const bf16_t*)(p.ws + OFF_W1D);
  bf16_t* H = (bf16_t*)(p.ws + OFF_H); float* H3 = (float*)(p.ws + OFF_H3);
  const int nM = NMT5, nN = 8;
  for (int L = blockIdx.x; L < nM * nN; L += gridDim.x) {
    int tm, tn; tile_coords(L, nM, nN, tm, tn);
    f32x4 acc[5][4]; ZERO_ACC5(acc);
    gemm_tile_dma<5>(A, 2816, W, 2816, 2816, tm * 160, tn * 128, acc, lds);
    EPI_VARS5;
    f32x4 xin[5][4]; uint2 hin[5][4];
#pragma unroll
    for (int mi = 0; mi < 5; ++mi) {
      int row = rbase + mi * 16; row = row < M_TOK ? row : M_TOK - 1;
      const float* xr = FIRST ? x_row(p, row) : nullptr;
#pragma unroll
      for (int ni = 0; ni < 4; ++ni) {
        const int col = cbase + ni * 16;
        if (FIRST) xin[mi][ni] = *(const f32x4*)(xr + col); else hin[mi][ni] = *(const uint2*)(H + (size_t)row * 1024 + col);
      }
    }
#pragma unroll
    for (int mi = 0; mi < 5; ++mi)
#pragma unroll
      for (int ni = 0; ni < 4; ++ni) {
        const f32x4 a = acc[mi][ni];
        if (FIRST) { const f32x4 xv = xin[mi][ni]; hin[mi][ni] = pk4(xv[0] + 0.5f * a[0], xv[1] + 0.5f * a[1], xv[2] + 0.5f * a[2], xv[3] + 0.5f * a[3]); }
        else { float h[4]; unpk4(hin[mi][ni], h); acc[mi][ni] = (f32x4){h[0] + 0.5f * a[0], h[1] + 0.5f * a[1], h[2] + 0.5f * a[2], h[3] + 0.5f * a[3]}; }
      }
    if (FIRST) PIN_U2(hin); else PIN_F4(acc);
#pragma unroll
    for (int mi = 0; mi < 5; ++mi) {
      const int row = rbase + mi * 16;
      if (row < M_TOK) {
#pragma unroll
        for (int ni = 0; ni < 4; ++ni) {
          const int col = cbase + ni * 16;
          if (FIRST) *(uint2*)(H + (size_t)row * 1024 + col) = hin[mi][ni];
          else *(f32x4*)(H3 + (size_t)row * 1024 + col) = acc[mi][ni];
        }
      }
    }
  }
}

__device__ __forceinline__ void rope_cs(float ang, float& c, float& s) {
  double rev = (double)ang * 0.15915494309189535; rev -= rint(rev); const float fr = (float)rev;
  s = __builtin_amdgcn_sinf(fr); c = __builtin_amdgcn_cosf(fr);
}
__device__ __forceinline__ void phase_win(const Params& p, unsigned char* lds) {
  const bf16_t* A = (const bf16_t*)(p.ws + OFF_A); const bf16_t* W = (const bf16_t*)(p.ws + OFF_WIN);
  bf16_t* QK = (bf16_t*)(p.ws + OFF_QK); bf16_t* V = (bf16_t*)(p.ws + OFF_V); bf16_t* GR = (bf16_t*)(p.ws + OFF_GR); bf16_t* PR = (bf16_t*)(p.ws + OFF_PR);
  bf16_t* GB = (bf16_t*)(p.ws + OFF_GB); bf16_t* GA = (bf16_t*)((unsigned char*)p.out + OO_GA);
  const int nM = NMT, nN = 5376 / 128;
  for (int L = blockIdx.x; L < nM * nN; L += gridDim.x) {
    int tm, tn; tile_coords(L, nM, nN, tm, tn);
    f32x4 acc[8][4]; ZERO_ACC8(acc);
    gemm_tile_dma<8>(A, 1024, W, 1024, 1024, tm * 256, tn * 128, acc, lds);
    EPI_VARS8;
    const int n0 = tn * 128;
    if (n0 < 512) {
      const float sc = n0 >= 256 ? 0.125f : 1.0f;
      const int hb = n0 + wn * 64;
#pragma unroll
      for (int mi = 0; mi < 8; ++mi) {
        const int row = rbase + mi * 16;
        if (row >= M_TOK) continue;
        const float pos = row < MP ? (float)(row % TP) : (float)(PAST + ((row - MP) & 3));
#pragma unroll
        for (int ni = 0; ni < 2; ++ni) {
          float o1[4], o2[4];
#pragma unroll
          for (int jj = 0; jj < 4; ++jj) {
            const int j = ni * 16 + (lane >> 4) * 4 + jj;
            float c, s; rope_cs(pos * p.invf[j], c, s);
            const float x1 = acc[mi][ni][jj], x2 = acc[mi][ni + 2][jj];
            o1[jj] = (x1 * c - x2 * s) * sc; o2[jj] = (x1 * s + x2 * c) * sc;
          }
          const int j0 = ni * 16 + (lane >> 4) * 4;
          *(uint2*)(QK + (size_t)row * 512 + hb + j0) = pk4(o1[0], o1[1], o1[2], o1[3]);
          *(uint2*)(QK + (size_t)row * 512 + hb + 32 + j0) = pk4(o2[0], o2[1], o2[2], o2[3]);
        }
      }
    } else {
#pragma unroll
      for (int mi = 0; mi < 8; ++mi) {
        const int row = rbase + mi * 16;
        if (row >= M_TOK) continue;
        float* sh = nullptr;
        if (row < MP) { const int b = row / TP; if (row - b * TP == TP - 1) sh = p.out + O_SHP + (size_t)b * 1792; }
        else { const int r2 = row - MP; if ((r2 & 3) == 3) sh = p.out + O_SHS + (size_t)(r2 >> 2) * 1792; }
#pragma unroll
        for (int ni = 0; ni < 4; ++ni) {
          const int col = cbase + ni * 16; const f32x4 a = acc[mi][ni];
          if (n0 < 1024) *(uint2*)(V + (size_t)row * 512 + (col - 512)) = pk4(a[0], a[1], a[2], a[3]);
          else if (n0 < 1536) *(uint2*)(GR + (size_t)row * 512 + (col - 1024)) = pk4(siluf(a[0]), siluf(a[1]), siluf(a[2]), siluf(a[3]));
          else if (n0 < 3328) { *(uint2*)(PR + (size_t)row * 1792 + (col - 1536)) = pk4(a[0], a[1], a[2], a[3]);
            if (sh) *(float4*)(sh + (col - 1536)) = make_float4(a[0], a[1], a[2], a[3]); }
          else if (n0 < 4352) *(uint2*)(GA + (size_t)row * 1024 + (col - 3328)) = pk4(sigmoidf(a[0]), sigmoidf(a[1]), sigmoidf(a[2]), sigmoidf(a[3]));
          else *(uint2*)(GB + (size_t)row * 1024 + (col - 4352)) = pk4(sigmoidf(a[0]), sigmoidf(a[1]), sigmoidf(a[2]), sigmoidf(a[3]));
        }
      }
    }
  }
}

__device__ __forceinline__ void phase_lora(const Params& p, unsigned char* lds) {
  float* sS = (float*)lds;
  const int tid = threadIdx.x;
  const bf16_t* PR = (const bf16_t*)(p.ws + OFF_PR);
  bf16_t* LD = (bf16_t*)(p.ws + OFF_LD); bf16_t* AA = (bf16_t*)(p.ws + OFF_AA); bf16_t* GG = (bf16_t*)((unsigned char*)p.out + OO_GG);
  const float mu_j = p.mu[1536 + tid];
  for (int tile = blockIdx.x; tile < M_TOK / 16; tile += gridDim.x) {
    const int row0 = tile * 16;
    __syncthreads();
#pragma unroll 4
    for (int tt = 0; tt < 16; ++tt) {
      const int row = row0 + tt;
      const float pc = bf2f(PR[(size_t)row * 1792 + 1536 + tid]);
      float pp;
      if (row < MP) { const int t = row % TP; pp = t == 0 ? 0.f : bf2f(PR[(size_t)(row - 1) * 1792 + 1536 + tid]); }
      else { const int r2 = row - MP; pp = (r2 & 3) == 0 ? p.state_shift[(size_t)(r2 >> 2) * 1792 + 1536 + tid] : bf2f(PR[(size_t)(row - 1) * 1792 + 1536 + tid]); }
      const float pm = pc + (pp - pc) * mu_j;
      sS[tt * 256 + tid] = tid < 64 ? tanhf(pm) : (tid < 128 ? pm : sigmoidf(pm));
    }
    __syncthreads();
#pragma unroll 1
    for (int which = 0; which < 3; ++which) {
      const float* Wm = which == 0 ? p.w2 : (which == 1 ? p.a2 : p.g2);
      const int jb = which == 0 ? 0 : (which == 1 ? 64 : 128), nj = which == 2 ? 128 : 64;
      float acc0[16], acc1[16];
#pragma unroll
      for (int tt = 0; tt < 16; ++tt) { acc0[tt] = 0.f; acc1[tt] = 0.f; }
      for (int j = 0; j < nj; j += 4) {
        float wa[4], wb[4];
#pragma unroll
        for (int e = 0; e < 4; ++e) { wa[e] = Wm[(size_t)(j + e) * 512 + tid]; wb[e] = Wm[(size_t)(j + e) * 512 + tid + 256]; }
#pragma unroll
        for (int tt = 0; tt < 16; ++tt) {
          const float4 s4 = *(const float4*)(sS + tt * 256 + jb + j);
          acc0[tt] += s4.x * wa[0] + s4.y * wa[1] + s4.z * wa[2] + s4.w * wa[3];
          acc1[tt] += s4.x * wb[0] + s4.y * wb[1] + s4.z * wb[2] + s4.w * wb[3];
        }
      }
      if (which == 0) {
        const float b0 = p.w0[tid], b1 = p.w0[tid + 256];
#pragma unroll
        for (int tt = 0; tt < 16; ++tt) {
          const float x0 = -(b0 + acc0[tt]), x1 = -(b1 + acc1[tt]);
          const float sp0 = fmaxf(x0, 0.f) + log1pf(expf(-fabsf(x0))), sp1 = fmaxf(x1, 0.f) + log1pf(expf(-fabsf(x1)));
          LD[(size_t)(row0 + tt) * 512 + tid] = (bf16_t)f2bf(-expf(-sp0 - 0.5f));
          LD[(size_t)(row0 + tt) * 512 + tid + 256] = (bf16_t)f2bf(-expf(-sp1 - 0.5f));
        }
      } else if (which == 1) {
        const float b0 = p.a0[tid], b1 = p.a0[tid + 256];
#pragma unroll
        for (int tt = 0; tt < 16; ++tt) {
          AA[(size_t)(row0 + tt) * 512 + tid] = (bf16_t)f2bf(sigmoidf(b0 + acc0[tt]));
          AA[(size_t)(row0 + tt) * 512 + tid + 256] = (bf16_t)f2bf(sigmoidf(b1 + acc1[tt]));
        }
      } else {
#pragma unroll
        for (int tt = 0; tt < 16; ++tt) {
          GG[(size_t)(row0 + tt) * 512 + tid] = (bf16_t)f2bf(acc0[tt]);
          GG[(size_t)(row0 + tt) * 512 + tid + 256] = (bf16_t)f2bf(acc1[tt]);
        }
      }
    }
  }
}


__device__ __forceinline__ void phase_lora_mfma(const Params& p, unsigned char* lds) {
  constexpr int LSTR = 272;
  unsigned char* sA = lds; unsigned char* sB = lds + 128 * LSTR;
  const bf16_t* PR = (const bf16_t*)(p.ws + OFF_PR);
  bf16_t* LD = (bf16_t*)(p.ws + OFF_LD); bf16_t* AA = (bf16_t*)(p.ws + OFF_AA); bf16_t* GG = (bf16_t*)((unsigned char*)p.out + OO_GG);
  for (int grp = blockIdx.x; grp < (M_TOK / 128) * 3; grp += gridDim.x) {
    int tid_o = threadIdx.x; asm volatile("" : "+v"(tid_o));
    const int tid = tid_o, lane = tid & 63, wid = tid >> 6, wm = wid >> 1, wn = wid & 1, l15 = lane & 15, l4 = lane >> 4;
    const int tm = grp / 3, which = grp - tm * 3;
    const int Kc = which == 2 ? 128 : 64, jb = which == 0 ? 0 : (which == 1 ? 64 : 128), cpr = Kc >> 3;
    const bf16_t* Wt = (const bf16_t*)(p.ws + (which == 0 ? OFF_W2T : (which == 1 ? OFF_A2T : OFF_G2T)));
    __syncthreads();
    for (int q = tid; q < 128 * cpr; q += NT) {
      const int r = q / cpr, ck = q - r * cpr, row = tm * 128 + r, col = 1536 + jb + ck * 8;
      const u32x4 cu = *(const u32x4*)(PR + (size_t)row * 1792 + col);
      float pc[8], pp[8];
#pragma unroll
      for (int e = 0; e < 4; ++e) { pc[2 * e] = __uint_as_float(cu[e] << 16); pc[2 * e + 1] = __uint_as_float(cu[e] & 0xffff0000u); }
      bool first; const float* sprev = nullptr;
      if (row < MP) first = (row % TP) == 0; else { const int r2 = row - MP; first = (r2 & 3) == 0; sprev = p.state_shift + (size_t)(r2 >> 2) * 1792 + col; }
      if (!first) { const u32x4 pu = *(const u32x4*)(PR + (size_t)(row - 1) * 1792 + col);
#pragma unroll
        for (int e = 0; e < 4; ++e) { pp[2 * e] = __uint_as_float(pu[e] << 16); pp[2 * e + 1] = __uint_as_float(pu[e] & 0xffff0000u); } }
      else {
#pragma unroll
        for (int e = 0; e < 8; ++e) pp[e] = sprev ? sprev[e] : 0.f;
      }
      float sv[8];
#pragma unroll
      for (int e = 0; e < 8; ++e) {
        const float pm = pc[e] + (pp[e] - pc[e]) * p.mu[col + e];
        float t;
        if (which == 0) { const float ex = __expf(-2.f * fabsf(pm)); t = (1.f - ex) / (1.f + ex); t = pm < 0.f ? -t : t; }
        else if (which == 1) t = pm;
        else t = sigmoidf(pm);
        sv[e] = t;
      }
      u32x4 o; o[0] = pk2(sv[0], sv[1]); o[1] = pk2(sv[2], sv[3]); o[2] = pk2(sv[4], sv[5]); o[3] = pk2(sv[6], sv[7]);
      *(u32x4*)(sA + r * LSTR + ck * 16) = o;
    }
    for (int tn = 0; tn < 4; ++tn) {
      if (tn > 0) __syncthreads();
      for (int q = tid; q < 128 * cpr; q += NT) { const int r = q / cpr, ck = q - r * cpr; *(u32x4*)(sB + r * LSTR + ck * 16) = *(const u32x4*)(Wt + (size_t)(tn * 128 + r) * Kc + ck * 8); }
      __syncthreads();
      f32x4 acc[4][4]; ZERO_ACC(acc);
      for (int kk = 0; kk < (Kc >> 5); ++kk) {
        bf16x8 af[4], bfr[4];
#pragma unroll
        for (int i = 0; i < 4; ++i) { af[i] = *(const bf16x8*)(sA + (wm * 64 + i * 16 + l15) * LSTR + kk * 64 + l4 * 16); bfr[i] = *(const bf16x8*)(sB + (wn * 64 + i * 16 + l15) * LSTR + kk * 64 + l4 * 16); }
#pragma unroll
        for (int mi = 0; mi < 4; ++mi)
#pragma unroll
          for (int ni = 0; ni < 4; ++ni) acc[mi][ni] = __builtin_amdgcn_mfma_f32_16x16x32_bf16(bfr[ni], af[mi], acc[mi][ni], 0, 0, 0);
      }
#pragma unroll
      for (int ni = 0; ni < 4; ++ni) {
        const int col = tn * 128 + wn * 64 + ni * 16 + l4 * 4;
        float bias[4] = {0.f, 0.f, 0.f, 0.f};
        if (which == 0) { const float4 b4 = *(const float4*)(p.w0 + col); bias[0] = b4.x; bias[1] = b4.y; bias[2] = b4.z; bias[3] = b4.w; }
        else if (which == 1) { const float4 b4 = *(const float4*)(p.a0 + col); bias[0] = b4.x; bias[1] = b4.y; bias[2] = b4.z; bias[3] = b4.w; }
#pragma unroll
        for (int mi = 0; mi < 4; ++mi) {
          const int row = tm * 128 + wm * 64 + mi * 16 + l15;
          float o[4];
#pragma unroll
          for (int jj = 0; jj < 4; ++jj) {
            const float a = acc[mi][ni][jj] + bias[jj];
            if (which == 0) o[jj] = -0.87503879f * sigmoidf(a);
            else if (which == 1) o[jj] = sigmoidf(a);
            else o[jj] = a;
          }
          bf16_t* dst = which == 0 ? LD : (which == 1 ? AA : GG);
          *(uint2*)(dst + (size_t)row * 512 + col) = pk4(o[0], o[1], o[2], o[3]);
        }
      }
    }
  }
}

struct StageRegs { uint2 cr, ck, cv, qr, qk, qv, ld, aa; };

__device__ __forceinline__ void rwkv_item(const Params& p, int rowbase, int T, int h, int rb, const float* shift_prev, const float* S_in, float* S_out, unsigned char* lds) {
  float* stage = (float*)lds;
  float* ypart = (float*)(lds + 49152);
  int tid_f = threadIdx.x; asm volatile("" : "+v"(tid_f));
  const int tid = tid_f, lane = tid & 63, wid = tid >> 6;
  const int t_l = tid >> 4, c4 = tid & 15, ch = h * 64 + c4 * 4;
  const int kg = lane & 15, vloc = wid * 4 + (lane >> 4), vrow = rb * 16 + vloc;
  const bf16_t* PR = (const bf16_t*)(p.ws + OFF_PR); const bf16_t* LD = (const bf16_t*)(p.ws + OFF_LD); const bf16_t* AA = (const bf16_t*)(p.ws + OFF_AA);
  bf16_t* Y = (bf16_t*)(p.ws + OFF_Y); float* RHO = (float*)((unsigned char*)p.out + OO_RHO);
  float mur[4], muk[4], muv[4], kkc[4], kac[4], rkc[4];
#pragma unroll
  for (int e = 0; e < 4; ++e) { mur[e] = p.mu[ch + e]; muk[e] = p.mu[512 + ch + e]; muv[e] = p.mu[1024 + ch + e]; kkc[e] = p.k_k[ch + e]; kac[e] = p.k_a[ch + e]; rkc[e] = p.r_k[ch + e]; }
  f32x4 S;
  if (S_in) S = *(const f32x4*)(S_in + (size_t)vrow * 64 + kg * 4); else S = (f32x4){0.f, 0.f, 0.f, 0.f};
  f32x2 Sa = S.xy, Sb = S.zw;

  float rho_keep = 0.f; unsigned y_keep = 0u;
  auto load = [&](int t0, StageRegs& r) {
    int t = t0 + t_l; if (t > T - 1) t = T - 1;
    const bf16_t* cur = PR + (size_t)(rowbase + t) * 1792 + ch;
    r.cr = *(const uint2*)cur; r.ck = *(const uint2*)(cur + 512); r.cv = *(const uint2*)(cur + 1024);
    { const bf16_t* pv = t > 0 ? cur - 1792 : cur; r.qr = *(const uint2*)pv; r.qk = *(const uint2*)(pv + 512); r.qv = *(const uint2*)(pv + 1024); }
    r.ld = *(const uint2*)(LD + (size_t)(rowbase + t) * 512 + ch); r.aa = *(const uint2*)(AA + (size_t)(rowbase + t) * 512 + ch);
  };
  auto process = [&](int t0, const StageRegs& r, int buf, bool first) {
    float cr[4], ck[4], cv[4], qr[4], qk[4], qv[4], ld[4], aa[4];
    unpk4(r.cr, cr); unpk4(r.ck, ck); unpk4(r.cv, cv); unpk4(r.qr, qr); unpk4(r.qk, qk); unpk4(r.qv, qv); unpk4(r.ld, ld); unpk4(r.aa, aa);
    const int t = t0 + t_l;
    if (first && t == 0) {
#pragma unroll
      for (int e = 0; e < 4; ++e) { qr[e] = 0.f; qk[e] = 0.f; qv[e] = 0.f; }
    }
    if (first && t == 0 && shift_prev) {
#pragma unroll
      for (int e = 0; e < 4; ++e) { qr[e] = shift_prev[ch + e]; qk[e] = shift_prev[512 + ch + e]; qv[e] = shift_prev[1024 + ch + e]; }
    }
    float rr[4], k[4], v[4], kk[4], kp[4], bb[4], w[4];
    float ss = 0.f, rho = 0.f;
#pragma unroll
    for (int e = 0; e < 4; ++e) {
      rr[e] = cr[e] + (qr[e] - cr[e]) * mur[e]; k[e] = ck[e] + (qk[e] - ck[e]) * muk[e]; v[e] = cv[e] + (qv[e] - cv[e]) * muv[e];
      kk[e] = k[e] * kkc[e]; ss += kk[e] * kk[e];
      kp[e] = k[e] * (1.f + (aa[e] - 1.f) * kac[e]);
      rho += rr[e] * kp[e] * rkc[e];
      w[e] = __builtin_amdgcn_exp2f(ld[e]);
    }
    ss = rowsum16(ss); rho = rowsum16(rho);
    const float inv = rsqrtf(fmaxf(ss, 1e-24f));
#pragma unroll
    for (int e = 0; e < 4; ++e) { kk[e] *= inv; bb[e] = kk[e] * aa[e]; }
    float* sp = stage + (size_t)((buf * 16 + t_l) * 6) * 64 + c4 * 4;
    *(float4*)(sp) = make_float4(rr[0], rr[1], rr[2], rr[3]);
    *(float4*)(sp + 64) = make_float4(w[0], w[1], w[2], w[3]);
    *(float4*)(sp + 128) = make_float4(kp[0], kp[1], kp[2], kp[3]);
    *(float4*)(sp + 192) = make_float4(v[0], v[1], v[2], v[3]);
    *(float4*)(sp + 256) = make_float4(-kk[0], -kk[1], -kk[2], -kk[3]);
    *(float4*)(sp + 320) = make_float4(bb[0], bb[1], bb[2], bb[3]);
    rho_keep = rho;
    if (rb == 0 && c4 == 0 && t < T) RHO[(size_t)(rowbase + t) * 8 + h] = rho_keep;
  };

  const int nch = (T + 15) >> 4;
  StageRegs rgA, rgB;
  __syncthreads();
  load(0, rgA); process(0, rgA, 0, true);
  if (nch > 1) load(16, rgB);
  if (nch > 2) load(32, rgA);
  __syncthreads();
  auto chunk_body = [&](int c, StageRegs& rg) {
    const int buf = c & 1, t0 = c * 16;
    const int nsteps = min(16, T - t0);
    const float* st = stage + (size_t)(buf * 16) * 384;
    struct StepOps { f32x4 r[2], w[2], kp[2], nk[2], b[2]; float vv[2]; };
    auto loadg = [&](StepOps& g, int s0) {
#pragma unroll
      for (int u = 0; u < 2; ++u) {
        const float* sp = st + (s0 + u) * 384;
        g.r[u] = *(const f32x4*)(sp + kg * 4); g.w[u] = *(const f32x4*)(sp + 64 + kg * 4); g.kp[u] = *(const f32x4*)(sp + 128 + kg * 4);
        g.nk[u] = *(const f32x4*)(sp + 256 + kg * 4); g.b[u] = *(const f32x4*)(sp + 320 + kg * 4); g.vv[u] = sp[192 + vrow];
      }
    };
    auto compg = [&](const StepOps& g, int s0) {
      float yp[2];
#pragma unroll
      for (int u = 0; u < 2; ++u) {
        f32x2 pa = Sa * g.nk[u].xy; pa = Sb * g.nk[u].zw + pa;
        const float sa = rowsum16(pa.x + pa.y);
        const f32x2 sa2 = {sa, sa}, vv2 = {g.vv[u], g.vv[u]};
        const f32x2 Xa = sa2 * g.b[u].xy + vv2 * g.kp[u].xy, Xb = sa2 * g.b[u].zw + vv2 * g.kp[u].zw;
        Sa = Sa * g.w[u].xy + Xa; Sb = Sb * g.w[u].zw + Xb;
        f32x2 ya = Sa * g.r[u].xy; ya = Sb * g.r[u].zw + ya;
        yp[u] = ya.x + ya.y;
      }
#pragma unroll
      for (int u = 0; u < 2; ++u) ypart[((s0 + u) * 16 + vloc) * 16 + kg] = yp[u];
    };
    {
      StepOps ga, gb, gc;
      loadg(ga, 0); loadg(gb, 2);
      if (4 < nsteps) loadg(gc, 4);
      compg(ga, 0);
      if (6 < nsteps) loadg(ga, 6);
      compg(gb, 2);
      if (nsteps > 4) {
        loadg(gb, 8);  compg(gc, 4);
        loadg(gc, 10); compg(ga, 6);
        loadg(ga, 12); compg(gb, 8);
        loadg(gb, 14); compg(gc, 10);
        compg(ga, 12);
        compg(gb, 14);
      }
    }
    asm volatile("" :: "v"(y_keep), "v"(rho_keep));
    if (c + 1 < nch) process(t0 + 16, rg, buf ^ 1, false);
    if (c + 3 < nch) load(t0 + 48, rg);
    RAW_BARRIER();
    if (t_l < nsteps) {
      const f32x4* yp = (const f32x4*)(ypart + (t_l * 16 + c4) * 16);
      const f32x4 y0 = yp[0], y1 = yp[1], y2 = yp[2], y3 = yp[3];
      const float y = ((y0[0] + y0[1]) + (y0[2] + y0[3])) + ((y1[0] + y1[1]) + (y1[2] + y1[3])) + ((y2[0] + y2[1]) + (y2[2] + y2[3])) + ((y3[0] + y3[1]) + (y3[2] + y3[3]));
      y_keep = f2bf(y);
      Y[(size_t)(rowbase + t0 + t_l) * 512 + h * 64 + rb * 16 + c4] = (bf16_t)y_keep;
    }
    RAW_BARRIER();
  };
  for (int c = 0; c < nch; c += 2) {
    chunk_body(c, rgB);
    if (c + 1 < nch) chunk_body(c + 1, rgA);
  }
  S.xy = Sa; S.zw = Sb;
  *(f32x4*)(S_out + (size_t)vrow * 64 + kg * 4) = S;
}

__device__ __forceinline__ void ret_item(const Params& p, int rowbase, int T, int h, const float* S_in, float* S_out, unsigned char* lds, int cb, int ce, int seg, float* loc, unsigned* flags) {
  unsigned char* sQ = lds; unsigned char* sK = lds + 9216; unsigned char* sKdT = lds + 18432; unsigned char* sVT = lds + 27648; unsigned char* sP = lds + 46080; unsigned char* sST = lds + 55296;
  float* part = (float*)sK;
  int tid_f = threadIdx.x; asm volatile("" : "+v"(tid_f));
  const int tid = tid_f, lane = tid & 63, w = tid >> 6, l15 = lane & 15, l4 = lane >> 4;
  const bf16_t* QK = (const bf16_t*)(p.ws + OFF_QK); const bf16_t* V = (const bf16_t*)(p.ws + OFF_V); bf16_t* GR = (bf16_t*)(p.ws + OFF_GR);
  const float lg2 = p.lg2g[h];
  f32x4 ST[2][4];
#pragma unroll
  for (int vt = 0; vt < 2; ++vt)
#pragma unroll
    for (int dt = 0; dt < 4; ++dt) ST[vt][dt] = (f32x4){0.f, 0.f, 0.f, 0.f};
  u32x4 pq[2], pk[2], pv[4];
  auto prefetch = [&](int t0n, int tidp) {
    const int Ln = min(64, T - t0n);
#pragma unroll
    for (int i = 0; i < 2; ++i) {
      const int q_ = tidp + i * 256, j = q_ & 63, ck = q_ >> 6;
      pq[i] = (u32x4){0u, 0u, 0u, 0u}; pk[i] = pq[i];
      if (j < Ln) { const bf16_t* src = QK + (size_t)(rowbase + t0n + j) * 512 + h * 64 + ck * 8; pq[i] = *(const u32x4*)src; pk[i] = *(const u32x4*)(src + 256); }
    }
#pragma unroll
    for (int i = 0; i < 4; ++i) {
      const int q_ = tidp + i * 256, j = q_ & 63, cv = q_ >> 6;
      pv[i] = (u32x4){0u, 0u, 0u, 0u};
      if (j < Ln) pv[i] = *(const u32x4*)(V + (size_t)(rowbase + t0n + j) * 512 + h * 128 + cv * 8);
    }
  };
  if (seg >= 0 && seg < 3) {
    prefetch(cb * 64, threadIdx.x);
    for (int c = cb; c < ce; ++c) {
      const int t0 = c * 64, Lc = min(64, T - t0);
      int tid_o = threadIdx.x; asm volatile("" : "+v"(tid_o));
      const int tid = tid_o, lane = tid & 63, w = tid >> 6, l15 = lane & 15, l4 = lane >> 4;
      __syncthreads();
#pragma unroll
      for (int i = 0; i < 2; ++i) {
        const int q_ = tid + i * 256, j = q_ & 63, ck = q_ >> 6;
        const u32x4 kv = pk[i];
        const float kd = __builtin_amdgcn_exp2f((float)(Lc - 1 - j) * lg2);
#pragma unroll
        for (int e = 0; e < 4; ++e) {
          *(bf16_t*)(sKdT + (ck * 8 + 2 * e) * 144 + j * 2) = (bf16_t)f2bf(__uint_as_float(kv[e] << 16) * kd);
          *(bf16_t*)(sKdT + (ck * 8 + 2 * e + 1) * 144 + j * 2) = (bf16_t)f2bf(__uint_as_float(kv[e] & 0xffff0000u) * kd);
        }
      }
#pragma unroll
      for (int i = 0; i < 4; ++i) {
        const int q_ = tid + i * 256, j = q_ & 63, cv = q_ >> 6;
        const u32x4 vv = pv[i];
#pragma unroll
        for (int e = 0; e < 4; ++e) {
          *(bf16_t*)(sVT + (cv * 8 + 2 * e) * 144 + j * 2) = (bf16_t)(vv[e] & 0xffffu);
          *(bf16_t*)(sVT + (cv * 8 + 2 * e + 1) * 144 + j * 2) = (bf16_t)(vv[e] >> 16);
        }
      }
      if (c + 1 < ce) prefetch(t0 + 64, tid);
      __syncthreads();
      const float gl = __builtin_amdgcn_exp2f((float)Lc * lg2);
      bf16x8 bV[2][2];
#pragma unroll
      for (int vt = 0; vt < 2; ++vt)
#pragma unroll
        for (int kk = 0; kk < 2; ++kk) bV[vt][kk] = *(const bf16x8*)(sVT + (32 * w + vt * 16 + l15) * 144 + kk * 64 + l4 * 16);
#pragma unroll
      for (int dt = 0; dt < 4; ++dt) {
        bf16x8 bK[2];
#pragma unroll
        for (int kk = 0; kk < 2; ++kk) bK[kk] = *(const bf16x8*)(sKdT + (dt * 16 + l15) * 144 + kk * 64 + l4 * 16);
#pragma unroll
        for (int vt = 0; vt < 2; ++vt) {
          f32x4 a = ST[vt][dt] * gl;
#pragma unroll
          for (int kk = 0; kk < 2; ++kk) a = __builtin_amdgcn_mfma_f32_16x16x32_bf16(bV[vt][kk], bK[kk], a, 0, 0, 0);
          ST[vt][dt] = a;
        }
      }
    }
    float* lp = loc + (size_t)seg * 8192;
#pragma unroll
    for (int vt = 0; vt < 2; ++vt)
#pragma unroll
      for (int dt = 0; dt < 4; ++dt)
        *(float4*)(lp + (size_t)(dt * 16 + l15) * 128 + 32 * w + vt * 16 + l4 * 4) = make_float4(ST[vt][dt][0], ST[vt][dt][1], ST[vt][dt][2], ST[vt][dt][3]);
    __threadfence();
    __syncthreads();
    if (threadIdx.x == 0) { asm volatile("s_waitcnt vmcnt(0)" ::: "memory"); __hip_atomic_store(flags + seg, 1u, __ATOMIC_RELAXED, __HIP_MEMORY_SCOPE_AGENT); }
  }
#pragma unroll
  for (int vt = 0; vt < 2; ++vt)
#pragma unroll
    for (int dt = 0; dt < 4; ++dt) ST[vt][dt] = (f32x4){0.f, 0.f, 0.f, 0.f};
  if (seg > 0) {
    if (threadIdx.x == 0) {
      for (int s2 = 0; s2 < seg; ++s2) { unsigned sp = 0; while (__hip_atomic_load(flags + s2, __ATOMIC_RELAXED, __HIP_MEMORY_SCOPE_AGENT) == 0u) { __builtin_amdgcn_s_sleep(2); if (++sp > (1u << 22)) break; } }
      __builtin_amdgcn_fence(__ATOMIC_ACQUIRE, "agent");
      asm volatile("s_waitcnt vmcnt(0)" ::: "memory");
    }
    __syncthreads();
    for (int s2 = 0; s2 < seg; ++s2) {
      const float dk = __builtin_amdgcn_exp2f((float)(64 * (cb - 8 * (s2 + 1))) * lg2);
      const float* lp = loc + (size_t)s2 * 8192;
#pragma unroll
      for (int vt = 0; vt < 2; ++vt)
#pragma unroll
        for (int dt = 0; dt < 4; ++dt) {
          const float4 t4 = *(const float4*)(lp + (size_t)(dt * 16 + l15) * 128 + 32 * w + vt * 16 + l4 * 4);
          ST[vt][dt][0] += dk * t4.x; ST[vt][dt][1] += dk * t4.y; ST[vt][dt][2] += dk * t4.z; ST[vt][dt][3] += dk * t4.w;
        }
    }
  } else if (S_in) {
#pragma unroll
    for (int vt = 0; vt < 2; ++vt)
#pragma unroll
      for (int dt = 0; dt < 4; ++dt) {
        const float4 t4 = *(const float4*)(S_in + (size_t)(dt * 16 + l15) * 128 + 32 * w + vt * 16 + l4 * 4);
        ST[vt][dt][0] = t4.x; ST[vt][dt][1] = t4.y; ST[vt][dt][2] = t4.z; ST[vt][dt][3] = t4.w;
      }
  }
  __syncthreads();
#pragma unroll
  for (int vt = 0; vt < 2; ++vt)
#pragma unroll
    for (int dt = 0; dt < 4; ++dt)
#pragma unroll
      for (int jj = 0; jj < 4; ++jj) *(bf16_t*)(sST + (32 * w + vt * 16 + l4 * 4 + jj) * 144 + (dt * 16 + l15) * 2) = (bf16_t)f2bf(ST[vt][dt][jj]);
  prefetch(cb * 64, threadIdx.x);
  for (int c = cb; c < ce; ++c) {
    const int t0 = c * 64, Lc = min(64, T - t0);
    int tid_o = threadIdx.x; asm volatile("" : "+v"(tid_o));
    const int tid = tid_o, lane = tid & 63, w = tid >> 6, l15 = lane & 15, l4 = lane >> 4;
    __syncthreads();
#pragma unroll
    for (int i = 0; i < 2; ++i) {
      const int q_ = tid + i * 256, j = q_ & 63, ck = q_ >> 6;
      const u32x4 kv = pk[i];
      *(u32x4*)(sQ + j * 144 + ck * 16) = pq[i]; *(u32x4*)(sK + j * 144 + ck * 16) = kv;
      const float kd = __builtin_amdgcn_exp2f((float)(Lc - 1 - j) * lg2);
#pragma unroll
      for (int e = 0; e < 4; ++e) {
        *(bf16_t*)(sKdT + (ck * 8 + 2 * e) * 144 + j * 2) = (bf16_t)f2bf(__uint_as_float(kv[e] << 16) * kd);
        *(bf16_t*)(sKdT + (ck * 8 + 2 * e + 1) * 144 + j * 2) = (bf16_t)f2bf(__uint_as_float(kv[e] & 0xffff0000u) * kd);
      }
    }
#pragma unroll
    for (int i = 0; i < 4; ++i) {
      const int q_ = tid + i * 256, j = q_ & 63, cv = q_ >> 6;
      const u32x4 vv = pv[i];
#pragma unroll
      for (int e = 0; e < 4; ++e) {
        *(bf16_t*)(sVT + (cv * 8 + 2 * e) * 144 + j * 2) = (bf16_t)(vv[e] & 0xffffu);
        *(bf16_t*)(sVT + (cv * 8 + 2 * e + 1) * 144 + j * 2) = (bf16_t)(vv[e] >> 16);
      }
    }
    if (c + 1 < ce) prefetch(t0 + 64, tid);
    __syncthreads();
    {
      f32x4 sc[4];
#pragma unroll
      for (int jt = 0; jt < 4; ++jt) sc[jt] = (f32x4){0.f, 0.f, 0.f, 0.f};
#pragma unroll
      for (int kk = 0; kk < 2; ++kk) {
        const bf16x8 aq = *(const bf16x8*)(sQ + (16 * w + l15) * 144 + kk * 64 + l4 * 16);
#pragma unroll
        for (int jt = 0; jt < 4; ++jt) { const bf16x8 bk = *(const bf16x8*)(sK + (jt * 16 + l15) * 144 + kk * 64 + l4 * 16); sc[jt] = __builtin_amdgcn_mfma_f32_16x16x32_bf16(aq, bk, sc[jt], 0, 0, 0); }
      }
#pragma unroll
      for (int jt = 0; jt < 4; ++jt)
#pragma unroll
        for (int jj = 0; jj < 4; ++jj) {
          const int i = 16 * w + l4 * 4 + jj, j = jt * 16 + l15;
          const float pv = i >= j ? sc[jt][jj] * __builtin_amdgcn_exp2f((float)(i - j) * lg2) : 0.f;
          *(bf16_t*)(sP + i * 144 + j * 2) = (bf16_t)f2bf(pv);
        }
    }
    __syncthreads();
    f32x4 o[4][2];
    {
      bf16x8 bV[2][2], bS[2][2];
#pragma unroll
      for (int vt = 0; vt < 2; ++vt)
#pragma unroll
        for (int kk = 0; kk < 2; ++kk) {
          bV[vt][kk] = *(const bf16x8*)(sVT + (32 * w + vt * 16 + l15) * 144 + kk * 64 + l4 * 16);
          bS[vt][kk] = *(const bf16x8*)(sST + (32 * w + vt * 16 + l15) * 144 + kk * 64 + l4 * 16);
        }
#pragma unroll
      for (int it = 0; it < 4; ++it) {
        bf16x8 aP[2], aQ[2];
#pragma unroll
        for (int kk = 0; kk < 2; ++kk) { aP[kk] = *(const bf16x8*)(sP + (it * 16 + l15) * 144 + kk * 64 + l4 * 16); aQ[kk] = *(const bf16x8*)(sQ + (it * 16 + l15) * 144 + kk * 64 + l4 * 16); }
#pragma unroll
        for (int vt = 0; vt < 2; ++vt) {
          f32x4 a1 = (f32x4){0.f, 0.f, 0.f, 0.f}, a2 = (f32x4){0.f, 0.f, 0.f, 0.f};
#pragma unroll
          for (int kk = 0; kk < 2; ++kk) { a1 = __builtin_amdgcn_mfma_f32_16x16x32_bf16(aP[kk], bV[vt][kk], a1, 0, 0, 0); a2 = __builtin_amdgcn_mfma_f32_16x16x32_bf16(aQ[kk], bS[vt][kk], a2, 0, 0, 0); }
#pragma unroll
          for (int jj = 0; jj < 4; ++jj) { const int i = it * 16 + l4 * 4 + jj; o[it][vt][jj] = a1[jj] + __builtin_amdgcn_exp2f((float)(i + 1) * lg2) * a2[jj]; }
        }
      }
      const float gl = __builtin_amdgcn_exp2f((float)Lc * lg2);
#pragma unroll
      for (int dt = 0; dt < 4; ++dt) {
        bf16x8 bK[2];
#pragma unroll
        for (int kk = 0; kk < 2; ++kk) bK[kk] = *(const bf16x8*)(sKdT + (dt * 16 + l15) * 144 + kk * 64 + l4 * 16);
#pragma unroll
        for (int vt = 0; vt < 2; ++vt) {
          f32x4 a = ST[vt][dt] * gl;
#pragma unroll
          for (int kk = 0; kk < 2; ++kk) a = __builtin_amdgcn_mfma_f32_16x16x32_bf16(bV[vt][kk], bK[kk], a, 0, 0, 0);
          ST[vt][dt] = a;
#pragma unroll
          for (int jj = 0; jj < 4; ++jj) *(bf16_t*)(sST + (32 * w + vt * 16 + l4 * 4 + jj) * 144 + (dt * 16 + l15) * 2) = (bf16_t)f2bf(a[jj]);
        }
      }
    }
    unsigned short grv[4][4][2];
#pragma unroll
    for (int it = 0; it < 4; ++it)
#pragma unroll
      for (int jj = 0; jj < 4; ++jj) {
        const int i = it * 16 + l4 * 4 + jj;
#pragma unroll
        for (int vt = 0; vt < 2; ++vt) grv[it][jj][vt] = i < Lc ? GR[(size_t)(rowbase + t0 + i) * 512 + h * 128 + 32 * w + vt * 16 + l15] : (unsigned short)0;
      }
#pragma unroll
    for (int it = 0; it < 4; ++it)
#pragma unroll
      for (int jj = 0; jj < 4; ++jj) {
        float s1 = o[it][0][jj] + o[it][1][jj], s2 = o[it][0][jj] * o[it][0][jj] + o[it][1][jj] * o[it][1][jj];
        s1 = rowsum16(s1); s2 = rowsum16(s2);
        if (l15 == 0) { const int i = it * 16 + l4 * 4 + jj; part[(w * 64 + i) * 2] = s1; part[(w * 64 + i) * 2 + 1] = s2; }
      }
    const float gn[2] = {p.ret_gn_g[h * 128 + 32 * w + l15], p.ret_gn_g[h * 128 + 32 * w + 16 + l15]};
    __syncthreads();
#pragma unroll
    for (int it = 0; it < 4; ++it)
#pragma unroll
      for (int jj = 0; jj < 4; ++jj) {
        const int i = it * 16 + l4 * 4 + jj;
        float s1 = 0.f, s2 = 0.f;
#pragma unroll
        for (int ww = 0; ww < 4; ++ww) { s1 += part[(ww * 64 + i) * 2]; s2 += part[(ww * 64 + i) * 2 + 1]; }
        const float mean = s1 * (1.f / 128.f), var = fmaxf(s2 * (1.f / 128.f) - mean * mean, 0.f), rstd = rsqrtf(var + 1e-6f);
        if (i < Lc) {
#pragma unroll
          for (int vt = 0; vt < 2; ++vt) {
            const int v = 32 * w + vt * 16 + l15;
            bf16_t* gp = GR + (size_t)(rowbase + t0 + i) * 512 + h * 128 + v;
            *gp = (bf16_t)f2bf((o[it][vt][jj] - mean) * rstd * gn[vt] * bf2f(grv[it][jj][vt]));
          }
        }
      }
  }
  if (S_out)
#pragma unroll
  for (int vt = 0; vt < 2; ++vt)
#pragma unroll
    for (int dt = 0; dt < 4; ++dt)
      *(float4*)(S_out + (size_t)(dt * 16 + l15) * 128 + 32 * w + vt * 16 + l4 * 4) = make_float4(ST[vt][dt][0], ST[vt][dt][1], ST[vt][dt][2], ST[vt][dt][3]);
}

constexpr size_t OO_LOC = 56000000;
constexpr int NQ_LIGHT = 4608, NQ_TOTAL = 4608 + 3 * 704;
__device__ __forceinline__ void phase_scan(const Params& p, unsigned char* lds, volatile LAS unsigned* qslot) {
  const int G = gridDim.x;
  unsigned* flags_all = (unsigned*)(p.ws + OFF_BAR + 14336);
  unsigned* qctr = (unsigned*)(p.ws + OFF_BAR + 15360);
  float* loc_all = (float*)((unsigned char*)p.out + OO_LOC);
  int hid = blockIdx.x;
  bool heavy = true;
#pragma unroll 1
  while (true) {
    int item;
    if (heavy) { if (hid < 384) { item = hid; hid += G; } else { heavy = false; continue; } }
    else {
      __syncthreads();
      if (threadIdx.x == 0) *qslot = atomicAdd(qctr, 1u);
      __syncthreads();
      const int qi = (int)*qslot;
      if (qi >= NQ_TOTAL) break;
      item = 384 + qi;
    }
    int kind; int rowbase = 0, T = 0, h = 0, rb = 0, cb = 0, ce = 0, seg = -1; const float* shp = nullptr; const float* sin = nullptr; float* sout = nullptr; float* loc = nullptr; unsigned* flg = nullptr;
    if (item < 256) { const int j = item >> 3, seq = (item & 7) * 8 + (j >> 2), b = seq >> 3; rb = j & 3; h = seq & 7; kind = 0; rowbase = b * TP; T = TP; sout = p.out + O_WKVP + (size_t)seq * 4096; }
    else if (item < 384) { const int idx = item - 256, bh = idx >> 2, b = bh >> 2; seg = idx & 3; h = bh & 3; kind = 1; rowbase = b * TP; T = TP; cb = seg * 8; ce = seg == 3 ? 33 : cb + 8;
      sout = seg == 3 ? p.out + O_RETP + (size_t)bh * 8192 : nullptr; loc = loc_all + (size_t)bh * 3 * 8192; flg = flags_all + bh * 4; }
    else if (item < 384 + 4096) { const int it = item - 384, seq = it >> 2, b = seq >> 3; rb = it & 3; h = seq & 7; kind = 0; rowbase = MP + b * 4; T = 4;
      shp = p.state_shift + (size_t)b * 1792; sin = p.state_wkv + (size_t)seq * 4096; sout = p.out + O_WKVS + (size_t)seq * 4096; }
    else if (item < 384 + NQ_LIGHT) { const int bh = item - 384 - 4096, b = bh >> 2; h = bh & 3; kind = 1; rowbase = MP + b * 4; T = 4; cb = 0; ce = 1; sin = p.state_ret + (size_t)bh * 8192; sout = p.out + O_RETS + (size_t)bh * 8192; }
    else kind = 2;
    if (kind == 0) {
      if (item < 256) __builtin_amdgcn_s_setprio(3);
      const int nrep = ((DUP6 == 1 && item < 256) || (DUP6 == 2 && item >= 384)) ? 2 : 1;
#pragma unroll 1
      for (int rep = 0; rep < nrep; ++rep) rwkv_item(p, rowbase, T, h, rb, shp, sin, sout, lds);
      if (item < 256) __builtin_amdgcn_s_setprio(0);
    }
    else if (kind == 1) ret_item(p, rowbase, T, h, sin, sout, lds, cb, ce, seg, loc, flg);
    else {
      const int tt = item - 384 - NQ_LIGHT, job = tt / 704, t = tt - job * 704;
      const float* src = job == 0 ? p.ffn2_wg : (job == 1 ? p.ffn2_wu : p.ffn2_wd);
      transpose_tile(src, job == 2 ? 2816 : 1024, job == 2 ? 1024 : 2816, (bf16_t*)(p.ws + (job == 2 ? OFF_W1D : OFF_W1GU)), job == 2 ? 1 : 2, job == 1 ? 1 : 0, t, lds);
    }
  }
}

__device__ __forceinline__ void phase_post(const Params& p, unsigned char* lds) {
  const int tid = threadIdx.x, h = (tid >> 4) & 7, c4 = tid & 15, ch = h * 64 + c4 * 4;
  bf16_t* Y = (bf16_t*)(p.ws + OFF_Y); const bf16_t* PR = (const bf16_t*)(p.ws + OFF_PR);
  const bf16_t* GG = (const bf16_t*)((unsigned char*)p.out + OO_GG); const float* RHO = (const float*)((unsigned char*)p.out + OO_RHO);
  float muv[4], lg[4], lb[4];
#pragma unroll
  for (int e = 0; e < 4; ++e) { muv[e] = p.mu[1024 + ch + e]; lg[e] = p.lnx_g[ch + e]; lb[e] = p.lnx_b[ch + e]; }
  for (int pr = blockIdx.x; pr < M_TOK / 2; pr += gridDim.x) {
    const int row = pr * 2 + (tid >> 7);
    float y[4], cv[4], qv[4], g[4];
    unpk4(*(const uint2*)(Y + (size_t)row * 512 + ch), y);
    unpk4(*(const uint2*)(PR + (size_t)row * 1792 + 1024 + ch), cv);
    unpk4(*(const uint2*)(GG + (size_t)row * 512 + ch), g);
    bool first; const float* sprev = nullptr;
    if (row < MP) first = (row % TP) == 0; else { const int r2 = row - MP; first = (r2 & 3) == 0; sprev = p.state_shift + (size_t)(r2 >> 2) * 1792 + 1024 + ch; }
    if (!first) unpk4(*(const uint2*)(PR + (size_t)(row - 1) * 1792 + 1024 + ch), qv);
    else {
#pragma unroll
      for (int e = 0; e < 4; ++e) qv[e] = sprev ? sprev[e] : 0.f;
    }
    const float rho = RHO[(size_t)row * 8 + h];
    float s = y[0] + y[1] + y[2] + y[3]; s = rowsum16(s);
    const float mean = s * (1.f / 64.f);
    float d[4], q = 0.f;
#pragma unroll
    for (int e = 0; e < 4; ++e) { d[e] = y[e] - mean; q += d[e] * d[e]; }
    q = rowsum16(q);
    const float rstd = rsqrtf(q * (1.f / 64.f) + 64e-5f);
    float o[4];
#pragma unroll
    for (int e = 0; e < 4; ++e) { const float v = cv[e] + (qv[e] - cv[e]) * muv[e]; o[e] = (d[e] * rstd * lg[e] + lb[e] + rho * v) * g[e]; }
    *(uint2*)(Y + (size_t)row * 512 + ch) = pk4(o[0], o[1], o[2], o[3]);
  }
}

__device__ __forceinline__ void phase_merge(const Params& p, unsigned char* lds) {
  const bf16_t* OR = (const bf16_t*)(p.ws + OFF_GR); const bf16_t* OW = (const bf16_t*)(p.ws + OFF_Y);
  const bf16_t* WR = (const bf16_t*)(p.ws + OFF_WR); const bf16_t* WWp = (const bf16_t*)(p.ws + OFF_WW);
  const bf16_t* GA = (const bf16_t*)((unsigned char*)p.out + OO_GA); const bf16_t* GB = (const bf16_t*)(p.ws + OFF_GB);
  bf16_t* MG = (bf16_t*)(p.ws + OFF_MG);
  const int nM = NMT5, nN = 8;
  for (int L = blockIdx.x; L < nM * nN; L += gridDim.x) {
    int tm, tn; tile_coords(L, nM, nN, tm, tn);
    f32x4 acc[5][4]; ZERO_ACC5(acc);
    gemm_tile_dma<5>(OR, 512, WR, 512, 512, tm * 160, tn * 128, acc, lds);
    EPI_VARS5;
    uint2 gin[5][4], min_[5][4];
#pragma unroll
    for (int mi = 0; mi < 5; ++mi) {
      int row = rbase + mi * 16; row = row < M_TOK ? row : M_TOK - 1;
#pragma unroll
      for (int ni = 0; ni < 4; ++ni) gin[mi][ni] = *(const uint2*)(GA + (size_t)row * 1024 + cbase + ni * 16);
    }
#pragma unroll
    for (int mi = 0; mi < 5; ++mi)
#pragma unroll
      for (int ni = 0; ni < 4; ++ni) { float g[4]; unpk4(gin[mi][ni], g);
        gin[mi][ni] = pk4(acc[mi][ni][0] * g[0], acc[mi][ni][1] * g[1], acc[mi][ni][2] * g[2], acc[mi][ni][3] * g[3]); }
    PIN_U2(gin);
#pragma unroll
    for (int mi = 0; mi < 5; ++mi) {
      const int row = rbase + mi * 16;
      if (row < M_TOK) {
#pragma unroll
        for (int ni = 0; ni < 4; ++ni) *(uint2*)(MG + (size_t)row * 1024 + cbase + ni * 16) = gin[mi][ni];
      }
    }
    ZERO_ACC5(acc);
    gemm_tile_dma<5>(OW, 512, WWp, 512, 512, tm * 160, tn * 128, acc, lds);
#pragma unroll
    for (int mi = 0; mi < 5; ++mi) {
      int row = rbase + mi * 16; row = row < M_TOK ? row : M_TOK - 1;
#pragma unroll
      for (int ni = 0; ni < 4; ++ni) { gin[mi][ni] = *(const uint2*)(GB + (size_t)row * 1024 + cbase + ni * 16); min_[mi][ni] = *(const uint2*)(MG + (size_t)row * 1024 + cbase + ni * 16); }
    }
#pragma unroll
    for (int mi = 0; mi < 5; ++mi)
#pragma unroll
      for (int ni = 0; ni < 4; ++ni) { float g[4], t[4]; unpk4(gin[mi][ni], g); unpk4(min_[mi][ni], t);
        gin[mi][ni] = pk4(t[0] + acc[mi][ni][0] * g[0], t[1] + acc[mi][ni][1] * g[1], t[2] + acc[mi][ni][2] * g[2], t[3] + acc[mi][ni][3] * g[3]); }
    PIN_U2(gin);
#pragma unroll
    for (int mi = 0; mi < 5; ++mi) {
      const int row = rbase + mi * 16;
      if (row < M_TOK) {
#pragma unroll
        for (int ni = 0; ni < 4; ++ni) *(uint2*)(MG + (size_t)row * 1024 + cbase + ni * 16) = gin[mi][ni];
      }
    }
  }
}

__device__ __forceinline__ void phase_wout(const Params& p, unsigned char* lds) {
  const bf16_t* A = (const bf16_t*)(p.ws + OFF_MG); const bf16_t* W = (const bf16_t*)(p.ws + OFF_WO); bf16_t* H = (bf16_t*)(p.ws + OFF_H);
  const int nM = NMT5, nN = 8;
  for (int L = blockIdx.x; L < nM * nN; L += gridDim.x) {
    int tm, tn; tile_coords(L, nM, nN, tm, tn);
    f32x4 acc[5][4]; ZERO_ACC5(acc);
    gemm_tile_dma<5>(A, 1024, W, 1024, 1024, tm * 160, tn * 128, acc, lds);
    EPI_VARS5;
    uint2 hin[5][4];
#pragma unroll
    for (int mi = 0; mi < 5; ++mi) {
      int row = rbase + mi * 16; row = row < M_TOK ? row : M_TOK - 1;
#pragma unroll
      for (int ni = 0; ni < 4; ++ni) hin[mi][ni] = *(const uint2*)(H + (size_t)row * 1024 + cbase + ni * 16);
    }
#pragma unroll
    for (int mi = 0; mi < 5; ++mi)
#pragma unroll
      for (int ni = 0; ni < 4; ++ni) { float h[4]; unpk4(hin[mi][ni], h); const f32x4 a = acc[mi][ni]; hin[mi][ni] = pk4(h[0] + a[0], h[1] + a[1], h[2] + a[2], h[3] + a[3]); }
    PIN_U2(hin);
#pragma unroll
    for (int mi = 0; mi < 5; ++mi) {
      const int row = rbase + mi * 16;
      if (row < M_TOK) {
#pragma unroll
        for (int ni = 0; ni < 4; ++ni) *(uint2*)(H + (size_t)row * 1024 + cbase + ni * 16) = hin[mi][ni];
      }
    }
  }
}

__global__ void __launch_bounds__(256, 2) mega(Params p) {
  extern __shared__ __attribute__((aligned(16))) unsigned char lds[];
  cg::grid_group grid = cg::this_grid();
  const int lo = p.phase_lo, hi = p.phase_hi;
  __shared__ uint4 xb_words;
  if (threadIdx.x == 0) xb_words = make_uint4(0u, 0u, 0u, 0u);
  __syncthreads();
  XcdBarrier xb = xcd_barrier_post((unsigned*)(p.ws + OFF_BAR), (volatile LAS unsigned*)&xb_words);
  if (hi > 1000) grid.sync();
  unsigned long long tp0 = 0;
#define PROBE_WAIT() do { if (blockIdx.x == 0) { const unsigned long long t1 = __builtin_amdgcn_s_memrealtime(); while (__builtin_amdgcn_s_memrealtime() < t1 + (t1 - tp0)) __builtin_amdgcn_s_sleep(8); } } while (0)
#define RUN_PHASE(k, call) if (PEN(k) && lo <= (k) && (k) < hi) { if ((k) > lo) xcd_barrier(xb); \
    if (PROBE_PHASE >= 0 && (k) == PROBE_PHASE + 1) PROBE_WAIT(); \
    if (PROBE_PHASE == (k)) tp0 = __builtin_amdgcn_s_memrealtime(); \
    call; if (((DUPMASK) >> (k)) & 1) { call; } }
  RUN_PHASE(0, phase0(p, lds))
  RUN_PHASE(1, phase_ffn_up(p, lds))
  RUN_PHASE(2, phase_ffn_down<true>(p, lds))
  RUN_PHASE(3, (rmsnorm_phase<1, 0>(p, p.mix_norm, (bf16_t*)(p.ws + OFF_A))))
  RUN_PHASE(4, phase_win(p, lds))
  RUN_PHASE(5, phase_lora_mfma(p, lds))
  RUN_PHASE(6, phase_scan(p, lds, ((volatile LAS unsigned*)&xb_words) + 2))
  RUN_PHASE(7, phase_post(p, lds))
  RUN_PHASE(8, phase_merge(p, lds))
  RUN_PHASE(9, phase_wout(p, lds))
  RUN_PHASE(10, (rmsnorm_phase<1, 0>(p, p.ffn2_norm, (bf16_t*)(p.ws + OFF_A))))
  RUN_PHASE(11, phase_ffn_up(p, lds))
  RUN_PHASE(12, phase_ffn_down<false>(p, lds))
  RUN_PHASE(13, (rmsnorm_phase<2, 1>(p, p.final_norm, nullptr)))
  if (PROBE_PHASE == 13) { xcd_barrier(xb); PROBE_WAIT(); }
}

extern "C" void kernel_launch(void* const* d_in, const int* in_sizes, int n_in, void* d_out, int out_size, void* d_ws, size_t ws_size, hipStream_t stream) {
  static int grid_blocks = 0;
  if (grid_blocks == 0) {
    if (n_in != 32 || ws_size < WS_NEED || out_size != 26458112) { fprintf(stderr, "kernel_launch: unexpected sizes n_in %d ws %zu out %d\n", n_in, ws_size, out_size); grid_blocks = -1; return; }
    int dev = 0, cus = 0, per_cu = 0;
    hipGetDevice(&dev);
    hipDeviceGetAttribute(&cus, hipDeviceAttributeMultiprocessorCount, dev);
    if (hipFuncSetAttribute((const void*)mega, hipFuncAttributeMaxDynamicSharedMemorySize, LDS_BYTES) != hipSuccess) { fprintf(stderr, "hipFuncSetAttribute failed\n"); grid_blocks = -1; return; }
    hipOccupancyMaxActiveBlocksPerMultiprocessor(&per_cu, (const void*)mega, NT, LDS_BYTES);
    if (per_cu < 1) { fprintf(stderr, "occupancy query returned %d\n", per_cu); grid_blocks = -1; return; }
    if (per_cu > 2) per_cu = 2;
    grid_blocks = cus * per_cu;
  }
  if (grid_blocks < 0) return;
  if (hipMemsetAsync((unsigned char*)d_ws + OFF_BAR, 0, 16384, stream) != hipSuccess) { fprintf(stderr, "memset failed\n"); return; }
  Params p{};
  const float** pp = (const float**)&p;
  for (int i = 0; i < 32; ++i) pp[i] = (const float*)d_in[i];
  p.out = (float*)d_out; p.ws = (unsigned char*)d_ws;
  for (int j = 0; j < 32; ++j) p.invf[j] = (float)pow(10000.0, -(double)j / 32.0);
  for (int h = 0; h < 4; ++h) p.lg2g[h] = (float)log2(1.0 - exp2(-5.0 - (double)h));
#if SINGLE_LAUNCH
  p.phase_lo = 0; p.phase_hi = NPHASE;
  void* args[] = {&p};
  hipError_t e = hipLaunchCooperativeKernel((const void*)mega, dim3(grid_blocks), dim3(NT), args, LDS_BYTES, stream);
  if (e != hipSuccess) fprintf(stderr, "cooperative launch failed: %s (grid %d)\n", hipGetErrorString(e), grid_blocks);
#else
  for (int ph = 0; ph < NPHASE; ++ph) {
    p.phase_lo = ph; p.phase_hi = ph + 1;
    hipLaunchKernelGGL(mega, dim3(grid_blocks), dim3(NT), LDS_BYTES, stream, p);
  }
#endif
}
```

```cpp
#include <hip/hip_runtime.h>
#include <hip/hip_cooperative_groups.h>
#include <cstdio>
#include <cmath>
namespace cg = cooperative_groups;

#ifndef PHMASK
#define PHMASK 0xffff
#endif
#define PEN(k) (((PHMASK) >> (k)) & 1)
#ifndef DUPMASK
#define DUPMASK 0
#endif
#ifndef DUP6
#define DUP6 0
#endif
#ifndef PROBE_PHASE
#define PROBE_PHASE (-1)
#endif
#ifndef SINGLE_LAUNCH
#define SINGLE_LAUNCH 1
#endif

typedef unsigned short bf16_t;
typedef short bf16x8 __attribute__((ext_vector_type(8)));
typedef float f32x4 __attribute__((ext_vector_type(4)));
typedef unsigned u32x4 __attribute__((ext_vector_type(4)));
typedef float f32x2 __attribute__((ext_vector_type(2)));

constexpr int NT = 256;
constexpr int M_TOK = 17024, MP = 16512, TP = 2064;
constexpr int PAST = 16384;
constexpr int LDS_BYTES = 73728;
constexpr int NPHASE = 14;

constexpr size_t S1024 = (size_t)M_TOK * 1024 * 2;
constexpr size_t S512 = S1024 / 2;
constexpr size_t OFF_W1GU = 0;
constexpr size_t OFF_W1D = OFF_W1GU + 11534336;
constexpr size_t OFF_WIN = OFF_W1D + 5767168;
constexpr size_t OFF_WR = OFF_WIN + 11010048;
constexpr size_t OFF_WW = OFF_WR + 1048576;
constexpr size_t OFF_WO = OFF_WW + 1048576;
constexpr size_t OFF_H = OFF_WO + 2097152;
constexpr size_t OFF_T = OFF_H + S1024;
constexpr size_t OFF_A = OFF_T;
constexpr size_t OFF_HF = OFF_T + S1024;
constexpr size_t OFF_QK = OFF_HF;
constexpr size_t OFF_V = OFF_QK + S512;
constexpr size_t OFF_GR = OFF_V + S512;
constexpr size_t OFF_PR = OFF_GR + S512;
constexpr size_t OFF_GB = OFF_PR + (size_t)M_TOK * 1792 * 2;
constexpr size_t OFF_Y = OFF_GB + S1024;
constexpr size_t OFF_END = OFF_Y + S512;
constexpr size_t OFF_MG = OFF_QK;
constexpr size_t OFF_BAR = OFF_END;
constexpr size_t OFF_W2T = OFF_BAR + 16384, OFF_A2T = OFF_W2T + 65536, OFF_G2T = OFF_A2T + 65536;
constexpr size_t WS_NEED = OFF_G2T + 131072;
constexpr size_t OFF_H3 = OFF_HF + (size_t)M_TOK * 2816 * 2;
constexpr size_t OFF_LD = OFF_A, OFF_AA = OFF_A + S512;
static_assert(OFF_H3 + (size_t)M_TOK * 1024 * 4 == OFF_END, "map");
constexpr size_t OO_GA = 0, OO_GG = S1024, OO_RHO = S1024 + S512;
constexpr size_t O_YP = 0, O_YS = 16777216, O_RETP = 17301504, O_WKVP = 17563648, O_SHP = 17825792, O_RETS = 17840128, O_WKVS = 22034432, O_SHS = 26228736;

struct Params {
  const float *x_prompt, *x_sample, *state_ret, *state_wkv, *state_shift, *meta;
  const float *ffn1_norm, *ffn1_wg, *ffn1_wu, *ffn1_wd, *mix_norm, *w_in, *ret_gn_g, *mu, *w0, *w2, *a0, *a2, *g2, *k_k, *k_a, *r_k, *lnx_g, *lnx_b;
  const float *w_out_ret, *w_out_rwkv, *w_out, *ffn2_norm, *ffn2_wg, *ffn2_wu, *ffn2_wd, *final_norm;
  float* out;
  unsigned char* ws;
  float invf[32];
  float lg2g[4];
  int phase_lo, phase_hi;
};


#define XB_TMO      128
#define XB_XCNT(j)  (256  + 64 * (j))
#define XB_XSUB(j)  (1280 + 64 * (j))
#define XB_XGEN(j)  (2304 + 64 * (j))
#define XB_TOP      3328
#define XB_TOPGEN   3392
#define XCD_BAR_WORDS 3456
#define XB_SPIN_CAP (1u << 18)
#define LAS __attribute__((address_space(3)))
__device__ __forceinline__ unsigned xb_ld(unsigned* p)              { return __hip_atomic_load(p, __ATOMIC_RELAXED, __HIP_MEMORY_SCOPE_AGENT); }
__device__ __forceinline__ unsigned xb_add(unsigned* p, unsigned v) { return __hip_atomic_fetch_add(p, v, __ATOMIC_RELAXED, __HIP_MEMORY_SCOPE_AGENT); }
__device__ __forceinline__ unsigned xb_xcc_id() { return (unsigned)__builtin_amdgcn_s_getreg((3 << 11) | 20) & 0xFu; }
#define XB_SPIN(cond, bar) do { unsigned _sp = 0; while (cond) { __builtin_amdgcn_s_sleep(1); \
    if ((++_sp & 255u) == 0u) { if (xb_ld(&(bar)[XB_TMO])) break; if (_sp > XB_SPIN_CAP) { atomicAdd(&(bar)[XB_TMO], 1u); break; } } } } while (0)
struct XcdBarrier { unsigned* bar; unsigned x; volatile LAS unsigned* st; };
__device__ __forceinline__ XcdBarrier xcd_barrier_post(unsigned* bar, volatile LAS unsigned* st) {
    XcdBarrier b; b.bar = bar; b.x = xb_xcc_id(); b.st = st;
    if (threadIdx.x == 0) (void)xb_add(&bar[XB_XCNT(b.x)], 1u);
    return b;
}
__device__ __forceinline__ void xcd_barrier_complete(unsigned* bar, unsigned x, unsigned& nloc, unsigned& nx) {
    const unsigned G = gridDim.x * gridDim.y * gridDim.z;
    unsigned sum, cnt, mine, sp = 0u;
    for (;;) {
        sum = 0u; cnt = 0u; mine = 0u;
#pragma unroll
        for (unsigned j = 0; j < 16; ++j) { const unsigned c = xb_ld(&bar[XB_XCNT(j)]); sum += c; cnt += (c > 0u) ? 1u : 0u; mine = (j == x) ? c : mine; }
        if (sum == G) break;
        __builtin_amdgcn_s_sleep(1);
        if ((++sp & 255u) == 0u) { if (xb_ld(&bar[XB_TMO])) break; if (sp > XB_SPIN_CAP) { atomicAdd(&bar[XB_TMO], 1u); break; } }
    }
    nloc = mine > 0u ? mine : 1u; nx = cnt > 0u ? cnt : 1u;
}
__device__ __forceinline__ void xcd_barrier(const XcdBarrier& b) {
    asm volatile("s_waitcnt vmcnt(0)" ::: "memory");
    __syncthreads();
    if (threadIdx.x == 0) {
        unsigned* bar = b.bar;
        __builtin_amdgcn_s_waitcnt(0);
        unsigned nloc = b.st[0], nx = b.st[1];
        if (nloc == 0u) { xcd_barrier_complete(bar, b.x, nloc, nx); b.st[0] = nloc; b.st[1] = nx; }
        const unsigned old = xb_add(&bar[XB_XSUB(b.x)], 1u);
        const unsigned gen = old / nloc;
        if (old + 1u == (gen + 1u) * nloc) {
            __builtin_amdgcn_fence(__ATOMIC_RELEASE, "agent");
            asm volatile("s_waitcnt vmcnt(0)" ::: "memory");
            const unsigned og = xb_add(&bar[XB_TOP], 1u);
            const unsigned tg = og / nx;
            if (og + 1u == (tg + 1u) * nx) xb_add(&bar[XB_TOPGEN], 1u);
            else XB_SPIN(xb_ld(&bar[XB_TOPGEN]) == tg, bar);
            __builtin_amdgcn_fence(__ATOMIC_ACQUIRE, "agent");
            xb_add(&bar[XB_XGEN(b.x)], 1u);
            asm volatile("s_waitcnt vmcnt(0)" ::: "memory");
        } else {
            XB_SPIN(xb_ld(&bar[XB_XGEN(b.x)]) == gen, bar);
            __builtin_amdgcn_fence(__ATOMIC_ACQUIRE, "agent");
            asm volatile("s_waitcnt vmcnt(0)" ::: "memory");
        }
    }
    __syncthreads();
}

__device__ __forceinline__ float bf2f(unsigned h) { return __uint_as_float(h << 16); }
__device__ __forceinline__ unsigned f2bf(float f) { unsigned u = __float_as_uint(f); return (u + 0x7fffu + ((u >> 16) & 1u)) >> 16; }
__device__ __forceinline__ unsigned pk2(float a, float b) { return f2bf(a) | (f2bf(b) << 16); }
__device__ __forceinline__ uint2 pk4(float a, float b, float c, float d) { uint2 r; r.x = pk2(a, b); r.y = pk2(c, d); return r; }
__device__ __forceinline__ void unpk4(uint2 u, float (&o)[4]) { o[0] = __uint_as_float(u.x << 16); o[1] = __uint_as_float(u.x & 0xffff0000u); o[2] = __uint_as_float(u.y << 16); o[3] = __uint_as_float(u.y & 0xffff0000u); }
template <int CTRL> __device__ __forceinline__ float dppf(float x) { return __builtin_bit_cast(float, __builtin_amdgcn_update_dpp(0, __builtin_bit_cast(int, x), CTRL, 0xf, 0xf, true)); }
__device__ __forceinline__ float rowsum16(float x) { x += dppf<0xB1>(x); x += dppf<0x4E>(x); x += dppf<0x141>(x); x += dppf<0x140>(x); return x; }
__device__ __forceinline__ float wavesum(float x) {
#pragma unroll
  for (int o = 32; o >= 1; o >>= 1) x += __shfl_xor(x, o);
  return x;
}
__device__ __forceinline__ float sigmoidf(float x) { return 1.f / (1.f + __expf(-x)); }
__device__ __forceinline__ float siluf(float x) { return x / (1.f + __expf(-x)); }

__device__ __forceinline__ const float* x_row(const Params& p, int row) {
  if (row < MP) { const int b = row / TP, t = row - b * TP; return t < 16 ? p.meta + t * 1024 : p.x_prompt + (size_t)(b * 2048 + t - 16) * 1024; }
  return p.x_sample + (size_t)(row - MP) * 1024;
}

__device__ __forceinline__ void transpose_tile(const float* __restrict__ src, int K, int N, bf16_t* __restrict__ dst, int rs, int ro, int t, unsigned char* lds) {
  float* tile = (float*)lds;
  const int tid = threadIdx.x;
  const int tn = N / 64;
  const int k0 = (t / tn) * 64, n0 = (t % tn) * 64;
  __syncthreads();
  { const int n = tid & 63, kq = tid >> 6;
#pragma unroll
    for (int i = 0; i < 16; ++i) { const int k = kq + 4 * i; tile[k * 65 + n] = src[(size_t)(k0 + k) * N + n0 + n]; } }
  __syncthreads();
  { const int kp = tid & 31, nq = tid >> 5;
#pragma unroll
    for (int i = 0; i < 8; ++i) { const int n = nq + 8 * i; const float v0 = tile[(2 * kp) * 65 + n], v1 = tile[(2 * kp + 1) * 65 + n];
      *(unsigned*)(dst + (size_t)((n0 + n) * rs + ro) * K + k0 + 2 * kp) = pk2(v0, v1); } }
}
__device__ __forceinline__ void transpose_tiles(const float* __restrict__ src, int K, int N, bf16_t* __restrict__ dst, int rs, int ro, unsigned char* lds) {
  const int nt = (K / 64) * (N / 64);
#pragma unroll 1
  for (int t = blockIdx.x; t < nt; t += gridDim.x) transpose_tile(src, K, N, dst, rs, ro, t, lds);
}

template <int SRC, int DST> __device__ __forceinline__ void rmsnorm_phase(const Params& p, const float* __restrict__ g, bf16_t* dstb) {
  const int lane = threadIdx.x & 63, wid = threadIdx.x >> 6;
  const bf16_t* H = (const bf16_t*)(p.ws + OFF_H);
  const float* H3 = (const float*)(p.ws + OFF_H3);
  for (int row = blockIdx.x * 4 + wid; row < M_TOK; row += gridDim.x * 4) {
    float v[16];
    const float* xr = SRC == 0 ? x_row(p, row) : nullptr;
#pragma unroll
    for (int i = 0; i < 4; ++i) {
      const int col = i * 256 + lane * 4;
      if (SRC == 0) { const float4 t = *(const float4*)(xr + col); v[4 * i] = t.x; v[4 * i + 1] = t.y; v[4 * i + 2] = t.z; v[4 * i + 3] = t.w; }
      else if (SRC == 1) { const uint2 u = *(const uint2*)(H + (size_t)row * 1024 + col); float o[4]; unpk4(u, o); v[4 * i] = o[0]; v[4 * i + 1] = o[1]; v[4 * i + 2] = o[2]; v[4 * i + 3] = o[3]; }
      else { const float4 t = *(const float4*)(H3 + (size_t)row * 1024 + col); v[4 * i] = t.x; v[4 * i + 1] = t.y; v[4 * i + 2] = t.z; v[4 * i + 3] = t.w; }
    }
    float ss = 0.f;
#pragma unroll
    for (int i = 0; i < 16; ++i) ss += v[i] * v[i];
    ss = wavesum(ss);
    const float rstd = rsqrtf(ss * (1.f / 1024.f) + 1e-6f);
    float* orow = nullptr;
    if (DST == 1) {
      if (row < MP) { const int b = row / TP, t = row - b * TP; if (t >= 16) orow = p.out + O_YP + (size_t)(b * 2048 + t - 16) * 1024; }
      else orow = p.out + O_YS + (size_t)(row - MP) * 1024;
    }
#pragma unroll
    for (int i = 0; i < 4; ++i) {
      const int col = i * 256 + lane * 4;
      const float4 gv = *(const float4*)(g + col);
      const float y0 = v[4 * i] * rstd * gv.x, y1 = v[4 * i + 1] * rstd * gv.y, y2 = v[4 * i + 2] * rstd * gv.z, y3 = v[4 * i + 3] * rstd * gv.w;
      if (DST == 0) *(uint2*)(dstb + (size_t)row * 1024 + col) = pk4(y0, y1, y2, y3);
      else if (orow) *(float4*)(orow + col) = make_float4(y0, y1, y2, y3);
    }
  }
}

#define RAW_BARRIER() do { asm volatile("s_waitcnt lgkmcnt(0)" ::: "memory"); __builtin_amdgcn_s_barrier(); asm volatile("" ::: "memory"); } while (0)
template <int MI> __device__ __forceinline__ void gemm_tile_dma(const bf16_t* __restrict__ A, int lda, const bf16_t* __restrict__ Bt, int ldb, int K, int m0, int n0, f32x4 (&acc)[MI][4], unsigned char* lds) {
  constexpr int BMT = 32 * MI, NA = 2 * MI, NAW = (NA + 3) / 4, STG = (BMT + 128) * 64;
  static_assert(3 * STG <= LDS_BYTES, "ring does not fit");
  const int tid = threadIdx.x, lane = tid & 63, wid = tid >> 6, wm = wid >> 1, wn = wid & 1, l15 = lane & 15, l4 = lane >> 4;
  const int nk = K >> 5;
  const int qd = (lane >> 4) & 3, cs = ((lane & 3) ^ (((qd << 1) ^ ((qd >> 1) * 3)) & 3)) * 8;
  const bf16_t* ag[NAW]; const bf16_t* bg[2];
#pragma unroll
  for (int i = 0; i < NAW; ++i) { int row = m0 + (wid + 4 * i) * 16 + (lane >> 2); row = row < M_TOK ? row : M_TOK - 1; ag[i] = A + (size_t)row * lda + cs; }
#pragma unroll
  for (int i = 0; i < 2; ++i) { const int row = n0 + (wid * 2 + i) * 16 + (lane >> 2); bg[i] = Bt + (size_t)row * ldb + cs; }
  auto issue = [&](int kt, int buf) {
    unsigned char* sb = lds + buf * STG + lane * 16;
#pragma unroll
    for (int i = 0; i < NAW; ++i) if (wid + 4 * i < NA) __builtin_amdgcn_global_load_lds((const unsigned*)(ag[i] + kt * 32), (LAS unsigned*)(sb + (wid + 4 * i) * 1024), 16, 0, 0);
#pragma unroll
    for (int i = 0; i < 2; ++i) __builtin_amdgcn_global_load_lds((const unsigned*)(bg[i] + kt * 32), (LAS unsigned*)(sb + BMT * 64 + (wid * 2 + i) * 1024), 16, 0, 0);
  };
  const int qr = (l15 >> 2) & 3, sw = ((l4 ^ ((qr << 1) ^ ((qr >> 1) * 3))) & 3) * 16;
  const int aofs = (wm * 16 * MI + l15) * 64 + sw, bofs = BMT * 64 + (wn * 64 + l15) * 64 + sw;
  const bool big = (NA % 4 == 0) || (wid < NA % 4);
  RAW_BARRIER();
  issue(0, 0);
  if (nk > 1) issue(1, 1);
  int bc = 0, bi = 2;
  for (int kt = 0; kt < nk; ++kt) {
    if (kt + 1 < nk) {
      if (MI == 8) asm volatile("s_waitcnt vmcnt(6)" ::: "memory");
      else if (big) asm volatile("s_waitcnt vmcnt(5)" ::: "memory");
      else asm volatile("s_waitcnt vmcnt(4)" ::: "memory");
    } else asm volatile("s_waitcnt vmcnt(0)" ::: "memory");
    RAW_BARRIER();
    if (kt + 2 < nk) issue(kt + 2, bi);
    const unsigned char* st = lds + bc * STG;
    bf16x8 af[MI], bfr[4];
#pragma unroll
    for (int i = 0; i < MI; ++i) af[i] = *(const bf16x8*)(st + aofs + i * 1024);
#pragma unroll
    for (int i = 0; i < 4; ++i) bfr[i] = *(const bf16x8*)(st + bofs + i * 1024);
#pragma unroll
    for (int mi = 0; mi < MI; ++mi)
#pragma unroll
      for (int ni = 0; ni < 4; ++ni) acc[mi][ni] = __builtin_amdgcn_mfma_f32_16x16x32_bf16(bfr[ni], af[mi], acc[mi][ni], 0, 0, 0);
    bc = bc == 2 ? 0 : bc + 1; bi = bi == 2 ? 0 : bi + 1;
  }
}

#ifndef GMT
#define GMT 4
#endif
__device__ __forceinline__ void tile_coords(int L, int nM, int nN, int& tm, int& tn) {
  const int nwg = nM * nN, q = nwg / 8, r = nwg % 8, xcd = L % 8, off = L / 8;
  const int wg = (xcd < r ? xcd * (q + 1) : r * (q + 1) + (xcd - r) * q) + off;
  const int nig = GMT * nN, gid = wg / nig, fm = gid * GMT, gsz = min(nM - fm, GMT);
  tm = fm + (wg % nig) % gsz; tn = (wg % nig) / gsz;
}

#define ZERO_ACC(a) _Pragma("unroll") for (int _i = 0; _i < 4; ++_i) _Pragma("unroll") for (int _j = 0; _j < 4; ++_j) a[_i][_j] = (f32x4){0.f, 0.f, 0.f, 0.f}
#define ZERO_ACC8(a) _Pragma("unroll") for (int _i = 0; _i < 8; ++_i) _Pragma("unroll") for (int _j = 0; _j < 4; ++_j) a[_i][_j] = (f32x4){0.f, 0.f, 0.f, 0.f}
#define EPI_VARS8 const int lane = threadIdx.x & 63, wid = threadIdx.x >> 6, wm = wid >> 1, wn = wid & 1; const int rbase = tm * 256 + wm * 128 + (lane & 15), cbase = tn * 128 + wn * 64 + (lane >> 4) * 4
#define NMT 67
#define NMT5 107
#define ZERO_ACC5(a) _Pragma("unroll") for (int _i = 0; _i < 5; ++_i) _Pragma("unroll") for (int _j = 0; _j < 4; ++_j) a[_i][_j] = (f32x4){0.f, 0.f, 0.f, 0.f}
#define EPI_VARS5 const int lane = threadIdx.x & 63, wid = threadIdx.x >> 6, wm = wid >> 1, wn = wid & 1; const int rbase = tm * 160 + wm * 80 + (lane & 15), cbase = tn * 128 + wn * 64 + (lane >> 4) * 4
#define EPI_VARS const int lane = threadIdx.x & 63, wid = threadIdx.x >> 6, wm = wid >> 1, wn = wid & 1; const int rbase = tm * 128 + wm * 64 + (lane & 15), cbase = tn * 128 + wn * 64 + (lane >> 4) * 4

__device__ __forceinline__ void transpose_jobs(const Params& p, int jlo, int jhi, unsigned char* lds) {
  unsigned char* ws = p.ws;
#pragma unroll 1
  for (int j = jlo; j < jhi; ++j) {
    const float* src; int K, N, rs = 1, ro = 0; size_t off;
    switch (j) {
      case 0: src = p.ffn1_wg; K = 1024; N = 2816; off = OFF_W1GU; rs = 2; break;
      case 1: src = p.ffn1_wu; K = 1024; N = 2816; off = OFF_W1GU; rs = 2; ro = 1; break;
      case 2: src = p.ffn1_wd; K = 2816; N = 1024; off = OFF_W1D; break;
      case 3: src = p.w_in; K = 1024; N = 5376; off = OFF_WIN; break;
      case 4: src = p.w_out_ret; K = 512; N = 1024; off = OFF_WR; break;
      case 5: src = p.w_out_rwkv; K = 512; N = 1024; off = OFF_WW; break;
      case 6: src = p.w_out; K = 1024; N = 1024; off = OFF_WO; break;
      case 7: src = p.ffn2_wg; K = 1024; N = 2816; off = OFF_W1GU; rs = 2; break;
      case 8: src = p.ffn2_wu; K = 1024; N = 2816; off = OFF_W1GU; rs = 2; ro = 1; break;
      case 9: src = p.ffn2_wd; K = 2816; N = 1024; off = OFF_W1D; break;
      case 10: src = p.w2; K = 64; N = 512; off = OFF_W2T; break;
      case 11: src = p.a2; K = 64; N = 512; off = OFF_A2T; break;
      default: src = p.g2; K = 128; N = 512; off = OFF_G2T; break;
    }
    transpose_tiles(src, K, N, (bf16_t*)(ws + off), rs, ro, lds);
  }
}
__device__ __forceinline__ void phase0(const Params& p, unsigned char* lds) {
  transpose_jobs(p, 0, 7, lds);
  transpose_jobs(p, 10, 13, lds);
  rmsnorm_phase<0, 0>(p, p.ffn1_norm, (bf16_t*)(p.ws + OFF_A));
}

__device__ __forceinline__ void phase_ffn_up(const Params& p, unsigned char* lds) {
  const bf16_t* A = (const bf16_t*)(p.ws + OFF_A); const bf16_t* W = (const bf16_t*)(p.ws + OFF_W1GU); bf16_t* HF = (bf16_t*)(p.ws + OFF_HF);
  const int nM = NMT, nN = 5632 / 128;
  for (int L = blockIdx.x; L < nM * nN; L += gridDim.x) {
    int tm, tn; tile_coords(L, nM, nN, tm, tn);
    f32x4 acc[8][4]; ZERO_ACC8(acc);
    gemm_tile_dma<8>(A, 1024, W, 1024, 1024, tm * 256, tn * 128, acc, lds);
    EPI_VARS8;
#pragma unroll
    for (int mi = 0; mi < 8; ++mi) {
      const int row = rbase + mi * 16;
      if (row < M_TOK) {
#pragma unroll
        for (int ni = 0; ni < 4; ++ni) {
          const int c = (cbase + ni * 16) >> 1; const f32x4 a = acc[mi][ni];
          *(unsigned*)(HF + (size_t)row * 2816 + c) = pk2(siluf(a[0]) * a[1], siluf(a[2]) * a[3]);
        }
      }
    }
  }
}

template <bool FIRST> __device__ __forceinline__ void phase_ffn_down(const Params& p, unsigned char* lds) {
  const bf16_t* A = (const bf16_t*)(p.ws + OFF_HF); const bf16_t* W = (const bf16_t*)(p.ws + OFF_W1D);
  bf16_t* H = (bf16_t*)(p.ws + OFF_H); float* H3 = (float*)(p.ws + OFF_H3);
  const int nM = NMT5, nN = 8;
  for (int L = blockIdx.x; L < nM * nN; L += gridDim.x) {
    int tm, tn; tile_coords(L, nM, nN, tm, tn);
    f32x4 acc[5][4]; ZERO_ACC5(acc);
    gemm_tile_dma<5>(A, 2816, W, 2816, 2816, tm * 160, tn * 128, acc, lds);
    EPI_VARS5;
#pragma unroll
    for (int mi = 0; mi < 5; ++mi) {
      const int row = rbase + mi * 16;
      if (row < M_TOK) {
        const float* xr = FIRST ? x_row(p, row) : nullptr;
#pragma unroll
        for (int ni = 0; ni < 4; ++ni) {
          const int col = cbase + ni * 16; const f32x4 a = acc[mi][ni];
          if (FIRST) { const float4 xv = *(const float4*)(xr + col);
            *(uint2*)(H + (size_t)row * 1024 + col) = pk4(xv.x + 0.5f * a[0], xv.y + 0.5f * a[1], xv.z + 0.5f * a[2], xv.w + 0.5f * a[3]); }
          else { float h[4]; unpk4(*(const uint2*)(H + (size_t)row * 1024 + col), h);
            *(float4*)(H3 + (size_t)row * 1024 + col) = make_float4(h[0] + 0.5f * a[0], h[1] + 0.5f * a[1], h[2] + 0.5f * a[2], h[3] + 0.5f * a[3]); }
        }
      }
    }
  }
}

__device__ __forceinline__ void rope_cs(float ang, float& c, float& s) {
  double rev = (double)ang * 0.15915494309189535; rev -= rint(rev); const float fr = (float)rev;
  s = __builtin_amdgcn_sinf(fr); c = __builtin_amdgcn_cosf(fr);
}
__device__ __forceinline__ void phase_win(const Params& p, unsigned char* lds) {
  const bf16_t* A = (const bf16_t*)(p.ws + OFF_A); const bf16_t* W = (const bf16_t*)(p.ws + OFF_WIN);
  bf16_t* QK = (bf16_t*)(p.ws + OFF_QK); bf16_t* V = (bf16_t*)(p.ws + OFF_V); bf16_t* GR = (bf16_t*)(p.ws + OFF_GR); bf16_t* PR = (bf16_t*)(p.ws + OFF_PR);
  bf16_t* GB = (bf16_t*)(p.ws + OFF_GB); bf16_t* GA = (bf16_t*)((unsigned char*)p.out + OO_GA);
  const int nM = NMT, nN = 5376 / 128;
  for (int L = blockIdx.x; L < nM * nN; L += gridDim.x) {
    int tm, tn; tile_coords(L, nM, nN, tm, tn);
    f32x4 acc[8][4]; ZERO_ACC8(acc);
    gemm_tile_dma<8>(A, 1024, W, 1024, 1024, tm * 256, tn * 128, acc, lds);
    EPI_VARS8;
    const int n0 = tn * 128;
    if (n0 < 512) {
      const float sc = n0 >= 256 ? 0.125f : 1.0f;
      const int hb = n0 + wn * 64;
#pragma unroll
      for (int mi = 0; mi < 8; ++mi) {
        const int row = rbase + mi * 16;
        if (row >= M_TOK) continue;
        const float pos = row < MP ? (float)(row % TP) : (float)(PAST + ((row - MP) & 3));
#pragma unroll
        for (int ni = 0; ni < 2; ++ni) {
          float o1[4], o2[4];
#pragma unroll
          for (int jj = 0; jj < 4; ++jj) {
            const int j = ni * 16 + (lane >> 4) * 4 + jj;
            float c, s; rope_cs(pos * p.invf[j], c, s);
            const float x1 = acc[mi][ni][jj], x2 = acc[mi][ni + 2][jj];
            o1[jj] = (x1 * c - x2 * s) * sc; o2[jj] = (x1 * s + x2 * c) * sc;
          }
          const int j0 = ni * 16 + (lane >> 4) * 4;
          *(uint2*)(QK + (size_t)row * 512 + hb + j0) = pk4(o1[0], o1[1], o1[2], o1[3]);
          *(uint2*)(QK + (size_t)row * 512 + hb + 32 + j0) = pk4(o2[0], o2[1], o2[2], o2[3]);
        }
      }
    } else {
#pragma unroll
      for (int mi = 0; mi < 8; ++mi) {
        const int row = rbase + mi * 16;
        if (row >= M_TOK) continue;
        float* sh = nullptr;
        if (row < MP) { const int b = row / TP; if (row - b * TP == TP - 1) sh = p.out + O_SHP + (size_t)b * 1792; }
        else { const int r2 = row - MP; if ((r2 & 3) == 3) sh = p.out + O_SHS + (size_t)(r2 >> 2) * 1792; }
#pragma unroll
        for (int ni = 0; ni < 4; ++ni) {
          const int col = cbase + ni * 16; const f32x4 a = acc[mi][ni];
          if (n0 < 1024) *(uint2*)(V + (size_t)row * 512 + (col - 512)) = pk4(a[0], a[1], a[2], a[3]);
          else if (n0 < 1536) *(uint2*)(GR + (size_t)row * 512 + (col - 1024)) = pk4(siluf(a[0]), siluf(a[1]), siluf(a[2]), siluf(a[3]));
          else if (n0 < 3328) { *(uint2*)(PR + (size_t)row * 1792 + (col - 1536)) = pk4(a[0], a[1], a[2], a[3]);
            if (sh) *(float4*)(sh + (col - 1536)) = make_float4(a[0], a[1], a[2], a[3]); }
          else if (n0 < 4352) *(uint2*)(GA + (size_t)row * 1024 + (col - 3328)) = pk4(sigmoidf(a[0]), sigmoidf(a[1]), sigmoidf(a[2]), sigmoidf(a[3]));
          else *(uint2*)(GB + (size_t)row * 1024 + (col - 4352)) = pk4(sigmoidf(a[0]), sigmoidf(a[1]), sigmoidf(a[2]), sigmoidf(a[3]));
        }
      }
    }
  }
}

__device__ __forceinline__ void phase_lora(const Params& p, unsigned char* lds) {
  float* sS = (float*)lds;
  const int tid = threadIdx.x;
  const bf16_t* PR = (const bf16_t*)(p.ws + OFF_PR);
  bf16_t* LD = (bf16_t*)(p.ws + OFF_LD); bf16_t* AA = (bf16_t*)(p.ws + OFF_AA); bf16_t* GG = (bf16_t*)((unsigned char*)p.out + OO_GG);
  const float mu_j = p.mu[1536 + tid];
  for (int tile = blockIdx.x; tile < M_TOK / 16; tile += gridDim.x) {
    const int row0 = tile * 16;
    __syncthreads();
#pragma unroll 4
    for (int tt = 0; tt < 16; ++tt) {
      const int row = row0 + tt;
      const float pc = bf2f(PR[(size_t)row * 1792 + 1536 + tid]);
      float pp;
      if (row < MP) { const int t = row % TP; pp = t == 0 ? 0.f : bf2f(PR[(size_t)(row - 1) * 1792 + 1536 + tid]); }
      else { const int r2 = row - MP; pp = (r2 & 3) == 0 ? p.state_shift[(size_t)(r2 >> 2) * 1792 + 1536 + tid] : bf2f(PR[(size_t)(row - 1) * 1792 + 1536 + tid]); }
      const float pm = pc + (pp - pc) * mu_j;
      sS[tt * 256 + tid] = tid < 64 ? tanhf(pm) : (tid < 128 ? pm : sigmoidf(pm));
    }
    __syncthreads();
#pragma unroll 1
    for (int which = 0; which < 3; ++which) {
      const float* Wm = which == 0 ? p.w2 : (which == 1 ? p.a2 : p.g2);
      const int jb = which == 0 ? 0 : (which == 1 ? 64 : 128), nj = which == 2 ? 128 : 64;
      float acc0[16], acc1[16];
#pragma unroll
      for (int tt = 0; tt < 16; ++tt) { acc0[tt] = 0.f; acc1[tt] = 0.f; }
      for (int j = 0; j < nj; j += 4) {
        float wa[4], wb[4];
#pragma unroll
        for (int e = 0; e < 4; ++e) { wa[e] = Wm[(size_t)(j + e) * 512 + tid]; wb[e] = Wm[(size_t)(j + e) * 512 + tid + 256]; }
#pragma unroll
        for (int tt = 0; tt < 16; ++tt) {
          const float4 s4 = *(const float4*)(sS + tt * 256 + jb + j);
          acc0[tt] += s4.x * wa[0] + s4.y * wa[1] + s4.z * wa[2] + s4.w * wa[3];
          acc1[tt] += s4.x * wb[0] + s4.y * wb[1] + s4.z * wb[2] + s4.w * wb[3];
        }
      }
      if (which == 0) {
        const float b0 = p.w0[tid], b1 = p.w0[tid + 256];
#pragma unroll
        for (int tt = 0; tt < 16; ++tt) {
          const float x0 = -(b0 + acc0[tt]), x1 = -(b1 + acc1[tt]);
          const float sp0 = fmaxf(x0, 0.f) + log1pf(expf(-fabsf(x0))), sp1 = fmaxf(x1, 0.f) + log1pf(expf(-fabsf(x1)));
          LD[(size_t)(row0 + tt) * 512 + tid] = (bf16_t)f2bf(-expf(-sp0 - 0.5f));
          LD[(size_t)(row0 + tt) * 512 + tid + 256] = (bf16_t)f2bf(-expf(-sp1 - 0.5f));
        }
      } else if (which == 1) {
        const float b0 = p.a0[tid], b1 = p.a0[tid + 256];
#pragma unroll
        for (int tt = 0; tt < 16; ++tt) {
          AA[(size_t)(row0 + tt) * 512 + tid] = (bf16_t)f2bf(sigmoidf(b0 + acc0[tt]));
          AA[(size_t)(row0 + tt) * 512 + tid + 256] = (bf16_t)f2bf(sigmoidf(b1 + acc1[tt]));
        }
      } else {
#pragma unroll
        for (int tt = 0; tt < 16; ++tt) {
          GG[(size_t)(row0 + tt) * 512 + tid] = (bf16_t)f2bf(acc0[tt]);
          GG[(size_t)(row0 + tt) * 512 + tid + 256] = (bf16_t)f2bf(acc1[tt]);
        }
      }
    }
  }
}


__device__ __forceinline__ void phase_lora_mfma(const Params& p, unsigned char* lds) {
  constexpr int LSTR = 272;
  unsigned char* sA = lds; unsigned char* sB = lds + 128 * LSTR;
  const bf16_t* PR = (const bf16_t*)(p.ws + OFF_PR);
  bf16_t* LD = (bf16_t*)(p.ws + OFF_LD); bf16_t* AA = (bf16_t*)(p.ws + OFF_AA); bf16_t* GG = (bf16_t*)((unsigned char*)p.out + OO_GG);
  for (int grp = blockIdx.x; grp < (M_TOK / 128) * 3; grp += gridDim.x) {
    int tid_o = threadIdx.x; asm volatile("" : "+v"(tid_o));
    const int tid = tid_o, lane = tid & 63, wid = tid >> 6, wm = wid >> 1, wn = wid & 1, l15 = lane & 15, l4 = lane >> 4;
    const int tm = grp / 3, which = grp - tm * 3;
    const int Kc = which == 2 ? 128 : 64, jb = which == 0 ? 0 : (which == 1 ? 64 : 128), cpr = Kc >> 3;
    const bf16_t* Wt = (const bf16_t*)(p.ws + (which == 0 ? OFF_W2T : (which == 1 ? OFF_A2T : OFF_G2T)));
    __syncthreads();
    for (int q = tid; q < 128 * cpr; q += NT) {
      const int r = q / cpr, ck = q - r * cpr, row = tm * 128 + r, col = 1536 + jb + ck * 8;
      const u32x4 cu = *(const u32x4*)(PR + (size_t)row * 1792 + col);
      float pc[8], pp[8];
#pragma unroll
      for (int e = 0; e < 4; ++e) { pc[2 * e] = __uint_as_float(cu[e] << 16); pc[2 * e + 1] = __uint_as_float(cu[e] & 0xffff0000u); }
      bool first; const float* sprev = nullptr;
      if (row < MP) first = (row % TP) == 0; else { const int r2 = row - MP; first = (r2 & 3) == 0; sprev = p.state_shift + (size_t)(r2 >> 2) * 1792 + col; }
      if (!first) { const u32x4 pu = *(const u32x4*)(PR + (size_t)(row - 1) * 1792 + col);
#pragma unroll
        for (int e = 0; e < 4; ++e) { pp[2 * e] = __uint_as_float(pu[e] << 16); pp[2 * e + 1] = __uint_as_float(pu[e] & 0xffff0000u); } }
      else {
#pragma unroll
        for (int e = 0; e < 8; ++e) pp[e] = sprev ? sprev[e] : 0.f;
      }
      float sv[8];
#pragma unroll
      for (int e = 0; e < 8; ++e) {
        const float pm = pc[e] + (pp[e] - pc[e]) * p.mu[col + e];
        float t;
        if (which == 0) { const float ex = __expf(-2.f * fabsf(pm)); t = (1.f - ex) / (1.f + ex); t = pm < 0.f ? -t : t; }
        else if (which == 1) t = pm;
        else t = sigmoidf(pm);
        sv[e] = t;
      }
      u32x4 o; o[0] = pk2(sv[0], sv[1]); o[1] = pk2(sv[2], sv[3]); o[2] = pk2(sv[4], sv[5]); o[3] = pk2(sv[6], sv[7]);
      *(u32x4*)(sA + r * LSTR + ck * 16) = o;
    }
    for (int tn = 0; tn < 4; ++tn) {
      if (tn > 0) __syncthreads();
      for (int q = tid; q < 128 * cpr; q += NT) { const int r = q / cpr, ck = q - r * cpr; *(u32x4*)(sB + r * LSTR + ck * 16) = *(const u32x4*)(Wt + (size_t)(tn * 128 + r) * Kc + ck * 8); }
      __syncthreads();
      f32x4 acc[4][4]; ZERO_ACC(acc);
      for (int kk = 0; kk < (Kc >> 5); ++kk) {
        bf16x8 af[4], bfr[4];
#pragma unroll
        for (int i = 0; i < 4; ++i) { af[i] = *(const bf16x8*)(sA + (wm * 64 + i * 16 + l15) * LSTR + kk * 64 + l4 * 16); bfr[i] = *(const bf16x8*)(sB + (wn * 64 + i * 16 + l15) * LSTR + kk * 64 + l4 * 16); }
#pragma unroll
        for (int mi = 0; mi < 4; ++mi)
#pragma unroll
          for (int ni = 0; ni < 4; ++ni) acc[mi][ni] = __builtin_amdgcn_mfma_f32_16x16x32_bf16(bfr[ni], af[mi], acc[mi][ni], 0, 0, 0);
      }
#pragma unroll
      for (int ni = 0; ni < 4; ++ni) {
        const int col = tn * 128 + wn * 64 + ni * 16 + l4 * 4;
        float bias[4] = {0.f, 0.f, 0.f, 0.f};
        if (which == 0) { const float4 b4 = *(const float4*)(p.w0 + col); bias[0] = b4.x; bias[1] = b4.y; bias[2] = b4.z; bias[3] = b4.w; }
        else if (which == 1) { const float4 b4 = *(const float4*)(p.a0 + col); bias[0] = b4.x; bias[1] = b4.y; bias[2] = b4.z; bias[3] = b4.w; }
#pragma unroll
        for (int mi = 0; mi < 4; ++mi) {
          const int row = tm * 128 + wm * 64 + mi * 16 + l15;
          float o[4];
#pragma unroll
          for (int jj = 0; jj < 4; ++jj) {
            const float a = acc[mi][ni][jj] + bias[jj];
            if (which == 0) o[jj] = -0.87503879f * sigmoidf(a);
            else if (which == 1) o[jj] = sigmoidf(a);
            else o[jj] = a;
          }
          bf16_t* dst = which == 0 ? LD : (which == 1 ? AA : GG);
          *(uint2*)(dst + (size_t)row * 512 + col) = pk4(o[0], o[1], o[2], o[3]);
        }
      }
    }
  }
}

struct StageRegs { uint2 cr, ck, cv, qr, qk, qv, ld, aa; };

__device__ __forceinline__ void rwkv_item(const Params& p, int rowbase, int T, int h, int rb, const float* shift_prev, const float* S_in, float* S_out, unsigned char* lds) {
  float* stage = (float*)lds;
  float* ypart = (float*)(lds + 49152);
  int tid_f = threadIdx.x; asm volatile("" : "+v"(tid_f));
  const int tid = tid_f, lane = tid & 63, wid = tid >> 6;
  const int t_l = tid >> 4, c4 = tid & 15, ch = h * 64 + c4 * 4;
  const int kg = lane & 15, vloc = wid * 4 + (lane >> 4), vrow = rb * 16 + vloc;
  const bf16_t* PR = (const bf16_t*)(p.ws + OFF_PR); const bf16_t* LD = (const bf16_t*)(p.ws + OFF_LD); const bf16_t* AA = (const bf16_t*)(p.ws + OFF_AA);
  bf16_t* Y = (bf16_t*)(p.ws + OFF_Y); float* RHO = (float*)((unsigned char*)p.out + OO_RHO);
  float mur[4], muk[4], muv[4], kkc[4], kac[4], rkc[4];
#pragma unroll
  for (int e = 0; e < 4; ++e) { mur[e] = p.mu[ch + e]; muk[e] = p.mu[512 + ch + e]; muv[e] = p.mu[1024 + ch + e]; kkc[e] = p.k_k[ch + e]; kac[e] = p.k_a[ch + e]; rkc[e] = p.r_k[ch + e]; }
  f32x4 S;
  if (S_in) S = *(const f32x4*)(S_in + (size_t)vrow * 64 + kg * 4); else S = (f32x4){0.f, 0.f, 0.f, 0.f};
  f32x2 Sa = S.xy, Sb = S.zw;

  float rho_keep = 0.f; unsigned y_keep = 0u;
  auto load = [&](int t0, StageRegs& r) {
    int t = t0 + t_l; if (t > T - 1) t = T - 1;
    const bf16_t* cur = PR + (size_t)(rowbase + t) * 1792 + ch;
    r.cr = *(const uint2*)cur; r.ck = *(const uint2*)(cur + 512); r.cv = *(const uint2*)(cur + 1024);
    { const bf16_t* pv = t > 0 ? cur - 1792 : cur; r.qr = *(const uint2*)pv; r.qk = *(const uint2*)(pv + 512); r.qv = *(const uint2*)(pv + 1024); }
    r.ld = *(const uint2*)(LD + (size_t)(rowbase + t) * 512 + ch); r.aa = *(const uint2*)(AA + (size_t)(rowbase + t) * 512 + ch);
  };
  auto process = [&](int t0, const StageRegs& r, int buf, bool first) {
    float cr[4], ck[4], cv[4], qr[4], qk[4], qv[4], ld[4], aa[4];
    unpk4(r.cr, cr); unpk4(r.ck, ck); unpk4(r.cv, cv); unpk4(r.qr, qr); unpk4(r.qk, qk); unpk4(r.qv, qv); unpk4(r.ld, ld); unpk4(r.aa, aa);
    const int t = t0 + t_l;
    if (first && t == 0) {
#pragma unroll
      for (int e = 0; e < 4; ++e) { qr[e] = 0.f; qk[e] = 0.f; qv[e] = 0.f; }
    }
    if (first && t == 0 && shift_prev) {
#pragma unroll
      for (int e = 0; e < 4; ++e) { qr[e] = shift_prev[ch + e]; qk[e] = shift_prev[512 + ch + e]; qv[e] = shift_prev[1024 + ch + e]; }
    }
    float rr[4], k[4], v[4], kk[4], kp[4], bb[4], w[4];
    float ss = 0.f, rho = 0.f;
#pragma unroll
    for (int e = 0; e < 4; ++e) {
      rr[e] = cr[e] + (qr[e] - cr[e]) * mur[e]; k[e] = ck[e] + (qk[e] - ck[e]) * muk[e]; v[e] = cv[e] + (qv[e] - cv[e]) * muv[e];
      kk[e] = k[e] * kkc[e]; ss += kk[e] * kk[e];
      kp[e] = k[e] * (1.f + (aa[e] - 1.f) * kac[e]);
      rho += rr[e] * kp[e] * rkc[e];
      w[e] = __builtin_amdgcn_exp2f(ld[e]);
    }
    ss = rowsum16(ss); rho = rowsum16(rho);
    const float inv = rsqrtf(fmaxf(ss, 1e-24f));
#pragma unroll
    for (int e = 0; e < 4; ++e) { kk[e] *= inv; bb[e] = kk[e] * aa[e]; }
    float* sp = stage + (size_t)((buf * 16 + t_l) * 6) * 64 + c4 * 4;
    *(float4*)(sp) = make_float4(rr[0], rr[1], rr[2], rr[3]);
    *(float4*)(sp + 64) = make_float4(w[0], w[1], w[2], w[3]);
    *(float4*)(sp + 128) = make_float4(kp[0], kp[1], kp[2], kp[3]);
    *(float4*)(sp + 192) = make_float4(v[0], v[1], v[2], v[3]);
    *(float4*)(sp + 256) = make_float4(-kk[0], -kk[1], -kk[2], -kk[3]);
    *(float4*)(sp + 320) = make_float4(bb[0], bb[1], bb[2], bb[3]);
    rho_keep = rho;
    if (rb == 0 && c4 == 0 && t < T) RHO[(size_t)(rowbase + t) * 8 + h] = rho_keep;
  };

  const int nch = (T + 15) >> 4;
  StageRegs rgA, rgB;
  __syncthreads();
  load(0, rgA); process(0, rgA, 0, true);
  if (nch > 1) load(16, rgB);
  if (nch > 2) load(32, rgA);
  __syncthreads();
  auto chunk_body = [&](int c, StageRegs& rg) {
    const int buf = c & 1, t0 = c * 16;
    const int nsteps = min(16, T - t0);
    const float* st = stage + (size_t)(buf * 16) * 384;
    struct StepOps { f32x4 r[2], w[2], kp[2], nk[2], b[2]; float vv[2]; };
    auto loadg = [&](StepOps& g, int s0) {
#pragma unroll
      for (int u = 0; u < 2; ++u) {
        const float* sp = st + (s0 + u) * 384;
        g.r[u] = *(const f32x4*)(sp + kg * 4); g.w[u] = *(const f32x4*)(sp + 64 + kg * 4); g.kp[u] = *(const f32x4*)(sp + 128 + kg * 4);
        g.nk[u] = *(const f32x4*)(sp + 256 + kg * 4); g.b[u] = *(const f32x4*)(sp + 320 + kg * 4); g.vv[u] = sp[192 + vrow];
      }
    };
    auto compg = [&](const StepOps& g, int s0) {
      float yp[2];
#pragma unroll
      for (int u = 0; u < 2; ++u) {
        f32x2 pa = Sa * g.nk[u].xy; pa = Sb * g.nk[u].zw + pa;
        const float sa = rowsum16(pa.x + pa.y);
        const f32x2 sa2 = {sa, sa}, vv2 = {g.vv[u], g.vv[u]};
        const f32x2 Xa = sa2 * g.b[u].xy + vv2 * g.kp[u].xy, Xb = sa2 * g.b[u].zw + vv2 * g.kp[u].zw;
        Sa = Sa * g.w[u].xy + Xa; Sb = Sb * g.w[u].zw + Xb;
        f32x2 ya = Sa * g.r[u].xy; ya = Sb * g.r[u].zw + ya;
        yp[u] = ya.x + ya.y;
      }
#pragma unroll
      for (int u = 0; u < 2; ++u) ypart[((s0 + u) * 16 + vloc) * 16 + kg] = yp[u];
    };
    {
      StepOps ga, gb, gc;
      loadg(ga, 0); loadg(gb, 2);
      if (4 < nsteps) loadg(gc, 4);
      compg(ga, 0);
      if (6 < nsteps) loadg(ga, 6);
      compg(gb, 2);
      if (nsteps > 4) {
        loadg(gb, 8);  compg(gc, 4);
        loadg(gc, 10); compg(ga, 6);
        loadg(ga, 12); compg(gb, 8);
        loadg(gb, 14); compg(gc, 10);
        compg(ga, 12);
        compg(gb, 14);
      }
    }
    asm volatile("" :: "v"(y_keep), "v"(rho_keep));
    if (c + 1 < nch) process(t0 + 16, rg, buf ^ 1, false);
    if (c + 3 < nch) load(t0 + 48, rg);
    RAW_BARRIER();
    if (t_l < nsteps) {
      const f32x4* yp = (const f32x4*)(ypart + (t_l * 16 + c4) * 16);
      const f32x4 y0 = yp[0], y1 = yp[1], y2 = yp[2], y3 = yp[3];
      const float y = ((y0[0] + y0[1]) + (y0[2] + y0[3])) + ((y1[0] + y1[1]) + (y1[2] + y1[3])) + ((y2[0] + y2[1]) + (y2[2] + y2[3])) + ((y3[0] + y3[1]) + (y3[2] + y3[3]));
      y_keep = f2bf(y);
      Y[(size_t)(rowbase + t0 + t_l) * 512 + h * 64 + rb * 16 + c4] = (bf16_t)y_keep;
    }
    RAW_BARRIER();
  };
  for (int c = 0; c < nch; c += 2) {
    chunk_body(c, rgB);
    if (c + 1 < nch) chunk_body(c + 1, rgA);
  }
  S.xy = Sa; S.zw = Sb;
  *(f32x4*)(S_out + (size_t)vrow * 64 + kg * 4) = S;
}

__device__ __forceinline__ void ret_item(const Params& p, int rowbase, int T, int h, const float* S_in, float* S_out, unsigned char* lds, int cb, int ce, int seg, float* loc, unsigned* flags) {
  unsigned char* sQ = lds; unsigned char* sK = lds + 9216; unsigned char* sKdT = lds + 18432; unsigned char* sVT = lds + 27648; unsigned char* sP = lds + 46080; unsigned char* sST = lds + 55296;
  float* part = (float*)sK;
  int tid_f = threadIdx.x; asm volatile("" : "+v"(tid_f));
  const int tid = tid_f, lane = tid & 63, w = tid >> 6, l15 = lane & 15, l4 = lane >> 4;
  const bf16_t* QK = (const bf16_t*)(p.ws + OFF_QK); const bf16_t* V = (const bf16_t*)(p.ws + OFF_V); bf16_t* GR = (bf16_t*)(p.ws + OFF_GR);
  const float lg2 = p.lg2g[h];
  f32x4 ST[2][4];
#pragma unroll
  for (int vt = 0; vt < 2; ++vt)
#pragma unroll
    for (int dt = 0; dt < 4; ++dt) ST[vt][dt] = (f32x4){0.f, 0.f, 0.f, 0.f};
  u32x4 pq[2], pk[2], pv[4];
  auto prefetch = [&](int t0n, int tidp) {
    const int Ln = min(64, T - t0n);
#pragma unroll
    for (int i = 0; i < 2; ++i) {
      const int q_ = tidp + i * 256, j = q_ & 63, ck = q_ >> 6;
      pq[i] = (u32x4){0u, 0u, 0u, 0u}; pk[i] = pq[i];
      if (j < Ln) { const bf16_t* src = QK + (size_t)(rowbase + t0n + j) * 512 + h * 64 + ck * 8; pq[i] = *(const u32x4*)src; pk[i] = *(const u32x4*)(src + 256); }
    }
#pragma unroll
    for (int i = 0; i < 4; ++i) {
      const int q_ = tidp + i * 256, j = q_ & 63, cv = q_ >> 6;
      pv[i] = (u32x4){0u, 0u, 0u, 0u};
      if (j < Ln) pv[i] = *(const u32x4*)(V + (size_t)(rowbase + t0n + j) * 512 + h * 128 + cv * 8);
    }
  };
  if (seg >= 0 && seg < 3) {
    prefetch(cb * 64, threadIdx.x);
    for (int c = cb; c < ce; ++c) {
      const int t0 = c * 64, Lc = min(64, T - t0);
      int tid_o = threadIdx.x; asm volatile("" : "+v"(tid_o));
      const int tid = tid_o, lane = tid & 63, w = tid >> 6, l15 = lane & 15, l4 = lane >> 4;
      __syncthreads();
#pragma unroll
      for (int i = 0; i < 2; ++i) {
        const int q_ = tid + i * 256, j = q_ & 63, ck = q_ >> 6;
        const u32x4 kv = pk[i];
        const float kd = __builtin_amdgcn_exp2f((float)(Lc - 1 - j) * lg2);
#pragma unroll
        for (int e = 0; e < 4; ++e) {
          *(bf16_t*)(sKdT + (ck * 8 + 2 * e) * 144 + j * 2) = (bf16_t)f2bf(__uint_as_float(kv[e] << 16) * kd);
          *(bf16_t*)(sKdT + (ck * 8 + 2 * e + 1) * 144 + j * 2) = (bf16_t)f2bf(__uint_as_float(kv[e] & 0xffff0000u) * kd);
        }
      }
#pragma unroll
      for (int i = 0; i < 4; ++i) {
        const int q_ = tid + i * 256, j = q_ & 63, cv = q_ >> 6;
        const u32x4 vv = pv[i];
#pragma unroll
        for (int e = 0; e < 4; ++e) {
          *(bf16_t*)(sVT + (cv * 8 + 2 * e) * 144 + j * 2) = (bf16_t)(vv[e] & 0xffffu);
          *(bf16_t*)(sVT + (cv * 8 + 2 * e + 1) * 144 + j * 2) = (bf16_t)(vv[e] >> 16);
        }
      }
      if (c + 1 < ce) prefetch(t0 + 64, tid);
      __syncthreads();
      const float gl = __builtin_amdgcn_exp2f((float)Lc * lg2);
      bf16x8 bV[2][2];
#pragma unroll
      for (int vt = 0; vt < 2; ++vt)
#pragma unroll
        for (int kk = 0; kk < 2; ++kk) bV[vt][kk] = *(const bf16x8*)(sVT + (32 * w + vt * 16 + l15) * 144 + kk * 64 + l4 * 16);
#pragma unroll
      for (int dt = 0; dt < 4; ++dt) {
        bf16x8 bK[2];
#pragma unroll
        for (int kk = 0; kk < 2; ++kk) bK[kk] = *(const bf16x8*)(sKdT + (dt * 16 + l15) * 144 + kk * 64 + l4 * 16);
#pragma unroll
        for (int vt = 0; vt < 2; ++vt) {
          f32x4 a = ST[vt][dt] * gl;
#pragma unroll
          for (int kk = 0; kk < 2; ++kk) a = __builtin_amdgcn_mfma_f32_16x16x32_bf16(bV[vt][kk], bK[kk], a, 0, 0, 0);
          ST[vt][dt] = a;
        }
      }
    }
    float* lp = loc + (size_t)seg * 8192;
#pragma unroll
    for (int vt = 0; vt < 2; ++vt)
#pragma unroll
      for (int dt = 0; dt < 4; ++dt)
        *(float4*)(lp + (size_t)(dt * 16 + l15) * 128 + 32 * w + vt * 16 + l4 * 4) = make_float4(ST[vt][dt][0], ST[vt][dt][1], ST[vt][dt][2], ST[vt][dt][3]);
    __threadfence();
    __syncthreads();
    if (threadIdx.x == 0) { asm volatile("s_waitcnt vmcnt(0)" ::: "memory"); __hip_atomic_store(flags + seg, 1u, __ATOMIC_RELAXED, __HIP_MEMORY_SCOPE_AGENT); }
  }
#pragma unroll
  for (int vt = 0; vt < 2; ++vt)
#pragma unroll
    for (int dt = 0; dt < 4; ++dt) ST[vt][dt] = (f32x4){0.f, 0.f, 0.f, 0.f};
  if (seg > 0) {
    if (threadIdx.x == 0) {
      for (int s2 = 0; s2 < seg; ++s2) { unsigned sp = 0; while (__hip_atomic_load(flags + s2, __ATOMIC_RELAXED, __HIP_MEMORY_SCOPE_AGENT) == 0u) { __builtin_amdgcn_s_sleep(2); if (++sp > (1u << 22)) break; } }
      __builtin_amdgcn_fence(__ATOMIC_ACQUIRE, "agent");
      asm volatile("s_waitcnt vmcnt(0)" ::: "memory");
    }
    __syncthreads();
    for (int s2 = 0; s2 < seg; ++s2) {
      const float dk = __builtin_amdgcn_exp2f((float)(64 * (cb - 8 * (s2 + 1))) * lg2);
      const float* lp = loc + (size_t)s2 * 8192;
#pragma unroll
      for (int vt = 0; vt < 2; ++vt)
#pragma unroll
        for (int dt = 0; dt < 4; ++dt) {
          const float4 t4 = *(const float4*)(lp + (size_t)(dt * 16 + l15) * 128 + 32 * w + vt * 16 + l4 * 4);
          ST[vt][dt][0] += dk * t4.x; ST[vt][dt][1] += dk * t4.y; ST[vt][dt][2] += dk * t4.z; ST[vt][dt][3] += dk * t4.w;
        }
    }
  } else if (S_in) {
#pragma unroll
    for (int vt = 0; vt < 2; ++vt)
#pragma unroll
      for (int dt = 0; dt < 4; ++dt) {
        const float4 t4 = *(const float4*)(S_in + (size_t)(dt * 16 + l15) * 128 + 32 * w + vt * 16 + l4 * 4);
        ST[vt][dt][0] = t4.x; ST[vt][dt][1] = t4.y; ST[vt][dt][2] = t4.z; ST[vt][dt][3] = t4.w;
      }
  }
  __syncthreads();
#pragma unroll
  for (int vt = 0; vt < 2; ++vt)
#pragma unroll
    for (int dt = 0; dt < 4; ++dt)
#pragma unroll
      for (int jj = 0; jj < 4; ++jj) *(bf16_t*)(sST + (32 * w + vt * 16 + l4 * 4 + jj) * 144 + (dt * 16 + l15) * 2) = (bf16_t)f2bf(ST[vt][dt][jj]);
  prefetch(cb * 64, threadIdx.x);
  for (int c = cb; c < ce; ++c) {
    const int t0 = c * 64, Lc = min(64, T - t0);
    int tid_o = threadIdx.x; asm volatile("" : "+v"(tid_o));
    const int tid = tid_o, lane = tid & 63, w = tid >> 6, l15 = lane & 15, l4 = lane >> 4;
    __syncthreads();
#pragma unroll
    for (int i = 0; i < 2; ++i) {
      const int q_ = tid + i * 256, j = q_ & 63, ck = q_ >> 6;
      const u32x4 kv = pk[i];
      *(u32x4*)(sQ + j * 144 + ck * 16) = pq[i]; *(u32x4*)(sK + j * 144 + ck * 16) = kv;
      const float kd = __builtin_amdgcn_exp2f((float)(Lc - 1 - j) * lg2);
#pragma unroll
      for (int e = 0; e < 4; ++e) {
        *(bf16_t*)(sKdT + (ck * 8 + 2 * e) * 144 + j * 2) = (bf16_t)f2bf(__uint_as_float(kv[e] << 16) * kd);
        *(bf16_t*)(sKdT + (ck * 8 + 2 * e + 1) * 144 + j * 2) = (bf16_t)f2bf(__uint_as_float(kv[e] & 0xffff0000u) * kd);
      }
    }
#pragma unroll
    for (int i = 0; i < 4; ++i) {
      const int q_ = tid + i * 256, j = q_ & 63, cv = q_ >> 6;
      const u32x4 vv = pv[i];
#pragma unroll
      for (int e = 0; e < 4; ++e) {
        *(bf16_t*)(sVT + (cv * 8 + 2 * e) * 144 + j * 2) = (bf16_t)(vv[e] & 0xffffu);
        *(bf16_t*)(sVT + (cv * 8 + 2 * e + 1) * 144 + j * 2) = (bf16_t)(vv[e] >> 16);
      }
    }
    if (c + 1 < ce) prefetch(t0 + 64, tid);
    __syncthreads();
    {
      f32x4 sc[4];
#pragma unroll
      for (int jt = 0; jt < 4; ++jt) sc[jt] = (f32x4){0.f, 0.f, 0.f, 0.f};
#pragma unroll
      for (int kk = 0; kk < 2; ++kk) {
        const bf16x8 aq = *(const bf16x8*)(sQ + (16 * w + l15) * 144 + kk * 64 + l4 * 16);
#pragma unroll
        for (int jt = 0; jt < 4; ++jt) { const bf16x8 bk = *(const bf16x8*)(sK + (jt * 16 + l15) * 144 + kk * 64 + l4 * 16); sc[jt] = __builtin_amdgcn_mfma_f32_16x16x32_bf16(aq, bk, sc[jt], 0, 0, 0); }
      }
#pragma unroll
      for (int jt = 0; jt < 4; ++jt)
#pragma unroll
        for (int jj = 0; jj < 4; ++jj) {
          const int i = 16 * w + l4 * 4 + jj, j = jt * 16 + l15;
          const float pv = i >= j ? sc[jt][jj] * __builtin_amdgcn_exp2f((float)(i - j) * lg2) : 0.f;
          *(bf16_t*)(sP + i * 144 + j * 2) = (bf16_t)f2bf(pv);
        }
    }
    __syncthreads();
    f32x4 o[4][2];
    {
      bf16x8 bV[2][2], bS[2][2];
#pragma unroll
      for (int vt = 0; vt < 2; ++vt)
#pragma unroll
        for (int kk = 0; kk < 2; ++kk) {
          bV[vt][kk] = *(const bf16x8*)(sVT + (32 * w + vt * 16 + l15) * 144 + kk * 64 + l4 * 16);
          bS[vt][kk] = *(const bf16x8*)(sST + (32 * w + vt * 16 + l15) * 144 + kk * 64 + l4 * 16);
        }
#pragma unroll
      for (int it = 0; it < 4; ++it) {
        bf16x8 aP[2], aQ[2];
#pragma unroll
        for (int kk = 0; kk < 2; ++kk) { aP[kk] = *(const bf16x8*)(sP + (it * 16 + l15) * 144 + kk * 64 + l4 * 16); aQ[kk] = *(const bf16x8*)(sQ + (it * 16 + l15) * 144 + kk * 64 + l4 * 16); }
#pragma unroll
        for (int vt = 0; vt < 2; ++vt) {
          f32x4 a1 = (f32x4){0.f, 0.f, 0.f, 0.f}, a2 = (f32x4){0.f, 0.f, 0.f, 0.f};
#pragma unroll
          for (int kk = 0; kk < 2; ++kk) { a1 = __builtin_amdgcn_mfma_f32_16x16x32_bf16(aP[kk], bV[vt][kk], a1, 0, 0, 0); a2 = __builtin_amdgcn_mfma_f32_16x16x32_bf16(aQ[kk], bS[vt][kk], a2, 0, 0, 0); }
#pragma unroll
          for (int jj = 0; jj < 4; ++jj) { const int i = it * 16 + l4 * 4 + jj; o[it][vt][jj] = a1[jj] + __builtin_amdgcn_exp2f((float)(i + 1) * lg2) * a2[jj]; }
        }
      }
      const float gl = __builtin_amdgcn_exp2f((float)Lc * lg2);
#pragma unroll
      for (int dt = 0; dt < 4; ++dt) {
        bf16x8 bK[2];
#pragma unroll
        for (int kk = 0; kk < 2; ++kk) bK[kk] = *(const bf16x8*)(sKdT + (dt * 16 + l15) * 144 + kk * 64 + l4 * 16);
#pragma unroll
        for (int vt = 0; vt < 2; ++vt) {
          f32x4 a = ST[vt][dt] * gl;
#pragma unroll
          for (int kk = 0; kk < 2; ++kk) a = __builtin_amdgcn_mfma_f32_16x16x32_bf16(bV[vt][kk], bK[kk], a, 0, 0, 0);
          ST[vt][dt] = a;
#pragma unroll
          for (int jj = 0; jj < 4; ++jj) *(bf16_t*)(sST + (32 * w + vt * 16 + l4 * 4 + jj) * 144 + (dt * 16 + l15) * 2) = (bf16_t)f2bf(a[jj]);
        }
      }
    }
    unsigned short grv[4][4][2];
#pragma unroll
    for (int it = 0; it < 4; ++it)
#pragma unroll
      for (int jj = 0; jj < 4; ++jj) {
        const int i = it * 16 + l4 * 4 + jj;
#pragma unroll
        for (int vt = 0; vt < 2; ++vt) grv[it][jj][vt] = i < Lc ? GR[(size_t)(rowbase + t0 + i) * 512 + h * 128 + 32 * w + vt * 16 + l15] : (unsigned short)0;
      }
#pragma unroll
    for (int it = 0; it < 4; ++it)
#pragma unroll
      for (int jj = 0; jj < 4; ++jj) {
        float s1 = o[it][0][jj] + o[it][1][jj], s2 = o[it][0][jj] * o[it][0][jj] + o[it][1][jj] * o[it][1][jj];
        s1 = rowsum16(s1); s2 = rowsum16(s2);
        if (l15 == 0) { const int i = it * 16 + l4 * 4 + jj; part[(w * 64 + i) * 2] = s1; part[(w * 64 + i) * 2 + 1] = s2; }
      }
    const float gn[2] = {p.ret_gn_g[h * 128 + 32 * w + l15], p.ret_gn_g[h * 128 + 32 * w + 16 + l15]};
    __syncthreads();
#pragma unroll
    for (int it = 0; it < 4; ++it)
#pragma unroll
      for (int jj = 0; jj < 4; ++jj) {
        const int i = it * 16 + l4 * 4 + jj;
        float s1 = 0.f, s2 = 0.f;
#pragma unroll
        for (int ww = 0; ww < 4; ++ww) { s1 += part[(ww * 64 + i) * 2]; s2 += part[(ww * 64 + i) * 2 + 1]; }
        const float mean = s1 * (1.f / 128.f), var = fmaxf(s2 * (1.f / 128.f) - mean * mean, 0.f), rstd = rsqrtf(var + 1e-6f);
        if (i < Lc) {
#pragma unroll
          for (int vt = 0; vt < 2; ++vt) {
            const int v = 32 * w + vt * 16 + l15;
            bf16_t* gp = GR + (size_t)(rowbase + t0 + i) * 512 + h * 128 + v;
            *gp = (bf16_t)f2bf((o[it][vt][jj] - mean) * rstd * gn[vt] * bf2f(grv[it][jj][vt]));
          }
        }
      }
  }
  if (S_out)
#pragma unroll
  for (int vt = 0; vt < 2; ++vt)
#pragma unroll
    for (int dt = 0; dt < 4; ++dt)
      *(float4*)(S_out + (size_t)(dt * 16 + l15) * 128 + 32 * w + vt * 16 + l4 * 4) = make_float4(ST[vt][dt][0], ST[vt][dt][1], ST[vt][dt][2], ST[vt][dt][3]);
}

constexpr size_t OO_LOC = 56000000;
constexpr int NQ_LIGHT = 4608, NQ_TOTAL = 4608 + 3 * 704;
__device__ __forceinline__ void phase_scan(const Params& p, unsigned char* lds, volatile LAS unsigned* qslot) {
  const int G = gridDim.x;
  unsigned* flags_all = (unsigned*)(p.ws + OFF_BAR + 14336);
  unsigned* qctr = (unsigned*)(p.ws + OFF_BAR + 15360);
  float* loc_all = (float*)((unsigned char*)p.out + OO_LOC);
  int hid = blockIdx.x;
  bool heavy = true;
#pragma unroll 1
  while (true) {
    int item;
    if (heavy) { if (hid < 384) { item = hid; hid += G; } else { heavy = false; continue; } }
    else {
      __syncthreads();
      if (threadIdx.x == 0) *qslot = atomicAdd(qctr, 1u);
      __syncthreads();
      const int qi = (int)*qslot;
      if (qi >= NQ_TOTAL) break;
      item = 384 + qi;
    }
    int kind; int rowbase = 0, T = 0, h = 0, rb = 0, cb = 0, ce = 0, seg = -1; const float* shp = nullptr; const float* sin = nullptr; float* sout = nullptr; float* loc = nullptr; unsigned* flg = nullptr;
    if (item < 256) { const int j = item >> 3, seq = (item & 7) * 8 + (j >> 2), b = seq >> 3; rb = j & 3; h = seq & 7; kind = 0; rowbase = b * TP; T = TP; sout = p.out + O_WKVP + (size_t)seq * 4096; }
    else if (item < 384) { const int idx = item - 256, bh = idx >> 2, b = bh >> 2; seg = idx & 3; h = bh & 3; kind = 1; rowbase = b * TP; T = TP; cb = seg * 8; ce = seg == 3 ? 33 : cb + 8;
      sout = seg == 3 ? p.out + O_RETP + (size_t)bh * 8192 : nullptr; loc = loc_all + (size_t)bh * 3 * 8192; flg = flags_all + bh * 4; }
    else if (item < 384 + 4096) { const int it = item - 384, seq = it >> 2, b = seq >> 3; rb = it & 3; h = seq & 7; kind = 0; rowbase = MP + b * 4; T = 4;
      shp = p.state_shift + (size_t)b * 1792; sin = p.state_wkv + (size_t)seq * 4096; sout = p.out + O_WKVS + (size_t)seq * 4096; }
    else if (item < 384 + NQ_LIGHT) { const int bh = item - 384 - 4096, b = bh >> 2; h = bh & 3; kind = 1; rowbase = MP + b * 4; T = 4; cb = 0; ce = 1; sin = p.state_ret + (size_t)bh * 8192; sout = p.out + O_RETS + (size_t)bh * 8192; }
    else kind = 2;
    if (kind == 0) {
      if (item < 256) __builtin_amdgcn_s_setprio(3);
      const int nrep = ((DUP6 == 1 && item < 256) || (DUP6 == 2 && item >= 384)) ? 2 : 1;
#pragma unroll 1
      for (int rep = 0; rep < nrep; ++rep) rwkv_item(p, rowbase, T, h, rb, shp, sin, sout, lds);
      if (item < 256) __builtin_amdgcn_s_setprio(0);
    }
    else if (kind == 1) ret_item(p, rowbase, T, h, sin, sout, lds, cb, ce, seg, loc, flg);
    else {
      const int tt = item - 384 - NQ_LIGHT, job = tt / 704, t = tt - job * 704;
      const float* src = job == 0 ? p.ffn2_wg : (job == 1 ? p.ffn2_wu : p.ffn2_wd);
      transpose_tile(src, job == 2 ? 2816 : 1024, job == 2 ? 1024 : 2816, (bf16_t*)(p.ws + (job == 2 ? OFF_W1D : OFF_W1GU)), job == 2 ? 1 : 2, job == 1 ? 1 : 0, t, lds);
    }
  }
}

__device__ __forceinline__ void phase_post(const Params& p, unsigned char* lds) {
  const int tid = threadIdx.x, h = (tid >> 4) & 7, c4 = tid & 15, ch = h * 64 + c4 * 4;
  bf16_t* Y = (bf16_t*)(p.ws + OFF_Y); const bf16_t* PR = (const bf16_t*)(p.ws + OFF_PR);
  const bf16_t* GG = (const bf16_t*)((unsigned char*)p.out + OO_GG); const float* RHO = (const float*)((unsigned char*)p.out + OO_RHO);
  float muv[4], lg[4], lb[4];
#pragma unroll
  for (int e = 0; e < 4; ++e) { muv[e] = p.mu[1024 + ch + e]; lg[e] = p.lnx_g[ch + e]; lb[e] = p.lnx_b[ch + e]; }
  for (int pr = blockIdx.x; pr < M_TOK / 2; pr += gridDim.x) {
    const int row = pr * 2 + (tid >> 7);
    float y[4], cv[4], qv[4], g[4];
    unpk4(*(const uint2*)(Y + (size_t)row * 512 + ch), y);
    unpk4(*(const uint2*)(PR + (size_t)row * 1792 + 1024 + ch), cv);
    unpk4(*(const uint2*)(GG + (size_t)row * 512 + ch), g);
    bool first; const float* sprev = nullptr;
    if (row < MP) first = (row % TP) == 0; else { const int r2 = row - MP; first = (r2 & 3) == 0; sprev = p.state_shift + (size_t)(r2 >> 2) * 1792 + 1024 + ch; }
    if (!first) unpk4(*(const uint2*)(PR + (size_t)(row - 1) * 1792 + 1024 + ch), qv);
    else {
#pragma unroll
      for (int e = 0; e < 4; ++e) qv[e] = sprev ? sprev[e] : 0.f;
    }
    const float rho = RHO[(size_t)row * 8 + h];
    float s = y[0] + y[1] + y[2] + y[3]; s = rowsum16(s);
    const float mean = s * (1.f / 64.f);
    float d[4], q = 0.f;
#pragma unroll
    for (int e = 0; e < 4; ++e) { d[e] = y[e] - mean; q += d[e] * d[e]; }
    q = rowsum16(q);
    const float rstd = rsqrtf(q * (1.f / 64.f) + 64e-5f);
    float o[4];
#pragma unroll
    for (int e = 0; e < 4; ++e) { const float v = cv[e] + (qv[e] - cv[e]) * muv[e]; o[e] = (d[e] * rstd * lg[e] + lb[e] + rho * v) * g[e]; }
    *(uint2*)(Y + (size_t)row * 512 + ch) = pk4(o[0], o[1], o[2], o[3]);
  }
}

__device__ __forceinline__ void phase_merge(const Params& p, unsigned char* lds) {
  const bf16_t* OR = (const bf16_t*)(p.ws + OFF_GR); const bf16_t* OW = (const bf16_t*)(p.ws + OFF_Y);
  const bf16_t* WR = (const bf16_t*)(p.ws + OFF_WR); const bf16_t* WWp = (const bf16_t*)(p.ws + OFF_WW);
  const bf16_t* GA = (const bf16_t*)((unsigned char*)p.out + OO_GA); const bf16_t* GB = (const bf16_t*)(p.ws + OFF_GB);
  bf16_t* MG = (bf16_t*)(p.ws + OFF_MG);
  const int nM = NMT5, nN = 8;
  for (int L = blockIdx.x; L < nM * nN; L += gridDim.x) {
    int tm, tn; tile_coords(L, nM, nN, tm, tn);
    f32x4 acc[5][4]; ZERO_ACC5(acc);
    gemm_tile_dma<5>(OR, 512, WR, 512, 512, tm * 160, tn * 128, acc, lds);
    EPI_VARS5;
#pragma unroll
    for (int mi = 0; mi < 5; ++mi) {
      const int row = rbase + mi * 16;
      if (row < M_TOK) {
#pragma unroll
        for (int ni = 0; ni < 4; ++ni) { float g[4]; unpk4(*(const uint2*)(GA + (size_t)row * 1024 + cbase + ni * 16), g);
          *(uint2*)(MG + (size_t)row * 1024 + cbase + ni * 16) = pk4(acc[mi][ni][0] * g[0], acc[mi][ni][1] * g[1], acc[mi][ni][2] * g[2], acc[mi][ni][3] * g[3]); }
      }
    }
    ZERO_ACC5(acc);
    gemm_tile_dma<5>(OW, 512, WWp, 512, 512, tm * 160, tn * 128, acc, lds);
#pragma unroll
    for (int mi = 0; mi < 5; ++mi) {
      const int row = rbase + mi * 16;
      if (row < M_TOK) {
#pragma unroll
        for (int ni = 0; ni < 4; ++ni) { float g[4], t[4]; unpk4(*(const uint2*)(GB + (size_t)row * 1024 + cbase + ni * 16), g);
          uint2* mp = (uint2*)(MG + (size_t)row * 1024 + cbase + ni * 16); unpk4(*mp, t);
          *mp = pk4(t[0] + acc[mi][ni][0] * g[0], t[1] + acc[mi][ni][1] * g[1], t[2] + acc[mi][ni][2] * g[2], t[3] + acc[mi][ni][3] * g[3]); }
      }
    }
  }
}

__device__ __forceinline__ void phase_wout(const Params& p, unsigned char* lds) {
  const bf16_t* A = (const bf16_t*)(p.ws + OFF_MG); const bf16_t* W = (const bf16_t*)(p.ws + OFF_WO); bf16_t* H = (bf16_t*)(p.ws + OFF_H);
  const int nM = NMT5, nN = 8;
  for (int L = blockIdx.x; L < nM * nN; L += gridDim.x) {
    int tm, tn; tile_coords(L, nM, nN, tm, tn);
    f32x4 acc[5][4]; ZERO_ACC5(acc);
    gemm_tile_dma<5>(A, 1024, W, 1024, 1024, tm * 160, tn * 128, acc, lds);
    EPI_VARS5;
#pragma unroll
    for (int mi = 0; mi < 5; ++mi) {
      const int row = rbase + mi * 16;
      if (row < M_TOK) {
#pragma unroll
        for (int ni = 0; ni < 4; ++ni) { bf16_t* hp = H + (size_t)row * 1024 + cbase + ni * 16; float h[4]; unpk4(*(const uint2*)hp, h); const f32x4 a = acc[mi][ni];
          *(uint2*)hp = pk4(h[0] + a[0], h[1] + a[1], h[2] + a[2], h[3] + a[3]); }
      }
    }
  }
}

__global__ void __launch_bounds__(256, 2) mega(Params p) {
  extern __shared__ __attribute__((aligned(16))) unsigned char lds[];
  cg::grid_group grid = cg::this_grid();
  const int lo = p.phase_lo, hi = p.phase_hi;
  __shared__ uint4 xb_words;
  if (threadIdx.x == 0) xb_words = make_uint4(0u, 0u, 0u, 0u);
  __syncthreads();
  XcdBarrier xb = xcd_barrier_post((unsigned*)(p.ws + OFF_BAR), (volatile LAS unsigned*)&xb_words);
  if (hi > 1000) grid.sync();
  unsigned long long tp0 = 0;
#define PROBE_WAIT() do { if (blockIdx.x == 0) { const unsigned long long t1 = __builtin_amdgcn_s_memrealtime(); while (__builtin_amdgcn_s_memrealtime() < t1 + (t1 - tp0)) __builtin_amdgcn_s_sleep(8); } } while (0)
#define RUN_PHASE(k, call) if (PEN(k) && lo <= (k) && (k) < hi) { if ((k) > lo) xcd_barrier(xb); \
    if (PROBE_PHASE >= 0 && (k) == PROBE_PHASE + 1) PROBE_WAIT(); \
    if (PROBE_PHASE == (k)) tp0 = __builtin_amdgcn_s_memrealtime(); \
    call; if (((DUPMASK) >> (k)) & 1) { call; } }
  RUN_PHASE(0, phase0(p, lds))
  RUN_PHASE(1, phase_ffn_up(p, lds))
  RUN_PHASE(2, phase_ffn_down<true>(p, lds))
  RUN_PHASE(3, (rmsnorm_phase<1, 0>(p, p.mix_norm, (bf16_t*)(p.ws + OFF_A))))
  RUN_PHASE(4, phase_win(p, lds))
  RUN_PHASE(5, phase_lora_mfma(p, lds))
  RUN_PHASE(6, phase_scan(p, lds, ((volatile LAS unsigned*)&xb_words) + 2))
  RUN_PHASE(7, phase_post(p, lds))
  RUN_PHASE(8, phase_merge(p, lds))
  RUN_PHASE(9, phase_wout(p, lds))
  RUN_PHASE(10, (rmsnorm_phase<1, 0>(p, p.ffn2_norm, (bf16_t*)(p.ws + OFF_A))))
  RUN_PHASE(11, phase_ffn_up(p, lds))
  RUN_PHASE(12, phase_ffn_down<false>(p, lds))
  RUN_PHASE(13, (rmsnorm_phase<2, 1>(p, p.final_norm, nullptr)))
  if (PROBE_PHASE == 13) { xcd_barrier(xb); PROBE_WAIT(); }
}

extern "C" void kernel_launch(void* const* d_in, const int* in_sizes, int n_in, void* d_out, int out_size, void* d_ws, size_t ws_size, hipStream_t stream) {
  static int grid_blocks = 0;
  if (grid_blocks == 0) {
    if (n_in != 32 || ws_size < WS_NEED || out_size != 26458112) { fprintf(stderr, "kernel_launch: unexpected sizes n_in %d ws %zu out %d\n", n_in, ws_size, out_size); grid_blocks = -1; return; }
    int dev = 0, cus = 0, per_cu = 0;
    hipGetDevice(&dev);
    hipDeviceGetAttribute(&cus, hipDeviceAttributeMultiprocessorCount, dev);
    if (hipFuncSetAttribute((const void*)mega, hipFuncAttributeMaxDynamicSharedMemorySize, LDS_BYTES) != hipSuccess) { fprintf(stderr, "hipFuncSetAttribute failed\n"); grid_blocks = -1; return; }
    hipOccupancyMaxActiveBlocksPerMultiprocessor(&per_cu, (const void*)mega, NT, LDS_BYTES);
    if (per_cu < 1) { fprintf(stderr, "occupancy query returned %d\n", per_cu); grid_blocks = -1; return; }
    if (per_cu > 2) per_cu = 2;
    grid_blocks = cus * per_cu;
  }
  if (grid_blocks < 0) return;
  if (hipMemsetAsync((unsigned char*)d_ws + OFF_BAR, 0, 16384, stream) != hipSuccess) { fprintf(stderr, "memset failed\n"); return; }
  Params p{};
  const float** pp = (const float**)&p;
  for (int i = 0; i < 32; ++i) pp[i] = (const float*)d_in[i];
  p.out = (float*)d_out; p.ws = (unsigned char*)d_ws;
  for (int j = 0; j < 32; ++j) p.invf[j] = (float)pow(10000.0, -(double)j / 32.0);
  for (int h = 0; h < 4; ++h) p.lg2g[h] = (float)log2(1.0 - exp2(-5.0 - (double)h));
#if SINGLE_LAUNCH
  p.phase_lo = 0; p.phase_hi = NPHASE;
  void* args[] = {&p};
  hipError_t e = hipLaunchCooperativeKernel((const void*)mega, dim3(grid_blocks), dim3(NT), args, LDS_BYTES, stream);
  if (e != hipSuccess) fprintf(stderr, "cooperative launch failed: %s (grid %d)\n", hipGetErrorString(e), grid_blocks);
#else
  for (int ph = 0; ph < NPHASE; ++ph) {
    p.phase_lo = ph; p.phase_hi = ph + 1;
    hipLaunchKernelGGL(mega, dim3(grid_blocks), dim3(NT), LDS_BYTES, stream, p);
  }
#endif
}
```

```cpp
#include <hip/hip_runtime.h>
#include <hip/hip_cooperative_groups.h>
#include <cstdio>
#include <cmath>
namespace cg = cooperative_groups;

#ifndef PHMASK
#define PHMASK 0xffff
#endif
#define PEN(k) (((PHMASK) >> (k)) & 1)
#ifndef DUPMASK
#define DUPMASK 0
#endif
#ifndef DUP6
#define DUP6 0
#endif
#ifndef PROBE_PHASE
#define PROBE_PHASE (-1)
#endif
#ifndef SINGLE_LAUNCH
#define SINGLE_LAUNCH 1
#endif

typedef unsigned short bf16_t;
typedef short bf16x8 __attribute__((ext_vector_type(8)));
typedef float f32x4 __attribute__((ext_vector_type(4)));
typedef unsigned u32x4 __attribute__((ext_vector_type(4)));
typedef float f32x2 __attribute__((ext_vector_type(2)));

constexpr int NT = 256;
constexpr int M_TOK = 17024, MP = 16512, TP = 2064;
constexpr int PAST = 16384;
constexpr int LDS_BYTES = 73728;
constexpr int NPHASE = 14;

constexpr size_t S1024 = (size_t)M_TOK * 1024 * 2;
constexpr size_t S512 = S1024 / 2;
constexpr size_t OFF_W1GU = 0;
constexpr size_t OFF_W1D = OFF_W1GU + 11534336;
constexpr size_t OFF_WIN = OFF_W1D + 5767168;
constexpr size_t OFF_WR = OFF_WIN + 11010048;
constexpr size_t OFF_WW = OFF_WR + 1048576;
constexpr size_t OFF_WO = OFF_WW + 1048576;
constexpr size_t OFF_H = OFF_WO + 2097152;
constexpr size_t OFF_T = OFF_H + S1024;
constexpr size_t OFF_A = OFF_T;
constexpr size_t OFF_HF = OFF_T + S1024;
constexpr size_t OFF_QK = OFF_HF;
constexpr size_t OFF_V = OFF_QK + S512;
constexpr size_t OFF_GR = OFF_V + S512;
constexpr size_t OFF_PR = OFF_GR + S512;
constexpr size_t OFF_GB = OFF_PR + (size_t)M_TOK * 1792 * 2;
constexpr size_t OFF_Y = OFF_GB + S1024;
constexpr size_t OFF_END = OFF_Y + S512;
constexpr size_t OFF_MG = OFF_QK;
constexpr size_t OFF_BAR = OFF_END;
constexpr size_t OFF_W2T = OFF_BAR + 16384, OFF_A2T = OFF_W2T + 65536, OFF_G2T = OFF_A2T + 65536;
constexpr size_t WS_NEED = OFF_G2T + 131072;
constexpr size_t OFF_H3 = OFF_HF + (size_t)M_TOK * 2816 * 2;
constexpr size_t OFF_LD = OFF_A, OFF_AA = OFF_A + S512;
static_assert(OFF_H3 + (size_t)M_TOK * 1024 * 4 == OFF_END, "map");
constexpr size_t OO_GA = 0, OO_GG = S1024, OO_RHO = S1024 + S512;
constexpr size_t O_YP = 0, O_YS = 16777216, O_RETP = 17301504, O_WKVP = 17563648, O_SHP = 17825792, O_RETS = 17840128, O_WKVS = 22034432, O_SHS = 26228736;

struct Params {
  const float *x_prompt, *x_sample, *state_ret, *state_wkv, *state_shift, *meta;
  const float *ffn1_norm, *ffn1_wg, *ffn1_wu, *ffn1_wd, *mix_norm, *w_in, *ret_gn_g, *mu, *w0, *w2, *a0, *a2, *g2, *k_k, *k_a, *r_k, *lnx_g, *lnx_b;
  const float *w_out_ret, *w_out_rwkv, *w_out, *ffn2_norm, *ffn2_wg, *ffn2_wu, *ffn2_wd, *final_norm;
  float* out;
  unsigned char* ws;
  float invf[32];
  float lg2g[4];
  int phase_lo, phase_hi;
};


#define XB_TMO      128
#define XB_XCNT(j)  (256  + 64 * (j))
#define XB_XSUB(j)  (1280 + 64 * (j))
#define XB_XGEN(j)  (2304 + 64 * (j))
#define XB_TOP      3328
#define XB_TOPGEN   3392
#define XCD_BAR_WORDS 3456
#define XB_SPIN_CAP (1u << 18)
#define LAS __attribute__((address_space(3)))
__device__ __forceinline__ unsigned xb_ld(unsigned* p)              { return __hip_atomic_load(p, __ATOMIC_RELAXED, __HIP_MEMORY_SCOPE_AGENT); }
__device__ __forceinline__ unsigned xb_add(unsigned* p, unsigned v) { return __hip_atomic_fetch_add(p, v, __ATOMIC_RELAXED, __HIP_MEMORY_SCOPE_AGENT); }
__device__ __forceinline__ unsigned xb_xcc_id() { return (unsigned)__builtin_amdgcn_s_getreg((3 << 11) | 20) & 0xFu; }
#define XB_SPIN(cond, bar) do { unsigned _sp = 0; while (cond) { __builtin_amdgcn_s_sleep(1); \
    if ((++_sp & 255u) == 0u) { if (xb_ld(&(bar)[XB_TMO])) break; if (_sp > XB_SPIN_CAP) { atomicAdd(&(bar)[XB_TMO], 1u); break; } } } } while (0)
struct XcdBarrier { unsigned* bar; unsigned x; volatile LAS unsigned* st; };
__device__ __forceinline__ XcdBarrier xcd_barrier_post(unsigned* bar, volatile LAS unsigned* st) {
    XcdBarrier b; b.bar = bar; b.x = xb_xcc_id(); b.st = st;
    if (threadIdx.x == 0) (void)xb_add(&bar[XB_XCNT(b.x)], 1u);
    return b;
}
__device__ __forceinline__ void xcd_barrier_complete(unsigned* bar, unsigned x, unsigned& nloc, unsigned& nx) {
    const unsigned G = gridDim.x * gridDim.y * gridDim.z;
    unsigned sum, cnt, mine, sp = 0u;
    for (;;) {
        sum = 0u; cnt = 0u; mine = 0u;
#pragma unroll
        for (unsigned j = 0; j < 16; ++j) { const unsigned c = xb_ld(&bar[XB_XCNT(j)]); sum += c; cnt += (c > 0u) ? 1u : 0u; mine = (j == x) ? c : mine; }
        if (sum == G) break;
        __builtin_amdgcn_s_sleep(1);
        if ((++sp & 255u) == 0u) { if (xb_ld(&bar[XB_TMO])) break; if (sp > XB_SPIN_CAP) { atomicAdd(&bar[XB_TMO], 1u); break; } }
    }
    nloc = mine > 0u ? mine : 1u; nx = cnt > 0u ? cnt : 1u;
}
__device__ __forceinline__ void xcd_barrier(const XcdBarrier& b) {
    asm volatile("s_waitcnt vmcnt(0)" ::: "memory");
    __syncthreads();
    if (threadIdx.x == 0) {
        unsigned* bar = b.bar;
        __builtin_amdgcn_s_waitcnt(0);
        unsigned nloc = b.st[0], nx = b.st[1];
        if (nloc == 0u) { xcd_barrier_complete(bar, b.x, nloc, nx); b.st[0] = nloc; b.st[1] = nx; }
        const unsigned old = xb_add(&bar[XB_XSUB(b.x)], 1u);
        const unsigned gen = old / nloc;
        if (old + 1u == (gen + 1u) * nloc) {
            __builtin_amdgcn_fence(__ATOMIC_RELEASE, "agent");
            asm volatile("s_waitcnt vmcnt(0)" ::: "memory");
            const unsigned og = xb_add(&bar[XB_TOP], 1u);
            const unsigned tg = og / nx;
            if (og + 1u == (tg + 1u) * nx) xb_add(&bar[XB_TOPGEN], 1u);
            else XB_SPIN(xb_ld(&bar[XB_TOPGEN]) == tg, bar);
            __builtin_amdgcn_fence(__ATOMIC_ACQUIRE, "agent");
            xb_add(&bar[XB_XGEN(b.x)], 1u);
            asm volatile("s_waitcnt vmcnt(0)" ::: "memory");
        } else {
            XB_SPIN(xb_ld(&bar[XB_XGEN(b.x)]) == gen, bar);
            __builtin_amdgcn_fence(__ATOMIC_ACQUIRE, "agent");
            asm volatile("s_waitcnt vmcnt(0)" ::: "memory");
        }
    }
    __syncthreads();
}

__device__ __forceinline__ float bf2f(unsigned h) { return __uint_as_float(h << 16); }
__device__ __forceinline__ unsigned f2bf(float f) { unsigned u = __float_as_uint(f); return (u + 0x7fffu + ((u >> 16) & 1u)) >> 16; }
__device__ __forceinline__ unsigned pk2(float a, float b) { return f2bf(a) | (f2bf(b) << 16); }
__device__ __forceinline__ uint2 pk4(float a, float b, float c, float d) { uint2 r; r.x = pk2(a, b); r.y = pk2(c, d); return r; }
__device__ __forceinline__ void unpk4(uint2 u, float (&o)[4]) { o[0] = __uint_as_float(u.x << 16); o[1] = __uint_as_float(u.x & 0xffff0000u); o[2] = __uint_as_float(u.y << 16); o[3] = __uint_as_float(u.y & 0xffff0000u); }
template <int CTRL> __device__ __forceinline__ float dppf(float x) { return __builtin_bit_cast(float, __builtin_amdgcn_update_dpp(0, __builtin_bit_cast(int, x), CTRL, 0xf, 0xf, true)); }
__device__ __forceinline__ float rowsum16(float x) { x += dppf<0xB1>(x); x += dppf<0x4E>(x); x += dppf<0x141>(x); x += dppf<0x140>(x); return x; }
__device__ __forceinline__ float wavesum(float x) {
#pragma unroll
  for (int o = 32; o >= 1; o >>= 1) x += __shfl_xor(x, o);
  return x;
}
__device__ __forceinline__ float sigmoidf(float x) { return 1.f / (1.f + __expf(-x)); }
__device__ __forceinline__ float siluf(float x) { return x / (1.f + __expf(-x)); }

__device__ __forceinline__ const float* x_row(const Params& p, int row) {
  if (row < MP) { const int b = row / TP, t = row - b * TP; return t < 16 ? p.meta + t * 1024 : p.x_prompt + (size_t)(b * 2048 + t - 16) * 1024; }
  return p.x_sample + (size_t)(row - MP) * 1024;
}

__device__ __forceinline__ void transpose_tile(const float* __restrict__ src, int K, int N, bf16_t* __restrict__ dst, int rs, int ro, int t, unsigned char* lds) {
  float* tile = (float*)lds;
  const int tid = threadIdx.x;
  const int tn = N / 64;
  const int k0 = (t / tn) * 64, n0 = (t % tn) * 64;
  __syncthreads();
  { const int n = tid & 63, kq = tid >> 6;
#pragma unroll
    for (int i = 0; i < 16; ++i) { const int k = kq + 4 * i; tile[k * 65 + n] = src[(size_t)(k0 + k) * N + n0 + n]; } }
  __syncthreads();
  { const int kp = tid & 31, nq = tid >> 5;
#pragma unroll
    for (int i = 0; i < 8; ++i) { const int n = nq + 8 * i; const float v0 = tile[(2 * kp) * 65 + n], v1 = tile[(2 * kp + 1) * 65 + n];
      *(unsigned*)(dst + (size_t)((n0 + n) * rs + ro) * K + k0 + 2 * kp) = pk2(v0, v1); } }
}
__device__ __forceinline__ void transpose_tiles(const float* __restrict__ src, int K, int N, bf16_t* __restrict__ dst, int rs, int ro, unsigned char* lds, int bi, int nb) {
  const int nt = (K / 64) * (N / 64);
#pragma unroll 1
  for (int t = bi; t < nt; t += nb) transpose_tile(src, K, N, dst, rs, ro, t, lds);
}

template <int SRC, int DST> __device__ __forceinline__ void rmsnorm_phase(const Params& p, const float* __restrict__ g, bf16_t* dstb) {
  const int lane = threadIdx.x & 63, wid = threadIdx.x >> 6;
  const bf16_t* H = (const bf16_t*)(p.ws + OFF_H);
  const float* H3 = (const float*)(p.ws + OFF_H3);
  for (int row = blockIdx.x * 4 + wid; row < M_TOK; row += gridDim.x * 4) {
    float v[16];
    const float* xr = SRC == 0 ? x_row(p, row) : nullptr;
#pragma unroll
    for (int i = 0; i < 4; ++i) {
      const int col = i * 256 + lane * 4;
      if (SRC == 0) { const float4 t = *(const float4*)(xr + col); v[4 * i] = t.x; v[4 * i + 1] = t.y; v[4 * i + 2] = t.z; v[4 * i + 3] = t.w; }
      else if (SRC == 1) { const uint2 u = *(const uint2*)(H + (size_t)row * 1024 + col); float o[4]; unpk4(u, o); v[4 * i] = o[0]; v[4 * i + 1] = o[1]; v[4 * i + 2] = o[2]; v[4 * i + 3] = o[3]; }
      else { const float4 t = *(const float4*)(H3 + (size_t)row * 1024 + col); v[4 * i] = t.x; v[4 * i + 1] = t.y; v[4 * i + 2] = t.z; v[4 * i + 3] = t.w; }
    }
    float ss = 0.f;
#pragma unroll
    for (int i = 0; i < 16; ++i) ss += v[i] * v[i];
    ss = wavesum(ss);
    const float rstd = rsqrtf(ss * (1.f / 1024.f) + 1e-6f);
    float* orow = nullptr;
    if (DST == 1) {
      if (row < MP) { const int b = row / TP, t = row - b * TP; if (t >= 16) orow = p.out + O_YP + (size_t)(b * 2048 + t - 16) * 1024; }
      else orow = p.out + O_YS + (size_t)(row - MP) * 1024;
    }
#pragma unroll
    for (int i = 0; i < 4; ++i) {
      const int col = i * 256 + lane * 4;
      const float4 gv = *(const float4*)(g + col);
      const float y0 = v[4 * i] * rstd * gv.x, y1 = v[4 * i + 1] * rstd * gv.y, y2 = v[4 * i + 2] * rstd * gv.z, y3 = v[4 * i + 3] * rstd * gv.w;
      if (DST == 0) *(uint2*)(dstb + (size_t)row * 1024 + col) = pk4(y0, y1, y2, y3);
      else if (orow) *(float4*)(orow + col) = make_float4(y0, y1, y2, y3);
    }
  }
}

#define RAW_BARRIER() do { asm volatile("s_waitcnt lgkmcnt(0)" ::: "memory"); __builtin_amdgcn_s_barrier(); asm volatile("" ::: "memory"); } while (0)
template <int MI> __device__ __forceinline__ void gemm_tile_dma(const bf16_t* __restrict__ A, int lda, const bf16_t* __restrict__ Bt, int ldb, int K, int m0, int n0, f32x4 (&acc)[MI][4], unsigned char* lds) {
  constexpr int BMT = 32 * MI, NA = 2 * MI, NAW = (NA + 3) / 4, STG = (BMT + 128) * 64;
  static_assert(3 * STG <= LDS_BYTES, "ring does not fit");
  const int tid = threadIdx.x, lane = tid & 63, wid = tid >> 6, wm = wid >> 1, wn = wid & 1, l15 = lane & 15, l4 = lane >> 4;
  const int nk = K >> 5;
  const int qd = (lane >> 4) & 3, cs = ((lane & 3) ^ (((qd << 1) ^ ((qd >> 1) * 3)) & 3)) * 8;
  const bf16_t* ag[NAW]; const bf16_t* bg[2];
#pragma unroll
  for (int i = 0; i < NAW; ++i) { int row = m0 + (wid + 4 * i) * 16 + (lane >> 2); row = row < M_TOK ? row : M_TOK - 1; ag[i] = A + (size_t)row * lda + cs; }
#pragma unroll
  for (int i = 0; i < 2; ++i) { const int row = n0 + (wid * 2 + i) * 16 + (lane >> 2); bg[i] = Bt + (size_t)row * ldb + cs; }
  auto issue = [&](int kt, int buf) {
    unsigned char* sb = lds + buf * STG + lane * 16;
#pragma unroll
    for (int i = 0; i < NAW; ++i) if (wid + 4 * i < NA) __builtin_amdgcn_global_load_lds((const unsigned*)(ag[i] + kt * 32), (LAS unsigned*)(sb + (wid + 4 * i) * 1024), 16, 0, 0);
#pragma unroll
    for (int i = 0; i < 2; ++i) __builtin_amdgcn_global_load_lds((const unsigned*)(bg[i] + kt * 32), (LAS unsigned*)(sb + BMT * 64 + (wid * 2 + i) * 1024), 16, 0, 0);
  };
  const int qr = (l15 >> 2) & 3, sw = ((l4 ^ ((qr << 1) ^ ((qr >> 1) * 3))) & 3) * 16;
  const int aofs = (wm * 16 * MI + l15) * 64 + sw, bofs = BMT * 64 + (wn * 64 + l15) * 64 + sw;
  const bool big = (NA % 4 == 0) || (wid < NA % 4);
  RAW_BARRIER();
  issue(0, 0);
  if (nk > 1) issue(1, 1);
  int bc = 0, bi = 2;
  for (int kt = 0; kt < nk; ++kt) {
    if (kt + 1 < nk) {
      if (MI == 8) asm volatile("s_waitcnt vmcnt(6)" ::: "memory");
      else if (big) asm volatile("s_waitcnt vmcnt(5)" ::: "memory");
      else asm volatile("s_waitcnt vmcnt(4)" ::: "memory");
    } else asm volatile("s_waitcnt vmcnt(0)" ::: "memory");
    RAW_BARRIER();
    if (kt + 2 < nk) issue(kt + 2, bi);
    const unsigned char* st = lds + bc * STG;
    bf16x8 af[MI], bfr[4];
#pragma unroll
    for (int i = 0; i < MI; ++i) af[i] = *(const bf16x8*)(st + aofs + i * 1024);
#pragma unroll
    for (int i = 0; i < 4; ++i) bfr[i] = *(const bf16x8*)(st + bofs + i * 1024);
#pragma unroll
    for (int mi = 0; mi < MI; ++mi)
#pragma unroll
      for (int ni = 0; ni < 4; ++ni) acc[mi][ni] = __builtin_amdgcn_mfma_f32_16x16x32_bf16(bfr[ni], af[mi], acc[mi][ni], 0, 0, 0);
    bc = bc == 2 ? 0 : bc + 1; bi = bi == 2 ? 0 : bi + 1;
  }
}

#ifndef GMT
#define GMT 4
#endif
__device__ __forceinline__ void tile_coords(int L, int nM, int nN, int& tm, int& tn) {
  const int nwg = nM * nN, q = nwg / 8, r = nwg % 8, xcd = L % 8, off = L / 8;
  const int wg = (xcd < r ? xcd * (q + 1) : r * (q + 1) + (xcd - r) * q) + off;
  const int nig = GMT * nN, gid = wg / nig, fm = gid * GMT, gsz = min(nM - fm, GMT);
  tm = fm + (wg % nig) % gsz; tn = (wg % nig) / gsz;
}

#define ZERO_ACC(a) _Pragma("unroll") for (int _i = 0; _i < 4; ++_i) _Pragma("unroll") for (int _j = 0; _j < 4; ++_j) a[_i][_j] = (f32x4){0.f, 0.f, 0.f, 0.f}
#define ZERO_ACC8(a) _Pragma("unroll") for (int _i = 0; _i < 8; ++_i) _Pragma("unroll") for (int _j = 0; _j < 4; ++_j) a[_i][_j] = (f32x4){0.f, 0.f, 0.f, 0.f}
#define EPI_VARS8 const int lane = threadIdx.x & 63, wid = threadIdx.x >> 6, wm = wid >> 1, wn = wid & 1; const int rbase = tm * 256 + wm * 128 + (lane & 15), cbase = tn * 128 + wn * 64 + (lane >> 4) * 4
#define NMT 67
#define NMT5 107
#define ZERO_ACC5(a) _Pragma("unroll") for (int _i = 0; _i < 5; ++_i) _Pragma("unroll") for (int _j = 0; _j < 4; ++_j) a[_i][_j] = (f32x4){0.f, 0.f, 0.f, 0.f}
#define EPI_VARS5 const int lane = threadIdx.x & 63, wid = threadIdx.x >> 6, wm = wid >> 1, wn = wid & 1; const int rbase = tm * 160 + wm * 80 + (lane & 15), cbase = tn * 128 + wn * 64 + (lane >> 4) * 4
#define EPI_VARS const int lane = threadIdx.x & 63, wid = threadIdx.x >> 6, wm = wid >> 1, wn = wid & 1; const int rbase = tm * 128 + wm * 64 + (lane & 15), cbase = tn * 128 + wn * 64 + (lane >> 4) * 4

__device__ __forceinline__ void transpose_jobs(const Params& p, int jlo, int jhi, unsigned char* lds, int bi, int nb) {
  unsigned char* ws = p.ws;
#pragma unroll 1
  for (int j = jlo; j < jhi; ++j) {
    const float* src; int K, N, rs = 1, ro = 0; size_t off;
    switch (j) {
      case 0: src = p.ffn1_wg; K = 1024; N = 2816; off = OFF_W1GU; rs = 2; break;
      case 1: src = p.ffn1_wu; K = 1024; N = 2816; off = OFF_W1GU; rs = 2; ro = 1; break;
      case 2: src = p.ffn1_wd; K = 2816; N = 1024; off = OFF_W1D; break;
      case 3: src = p.w_in; K = 1024; N = 5376; off = OFF_WIN; break;
      case 4: src = p.w_out_ret; K = 512; N = 1024; off = OFF_WR; break;
      case 5: src = p.w_out_rwkv; K = 512; N = 1024; off = OFF_WW; break;
      case 6: src = p.w_out; K = 1024; N = 1024; off = OFF_WO; break;
      case 7: src = p.ffn2_wg; K = 1024; N = 2816; off = OFF_W1GU; rs = 2; break;
      case 8: src = p.ffn2_wu; K = 1024; N = 2816; off = OFF_W1GU; rs = 2; ro = 1; break;
      case 9: src = p.ffn2_wd; K = 2816; N = 1024; off = OFF_W1D; break;
      case 10: src = p.w2; K = 64; N = 512; off = OFF_W2T; break;
      case 11: src = p.a2; K = 64; N = 512; off = OFF_A2T; break;
      default: src = p.g2; K = 128; N = 512; off = OFF_G2T; break;
    }
    transpose_tiles(src, K, N, (bf16_t*)(ws + off), rs, ro, lds, bi, nb);
  }
}
__device__ __forceinline__ void phase0(const Params& p, unsigned char* lds) {
  transpose_jobs(p, 0, 2, lds, blockIdx.x, gridDim.x);
  transpose_jobs(p, 10, 13, lds, blockIdx.x, gridDim.x);
  rmsnorm_phase<0, 0>(p, p.ffn1_norm, (bf16_t*)(p.ws + OFF_A));
}

template <bool TAILFILL> __device__ __forceinline__ void phase_ffn_up(const Params& p, unsigned char* lds) {
  const bf16_t* A = (const bf16_t*)(p.ws + OFF_A); const bf16_t* W = (const bf16_t*)(p.ws + OFF_W1GU); bf16_t* HF = (bf16_t*)(p.ws + OFF_HF);
  const int nM = NMT, nN = 5632 / 128;
  for (int L = blockIdx.x; L < nM * nN; L += gridDim.x) {
    int tm, tn; tile_coords(L, nM, nN, tm, tn);
    f32x4 acc[8][4]; ZERO_ACC8(acc);
    gemm_tile_dma<8>(A, 1024, W, 1024, 1024, tm * 256, tn * 128, acc, lds);
    EPI_VARS8;
#pragma unroll
    for (int mi = 0; mi < 8; ++mi) {
      const int row = rbase + mi * 16;
      if (row < M_TOK) {
#pragma unroll
        for (int ni = 0; ni < 4; ++ni) {
          const int c = (cbase + ni * 16) >> 1; const f32x4 a = acc[mi][ni];
          *(unsigned*)(HF + (size_t)row * 2816 + c) = pk2(siluf(a[0]) * a[1], siluf(a[2]) * a[3]);
        }
      }
    }
  }
  if (TAILFILL) {
    const int G = gridDim.x, rem = (nM * nN) % G;
    int bi = blockIdx.x, nb = G;
    if (rem > 0 && G - rem >= 32) { bi = (int)blockIdx.x - rem; nb = G - rem; }
    if (bi >= 0) transpose_jobs(p, 2, 7, lds, bi, nb);
  }
}

template <bool FIRST> __device__ __forceinline__ void phase_ffn_down(const Params& p, unsigned char* lds) {
  const bf16_t* A = (const bf16_t*)(p.ws + OFF_HF); const bf16_t* W = (const bf16_t*)(p.ws + OFF_W1D);
  bf16_t* H = (bf16_t*)(p.ws + OFF_H); float* H3 = (float*)(p.ws + OFF_H3);
  const int nM = NMT5, nN = 8;
  for (int L = blockIdx.x; L < nM * nN; L += gridDim.x) {
    int tm, tn; tile_coords(L, nM, nN, tm, tn);
    f32x4 acc[5][4]; ZERO_ACC5(acc);
    gemm_tile_dma<5>(A, 2816, W, 2816, 2816, tm * 160, tn * 128, acc, lds);
    EPI_VARS5;
#pragma unroll
    for (int mi = 0; mi < 5; ++mi) {
      const int row = rbase + mi * 16;
      if (row < M_TOK) {
        const float* xr = FIRST ? x_row(p, row) : nullptr;
#pragma unroll
        for (int ni = 0; ni < 4; ++ni) {
          const int col = cbase + ni * 16; const f32x4 a = acc[mi][ni];
          if (FIRST) { const float4 xv = *(const float4*)(xr + col);
            *(uint2*)(H + (size_t)row * 1024 + col) = pk4(xv.x + 0.5f * a[0], xv.y + 0.5f * a[1], xv.z + 0.5f * a[2], xv.w + 0.5f * a[3]); }
          else { float h[4]; unpk4(*(const uint2*)(H + (size_t)row * 1024 + col), h);
            *(float4*)(H3 + (size_t)row * 1024 + col) = make_float4(h[0] + 0.5f * a[0], h[1] + 0.5f * a[1], h[2] + 0.5f * a[2], h[3] + 0.5f * a[3]); }
        }
      }
    }
  }
}

__device__ __forceinline__ void rope_cs(float ang, float& c, float& s) {
  double rev = (double)ang * 0.15915494309189535; rev -= rint(rev); const float fr = (float)rev;
  s = __builtin_amdgcn_sinf(fr); c = __builtin_amdgcn_cosf(fr);
}
__device__ __forceinline__ void phase_win(const Params& p, unsigned char* lds) {
  const bf16_t* A = (const bf16_t*)(p.ws + OFF_A); const bf16_t* W = (const bf16_t*)(p.ws + OFF_WIN);
  bf16_t* QK = (bf16_t*)(p.ws + OFF_QK); bf16_t* V = (bf16_t*)(p.ws + OFF_V); bf16_t* GR = (bf16_t*)(p.ws + OFF_GR); bf16_t* PR = (bf16_t*)(p.ws + OFF_PR);
  bf16_t* GB = (bf16_t*)(p.ws + OFF_GB); bf16_t* GA = (bf16_t*)((unsigned char*)p.out + OO_GA);
  const int nM = NMT, nN = 5376 / 128;
  for (int L = blockIdx.x; L < nM * nN; L += gridDim.x) {
    int tm, tn; tile_coords(L, nM, nN, tm, tn);
    f32x4 acc[8][4]; ZERO_ACC8(acc);
    gemm_tile_dma<8>(A, 1024, W, 1024, 1024, tm * 256, tn * 128, acc, lds);
    EPI_VARS8;
    const int n0 = tn * 128;
    if (n0 < 512) {
      const float sc = n0 >= 256 ? 0.125f : 1.0f;
      const int hb = n0 + wn * 64;
#pragma unroll
      for (int mi = 0; mi < 8; ++mi) {
        const int row = rbase + mi * 16;
        if (row >= M_TOK) continue;
        const float pos = row < MP ? (float)(row % TP) : (float)(PAST + ((row - MP) & 3));
#pragma unroll
        for (int ni = 0; ni < 2; ++ni) {
          float o1[4], o2[4];
#pragma unroll
          for (int jj = 0; jj < 4; ++jj) {
            const int j = ni * 16 + (lane >> 4) * 4 + jj;
            float c, s; rope_cs(pos * p.invf[j], c, s);
            const float x1 = acc[mi][ni][jj], x2 = acc[mi][ni + 2][jj];
            o1[jj] = (x1 * c - x2 * s) * sc; o2[jj] = (x1 * s + x2 * c) * sc;
          }
          const int j0 = ni * 16 + (lane >> 4) * 4;
          *(uint2*)(QK + (size_t)row * 512 + hb + j0) = pk4(o1[0], o1[1], o1[2], o1[3]);
          *(uint2*)(QK + (size_t)row * 512 + hb + 32 + j0) = pk4(o2[0], o2[1], o2[2], o2[3]);
        }
      }
    } else {
#pragma unroll
      for (int mi = 0; mi < 8; ++mi) {
        const int row = rbase + mi * 16;
        if (row >= M_TOK) continue;
        float* sh = nullptr;
        if (row < MP) { const int b = row / TP; if (row - b * TP == TP - 1) sh = p.out + O_SHP + (size_t)b * 1792; }
        else { const int r2 = row - MP; if ((r2 & 3) == 3) sh = p.out + O_SHS + (size_t)(r2 >> 2) * 1792; }
#pragma unroll
        for (int ni = 0; ni < 4; ++ni) {
          const int col = cbase + ni * 16; const f32x4 a = acc[mi][ni];
          if (n0 < 1024) *(uint2*)(V + (size_t)row * 512 + (col - 512)) = pk4(a[0], a[1], a[2], a[3]);
          else if (n0 < 1536) *(uint2*)(GR + (size_t)row * 512 + (col - 1024)) = pk4(siluf(a[0]), siluf(a[1]), siluf(a[2]), siluf(a[3]));
          else if (n0 < 3328) { *(uint2*)(PR + (size_t)row * 1792 + (col - 1536)) = pk4(a[0], a[1], a[2], a[3]);
            if (sh) *(float4*)(sh + (col - 1536)) = make_float4(a[0], a[1], a[2], a[3]); }
          else if (n0 < 4352) *(uint2*)(GA + (size_t)row * 1024 + (col - 3328)) = pk4(sigmoidf(a[0]), sigmoidf(a[1]), sigmoidf(a[2]), sigmoidf(a[3]));
          else *(uint2*)(GB + (size_t)row * 1024 + (col - 4352)) = pk4(sigmoidf(a[0]), sigmoidf(a[1]), sigmoidf(a[2]), sigmoidf(a[3]));
        }
      }
    }
  }
}

__device__ __forceinline__ void phase_lora(const Params& p, unsigned char* lds) {
  float* sS = (float*)lds;
  const int tid = threadIdx.x;
  const bf16_t* PR = (const bf16_t*)(p.ws + OFF_PR);
  bf16_t* LD = (bf16_t*)(p.ws + OFF_LD); bf16_t* AA = (bf16_t*)(p.ws + OFF_AA); bf16_t* GG = (bf16_t*)((unsigned char*)p.out + OO_GG);
  const float mu_j = p.mu[1536 + tid];
  for (int tile = blockIdx.x; tile < M_TOK / 16; tile += gridDim.x) {
    const int row0 = tile * 16;
    __syncthreads();
#pragma unroll 4
    for (int tt = 0; tt < 16; ++tt) {
      const int row = row0 + tt;
      const float pc = bf2f(PR[(size_t)row * 1792 + 1536 + tid]);
      float pp;
      if (row < MP) { const int t = row % TP; pp = t == 0 ? 0.f : bf2f(PR[(size_t)(row - 1) * 1792 + 1536 + tid]); }
      else { const int r2 = row - MP; pp = (r2 & 3) == 0 ? p.state_shift[(size_t)(r2 >> 2) * 1792 + 1536 + tid] : bf2f(PR[(size_t)(row - 1) * 1792 + 1536 + tid]); }
      const float pm = pc + (pp - pc) * mu_j;
      sS[tt * 256 + tid] = tid < 64 ? tanhf(pm) : (tid < 128 ? pm : sigmoidf(pm));
    }
    __syncthreads();
#pragma unroll 1
    for (int which = 0; which < 3; ++which) {
      const float* Wm = which == 0 ? p.w2 : (which == 1 ? p.a2 : p.g2);
      const int jb = which == 0 ? 0 : (which == 1 ? 64 : 128), nj = which == 2 ? 128 : 64;
      float acc0[16], acc1[16];
#pragma unroll
      for (int tt = 0; tt < 16; ++tt) { acc0[tt] = 0.f; acc1[tt] = 0.f; }
      for (int j = 0; j < nj; j += 4) {
        float wa[4], wb[4];
#pragma unroll
        for (int e = 0; e < 4; ++e) { wa[e] = Wm[(size_t)(j + e) * 512 + tid]; wb[e] = Wm[(size_t)(j + e) * 512 + tid + 256]; }
#pragma unroll
        for (int tt = 0; tt < 16; ++tt) {
          const float4 s4 = *(const float4*)(sS + tt * 256 + jb + j);
          acc0[tt] += s4.x * wa[0] + s4.y * wa[1] + s4.z * wa[2] + s4.w * wa[3];
          acc1[tt] += s4.x * wb[0] + s4.y * wb[1] + s4.z * wb[2] + s4.w * wb[3];
        }
      }
      if (which == 0) {
        const float b0 = p.w0[tid], b1 = p.w0[tid + 256];
#pragma unroll
        for (int tt = 0; tt < 16; ++tt) {
          const float x0 = -(b0 + acc0[tt]), x1 = -(b1 + acc1[tt]);
          const float sp0 = fmaxf(x0, 0.f) + log1pf(expf(-fabsf(x0))), sp1 = fmaxf(x1, 0.f) + log1pf(expf(-fabsf(x1)));
          LD[(size_t)(row0 + tt) * 512 + tid] = (bf16_t)f2bf(-expf(-sp0 - 0.5f));
          LD[(size_t)(row0 + tt) * 512 + tid + 256] = (bf16_t)f2bf(-expf(-sp1 - 0.5f));
        }
      } else if (which == 1) {
        const float b0 = p.a0[tid], b1 = p.a0[tid + 256];
#pragma unroll
        for (int tt = 0; tt < 16; ++tt) {
          AA[(size_t)(row0 + tt) * 512 + tid] = (bf16_t)f2bf(sigmoidf(b0 + acc0[tt]));
          AA[(size_t)(row0 + tt) * 512 + tid + 256] = (bf16_t)f2bf(sigmoidf(b1 + acc1[tt]));
        }
      } else {
#pragma unroll
        for (int tt = 0; tt < 16; ++tt) {
          GG[(size_t)(row0 + tt) * 512 + tid] = (bf16_t)f2bf(acc0[tt]);
          GG[(size_t)(row0 + tt) * 512 + tid + 256] = (bf16_t)f2bf(acc1[tt]);
        }
      }
    }
  }
}


__device__ __forceinline__ void phase_lora_mfma(const Params& p, unsigned char* lds) {
  constexpr int LSTR = 272;
  unsigned char* sA = lds; unsigned char* sB = lds + 128 * LSTR;
  const bf16_t* PR = (const bf16_t*)(p.ws + OFF_PR);
  bf16_t* LD = (bf16_t*)(p.ws + OFF_LD); bf16_t* AA = (bf16_t*)(p.ws + OFF_AA); bf16_t* GG = (bf16_t*)((unsigned char*)p.out + OO_GG);
  for (int grp = blockIdx.x; grp < (M_TOK / 128) * 3; grp += gridDim.x) {
    int tid_o = threadIdx.x; asm volatile("" : "+v"(tid_o));
    const int tid = tid_o, lane = tid & 63, wid = tid >> 6, wm = wid >> 1, wn = wid & 1, l15 = lane & 15, l4 = lane >> 4;
    const int tm = grp / 3, which = grp - tm * 3;
    const int Kc = which == 2 ? 128 : 64, jb = which == 0 ? 0 : (which == 1 ? 64 : 128), cpr = Kc >> 3;
    const bf16_t* Wt = (const bf16_t*)(p.ws + (which == 0 ? OFF_W2T : (which == 1 ? OFF_A2T : OFF_G2T)));
    __syncthreads();
    for (int q = tid; q < 128 * cpr; q += NT) {
      const int r = q / cpr, ck = q - r * cpr, row = tm * 128 + r, col = 1536 + jb + ck * 8;
      const u32x4 cu = *(const u32x4*)(PR + (size_t)row * 1792 + col);
      float pc[8], pp[8];
#pragma unroll
      for (int e = 0; e < 4; ++e) { pc[2 * e] = __uint_as_float(cu[e] << 16); pc[2 * e + 1] = __uint_as_float(cu[e] & 0xffff0000u); }
      bool first; const float* sprev = nullptr;
      if (row < MP) first = (row % TP) == 0; else { const int r2 = row - MP; first = (r2 & 3) == 0; sprev = p.state_shift + (size_t)(r2 >> 2) * 1792 + col; }
      if (!first) { const u32x4 pu = *(const u32x4*)(PR + (size_t)(row - 1) * 1792 + col);
#pragma unroll
        for (int e = 0; e < 4; ++e) { pp[2 * e] = __uint_as_float(pu[e] << 16); pp[2 * e + 1] = __uint_as_float(pu[e] & 0xffff0000u); } }
      else {
#pragma unroll
        for (int e = 0; e < 8; ++e) pp[e] = sprev ? sprev[e] : 0.f;
      }
      float sv[8];
#pragma unroll
      for (int e = 0; e < 8; ++e) {
        const float pm = pc[e] + (pp[e] - pc[e]) * p.mu[col + e];
        float t;
        if (which == 0) { const float ex = __expf(-2.f * fabsf(pm)); t = (1.f - ex) / (1.f + ex); t = pm < 0.f ? -t : t; }
        else if (which == 1) t = pm;
        else t = sigmoidf(pm);
        sv[e] = t;
      }
      u32x4 o; o[0] = pk2(sv[0], sv[1]); o[1] = pk2(sv[2], sv[3]); o[2] = pk2(sv[4], sv[5]); o[3] = pk2(sv[6], sv[7]);
      *(u32x4*)(sA + r * LSTR + ck * 16) = o;
    }
    for (int tn = 0; tn < 4; ++tn) {
      if (tn > 0) __syncthreads();
      for (int q = tid; q < 128 * cpr; q += NT) { const int r = q / cpr, ck = q - r * cpr; *(u32x4*)(sB + r * LSTR + ck * 16) = *(const u32x4*)(Wt + (size_t)(tn * 128 + r) * Kc + ck * 8); }
      __syncthreads();
      f32x4 acc[4][4]; ZERO_ACC(acc);
      for (int kk = 0; kk < (Kc >> 5); ++kk) {
        bf16x8 af[4], bfr[4];
#pragma unroll
        for (int i = 0; i < 4; ++i) { af[i] = *(const bf16x8*)(sA + (wm * 64 + i * 16 + l15) * LSTR + kk * 64 + l4 * 16); bfr[i] = *(const bf16x8*)(sB + (wn * 64 + i * 16 + l15) * LSTR + kk * 64 + l4 * 16); }
#pragma unroll
        for (int mi = 0; mi < 4; ++mi)
#pragma unroll
          for (int ni = 0; ni < 4; ++ni) acc[mi][ni] = __builtin_amdgcn_mfma_f32_16x16x32_bf16(bfr[ni], af[mi], acc[mi][ni], 0, 0, 0);
      }
#pragma unroll
      for (int ni = 0; ni < 4; ++ni) {
        const int col = tn * 128 + wn * 64 + ni * 16 + l4 * 4;
        float bias[4] = {0.f, 0.f, 0.f, 0.f};
        if (which == 0) { const float4 b4 = *(const float4*)(p.w0 + col); bias[0] = b4.x; bias[1] = b4.y; bias[2] = b4.z; bias[3] = b4.w; }
        else if (which == 1) { const float4 b4 = *(const float4*)(p.a0 + col); bias[0] = b4.x; bias[1] = b4.y; bias[2] = b4.z; bias[3] = b4.w; }
#pragma unroll
        for (int mi = 0; mi < 4; ++mi) {
          const int row = tm * 128 + wm * 64 + mi * 16 + l15;
          float o[4];
#pragma unroll
          for (int jj = 0; jj < 4; ++jj) {
            const float a = acc[mi][ni][jj] + bias[jj];
            if (which == 0) o[jj] = -0.87503879f * sigmoidf(a);
            else if (which == 1) o[jj] = sigmoidf(a);
            else o[jj] = a;
          }
          bf16_t* dst = which == 0 ? LD : (which == 1 ? AA : GG);
          *(uint2*)(dst + (size_t)row * 512 + col) = pk4(o[0], o[1], o[2], o[3]);
        }
      }
    }
  }
}

struct StageRegs { uint2 cr, ck, cv, qr, qk, qv, ld, aa; };

__device__ __forceinline__ void rwkv_item(const Params& p, int rowbase, int T, int h, int rb, const float* shift_prev, const float* S_in, float* S_out, unsigned char* lds) {
  float* stage = (float*)lds;
  float* ypart = (float*)(lds + 49152);
  int tid_f = threadIdx.x; asm volatile("" : "+v"(tid_f));
  const int tid = tid_f, lane = tid & 63, wid = tid >> 6;
  const int t_l = tid >> 4, c4 = tid & 15, ch = h * 64 + c4 * 4;
  const int kg = lane & 15, vloc = wid * 4 + (lane >> 4), vrow = rb * 16 + vloc;
  const bf16_t* PR = (const bf16_t*)(p.ws + OFF_PR); const bf16_t* LD = (const bf16_t*)(p.ws + OFF_LD); const bf16_t* AA = (const bf16_t*)(p.ws + OFF_AA);
  bf16_t* Y = (bf16_t*)(p.ws + OFF_Y); float* RHO = (float*)((unsigned char*)p.out + OO_RHO);
  float mur[4], muk[4], muv[4], kkc[4], kac[4], rkc[4];
#pragma unroll
  for (int e = 0; e < 4; ++e) { mur[e] = p.mu[ch + e]; muk[e] = p.mu[512 + ch + e]; muv[e] = p.mu[1024 + ch + e]; kkc[e] = p.k_k[ch + e]; kac[e] = p.k_a[ch + e]; rkc[e] = p.r_k[ch + e]; }
  f32x4 S;
  if (S_in) S = *(const f32x4*)(S_in + (size_t)vrow * 64 + kg * 4); else S = (f32x4){0.f, 0.f, 0.f, 0.f};
  f32x2 Sa = S.xy, Sb = S.zw;

  float rho_keep = 0.f; unsigned y_keep = 0u;
  auto load = [&](int t0, StageRegs& r) {
    int t = t0 + t_l; if (t > T - 1) t = T - 1;
    const bf16_t* cur = PR + (size_t)(rowbase + t) * 1792 + ch;
    r.cr = *(const uint2*)cur; r.ck = *(const uint2*)(cur + 512); r.cv = *(const uint2*)(cur + 1024);
    { const bf16_t* pv = t > 0 ? cur - 1792 : cur; r.qr = *(const uint2*)pv; r.qk = *(const uint2*)(pv + 512); r.qv = *(const uint2*)(pv + 1024); }
    r.ld = *(const uint2*)(LD + (size_t)(rowbase + t) * 512 + ch); r.aa = *(const uint2*)(AA + (size_t)(rowbase + t) * 512 + ch);
  };
  auto process = [&](int t0, const StageRegs& r, int buf, bool first) {
    float cr[4], ck[4], cv[4], qr[4], qk[4], qv[4], ld[4], aa[4];
    unpk4(r.cr, cr); unpk4(r.ck, ck); unpk4(r.cv, cv); unpk4(r.qr, qr); unpk4(r.qk, qk); unpk4(r.qv, qv); unpk4(r.ld, ld); unpk4(r.aa, aa);
    const int t = t0 + t_l;
    if (first && t == 0) {
#pragma unroll
      for (int e = 0; e < 4; ++e) { qr[e] = 0.f; qk[e] = 0.f; qv[e] = 0.f; }
    }
    if (first && t == 0 && shift_prev) {
#pragma unroll
      for (int e = 0; e < 4; ++e) { qr[e] = shift_prev[ch + e]; qk[e] = shift_prev[512 + ch + e]; qv[e] = shift_prev[1024 + ch + e]; }
    }
    float rr[4], k[4], v[4], kk[4], kp[4], bb[4], w[4];
    float ss = 0.f, rho = 0.f;
#pragma unroll
    for (int e = 0; e < 4; ++e) {
      rr[e] = cr[e] + (qr[e] - cr[e]) * mur[e]; k[e] = ck[e] + (qk[e] - ck[e]) * muk[e]; v[e] = cv[e] + (qv[e] - cv[e]) * muv[e];
      kk[e] = k[e] * kkc[e]; ss += kk[e] * kk[e];
      kp[e] = k[e] * (1.f + (aa[e] - 1.f) * kac[e]);
      rho += rr[e] * kp[e] * rkc[e];
      w[e] = __builtin_amdgcn_exp2f(ld[e]);
    }
    ss = rowsum16(ss); rho = rowsum16(rho);
    const float inv = rsqrtf(fmaxf(ss, 1e-24f));
#pragma unroll
    for (int e = 0; e < 4; ++e) { kk[e] *= inv; bb[e] = kk[e] * aa[e]; }
    float* sp = stage + (size_t)((buf * 16 + t_l) * 6) * 64 + c4 * 4;
    *(float4*)(sp) = make_float4(rr[0], rr[1], rr[2], rr[3]);
    *(float4*)(sp + 64) = make_float4(w[0], w[1], w[2], w[3]);
    *(float4*)(sp + 128) = make_float4(kp[0], kp[1], kp[2], kp[3]);
    *(float4*)(sp + 192) = make_float4(v[0], v[1], v[2], v[3]);
    *(float4*)(sp + 256) = make_float4(-kk[0], -kk[1], -kk[2], -kk[3]);
    *(float4*)(sp + 320) = make_float4(bb[0], bb[1], bb[2], bb[3]);
    rho_keep = rho;
    if (rb == 0 && c4 == 0 && t < T) RHO[(size_t)(rowbase + t) * 8 + h] = rho_keep;
  };

  const int nch = (T + 15) >> 4;
  StageRegs rgA, rgB;
  __syncthreads();
  load(0, rgA); process(0, rgA, 0, true);
  if (nch > 1) load(16, rgB);
  if (nch > 2) load(32, rgA);
  __syncthreads();
  auto chunk_body = [&](int c, StageRegs& rg) {
    const int buf = c & 1, t0 = c * 16;
    const int nsteps = min(16, T - t0);
    const float* st = stage + (size_t)(buf * 16) * 384;
    struct StepOps { f32x4 r[2], w[2], kp[2], nk[2], b[2]; float vv[2]; };
    auto loadg = [&](StepOps& g, int s0) {
#pragma unroll
      for (int u = 0; u < 2; ++u) {
        const float* sp = st + (s0 + u) * 384;
        g.r[u] = *(const f32x4*)(sp + kg * 4); g.w[u] = *(const f32x4*)(sp + 64 + kg * 4); g.kp[u] = *(const f32x4*)(sp + 128 + kg * 4);
        g.nk[u] = *(const f32x4*)(sp + 256 + kg * 4); g.b[u] = *(const f32x4*)(sp + 320 + kg * 4); g.vv[u] = sp[192 + vrow];
      }
    };
    auto compg = [&](const StepOps& g, int s0) {
      float yp[2];
#pragma unroll
      for (int u = 0; u < 2; ++u) {
        f32x2 pa = Sa * g.nk[u].xy; pa = Sb * g.nk[u].zw + pa;
        const float sa = rowsum16(pa.x + pa.y);
        const f32x2 sa2 = {sa, sa}, vv2 = {g.vv[u], g.vv[u]};
        const f32x2 Xa = sa2 * g.b[u].xy + vv2 * g.kp[u].xy, Xb = sa2 * g.b[u].zw + vv2 * g.kp[u].zw;
        Sa = Sa * g.w[u].xy + Xa; Sb = Sb * g.w[u].zw + Xb;
        f32x2 ya = Sa * g.r[u].xy; ya = Sb * g.r[u].zw + ya;
        yp[u] = ya.x + ya.y;
      }
#pragma unroll
      for (int u = 0; u < 2; ++u) ypart[((s0 + u) * 16 + vloc) * 16 + kg] = yp[u];
    };
    {
      StepOps ga, gb, gc;
      loadg(ga, 0); loadg(gb, 2);
      if (4 < nsteps) loadg(gc, 4);
      compg(ga, 0);
      if (6 < nsteps) loadg(ga, 6);
      compg(gb, 2);
      if (nsteps > 4) {
        loadg(gb, 8);  compg(gc, 4);
        loadg(gc, 10); compg(ga, 6);
        loadg(ga, 12); compg(gb, 8);
        loadg(gb, 14); compg(gc, 10);
        compg(ga, 12);
        compg(gb, 14);
      }
    }
    asm volatile("" :: "v"(y_keep), "v"(rho_keep));
    if (c + 1 < nch) process(t0 + 16, rg, buf ^ 1, false);
    if (c + 3 < nch) load(t0 + 48, rg);
    RAW_BARRIER();
    if (t_l < nsteps) {
      const f32x4* yp = (const f32x4*)(ypart + (t_l * 16 + c4) * 16);
      const f32x4 y0 = yp[0], y1 = yp[1], y2 = yp[2], y3 = yp[3];
      const float y = ((y0[0] + y0[1]) + (y0[2] + y0[3])) + ((y1[0] + y1[1]) + (y1[2] + y1[3])) + ((y2[0] + y2[1]) + (y2[2] + y2[3])) + ((y3[0] + y3[1]) + (y3[2] + y3[3]));
      y_keep = f2bf(y);
      Y[(size_t)(rowbase + t0 + t_l) * 512 + h * 64 + rb * 16 + c4] = (bf16_t)y_keep;
    }
    RAW_BARRIER();
  };
  for (int c = 0; c < nch; c += 2) {
    chunk_body(c, rgB);
    if (c + 1 < nch) chunk_body(c + 1, rgA);
  }
  S.xy = Sa; S.zw = Sb;
  *(f32x4*)(S_out + (size_t)vrow * 64 + kg * 4) = S;
}

__device__ __forceinline__ void ret_item(const Params& p, int rowbase, int T, int h, const float* S_in, float* S_out, unsigned char* lds, int cb, int ce, int seg, float* loc, unsigned* flags) {
  unsigned char* sQ = lds; unsigned char* sK = lds + 9216; unsigned char* sKdT = lds + 18432; unsigned char* sVT = lds + 27648; unsigned char* sP = lds + 46080; unsigned char* sST = lds + 55296;
  float* part = (float*)sK;
  int tid_f = threadIdx.x; asm volatile("" : "+v"(tid_f));
  const int tid = tid_f, lane = tid & 63, w = tid >> 6, l15 = lane & 15, l4 = lane >> 4;
  const bf16_t* QK = (const bf16_t*)(p.ws + OFF_QK); const bf16_t* V = (const bf16_t*)(p.ws + OFF_V); bf16_t* GR = (bf16_t*)(p.ws + OFF_GR);
  const float lg2 = p.lg2g[h];
  f32x4 ST[2][4];
#pragma unroll
  for (int vt = 0; vt < 2; ++vt)
#pragma unroll
    for (int dt = 0; dt < 4; ++dt) ST[vt][dt] = (f32x4){0.f, 0.f, 0.f, 0.f};
  u32x4 pq[2], pk[2], pv[4];
  auto prefetch = [&](int t0n, int tidp) {
    const int Ln = min(64, T - t0n);
#pragma unroll
    for (int i = 0; i < 2; ++i) {
      const int q_ = tidp + i * 256, j = q_ & 63, ck = q_ >> 6;
      pq[i] = (u32x4){0u, 0u, 0u, 0u}; pk[i] = pq[i];
      if (j < Ln) { const bf16_t* src = QK + (size_t)(rowbase + t0n + j) * 512 + h * 64 + ck * 8; pq[i] = *(const u32x4*)src; pk[i] = *(const u32x4*)(src + 256); }
    }
#pragma unroll
    for (int i = 0; i < 4; ++i) {
      const int q_ = tidp + i * 256, j = q_ & 63, cv = q_ >> 6;
      pv[i] = (u32x4){0u, 0u, 0u, 0u};
      if (j < Ln) pv[i] = *(const u32x4*)(V + (size_t)(rowbase + t0n + j) * 512 + h * 128 + cv * 8);
    }
  };
  if (seg >= 0 && seg < 3) {
    prefetch(cb * 64, threadIdx.x);
    for (int c = cb; c < ce; ++c) {
      const int t0 = c * 64, Lc = min(64, T - t0);
      int tid_o = threadIdx.x; asm volatile("" : "+v"(tid_o));
      const int tid = tid_o, lane = tid & 63, w = tid >> 6, l15 = lane & 15, l4 = lane >> 4;
      __syncthreads();
#pragma unroll
      for (int i = 0; i < 2; ++i) {
        const int q_ = tid + i * 256, j = q_ & 63, ck = q_ >> 6;
        const u32x4 kv = pk[i];
        const float kd = __builtin_amdgcn_exp2f((float)(Lc - 1 - j) * lg2);
#pragma unroll
        for (int e = 0; e < 4; ++e) {
          *(bf16_t*)(sKdT + (ck * 8 + 2 * e) * 144 + j * 2) = (bf16_t)f2bf(__uint_as_float(kv[e] << 16) * kd);
          *(bf16_t*)(sKdT + (ck * 8 + 2 * e + 1) * 144 + j * 2) = (bf16_t)f2bf(__uint_as_float(kv[e] & 0xffff0000u) * kd);
        }
      }
#pragma unroll
      for (int i = 0; i < 4; ++i) {
        const int q_ = tid + i * 256, j = q_ & 63, cv = q_ >> 6;
        const u32x4 vv = pv[i];
#pragma unroll
        for (int e = 0; e < 4; ++e) {
          *(bf16_t*)(sVT + (cv * 8 + 2 * e) * 144 + j * 2) = (bf16_t)(vv[e] & 0xffffu);
          *(bf16_t*)(sVT + (cv * 8 + 2 * e + 1) * 144 + j * 2) = (bf16_t)(vv[e] >> 16);
        }
      }
      if (c + 1 < ce) prefetch(t0 + 64, tid);
      __syncthreads();
      const float gl = __builtin_amdgcn_exp2f((float)Lc * lg2);
      bf16x8 bV[2][2];
#pragma unroll
      for (int vt = 0; vt < 2; ++vt)
#pragma unroll
        for (int kk = 0; kk < 2; ++kk) bV[vt][kk] = *(const bf16x8*)(sVT + (32 * w + vt * 16 + l15) * 144 + kk * 64 + l4 * 16);
#pragma unroll
      for (int dt = 0; dt < 4; ++dt) {
        bf16x8 bK[2];
#pragma unroll
        for (int kk = 0; kk < 2; ++kk) bK[kk] = *(const bf16x8*)(sKdT + (dt * 16 + l15) * 144 + kk * 64 + l4 * 16);
#pragma unroll
        for (int vt = 0; vt < 2; ++vt) {
          f32x4 a = ST[vt][dt] * gl;
#pragma unroll
          for (int kk = 0; kk < 2; ++kk) a = __builtin_amdgcn_mfma_f32_16x16x32_bf16(bV[vt][kk], bK[kk], a, 0, 0, 0);
          ST[vt][dt] = a;
        }
      }
    }
    float* lp = loc + (size_t)seg * 8192;
#pragma unroll
    for (int vt = 0; vt < 2; ++vt)
#pragma unroll
      for (int dt = 0; dt < 4; ++dt)
        *(float4*)(lp + (size_t)(dt * 16 + l15) * 128 + 32 * w + vt * 16 + l4 * 4) = make_float4(ST[vt][dt][0], ST[vt][dt][1], ST[vt][dt][2], ST[vt][dt][3]);
    __threadfence();
    __syncthreads();
    if (threadIdx.x == 0) { asm volatile("s_waitcnt vmcnt(0)" ::: "memory"); __hip_atomic_store(flags + seg, 1u, __ATOMIC_RELAXED, __HIP_MEMORY_SCOPE_AGENT); }
  }
#pragma unroll
  for (int vt = 0; vt < 2; ++vt)
#pragma unroll
    for (int dt = 0; dt < 4; ++dt) ST[vt][dt] = (f32x4){0.f, 0.f, 0.f, 0.f};
  if (seg > 0) {
    if (threadIdx.x == 0) {
      for (int s2 = 0; s2 < seg; ++s2) { unsigned sp = 0; while (__hip_atomic_load(flags + s2, __ATOMIC_RELAXED, __HIP_MEMORY_SCOPE_AGENT) == 0u) { __builtin_amdgcn_s_sleep(2); if (++sp > (1u << 22)) break; } }
      __builtin_amdgcn_fence(__ATOMIC_ACQUIRE, "agent");
      asm volatile("s_waitcnt vmcnt(0)" ::: "memory");
    }
    __syncthreads();
    for (int s2 = 0; s2 < seg; ++s2) {
      const float dk = __builtin_amdgcn_exp2f((float)(64 * (cb - 8 * (s2 + 1))) * lg2);
      const float* lp = loc + (size_t)s2 * 8192;
#pragma unroll
      for (int vt = 0; vt < 2; ++vt)
#pragma unroll
        for (int dt = 0; dt < 4; ++dt) {
          const float4 t4 = *(const float4*)(lp + (size_t)(dt * 16 + l15) * 128 + 32 * w + vt * 16 + l4 * 4);
          ST[vt][dt][0] += dk * t4.x; ST[vt][dt][1] += dk * t4.y; ST[vt][dt][2] += dk * t4.z; ST[vt][dt][3] += dk * t4.w;
        }
    }
  } else if (S_in) {
#pragma unroll
    for (int vt = 0; vt < 2; ++vt)
#pragma unroll
      for (int dt = 0; dt < 4; ++dt) {
        const float4 t4 = *(const float4*)(S_in + (size_t)(dt * 16 + l15) * 128 + 32 * w + vt * 16 + l4 * 4);
        ST[vt][dt][0] = t4.x; ST[vt][dt][1] = t4.y; ST[vt][dt][2] = t4.z; ST[vt][dt][3] = t4.w;
      }
  }
  __syncthreads();
#pragma unroll
  for (int vt = 0; vt < 2; ++vt)
#pragma unroll
    for (int dt = 0; dt < 4; ++dt)
#pragma unroll
      for (int jj = 0; jj < 4; ++jj) *(bf16_t*)(sST + (32 * w + vt * 16 + l4 * 4 + jj) * 144 + (dt * 16 + l15) * 2) = (bf16_t)f2bf(ST[vt][dt][jj]);
  prefetch(cb * 64, threadIdx.x);
  for (int c = cb; c < ce; ++c) {
    const int t0 = c * 64, Lc = min(64, T - t0);
    int tid_o = threadIdx.x; asm volatile("" : "+v"(tid_o));
    const int tid = tid_o, lane = tid & 63, w = tid >> 6, l15 = lane & 15, l4 = lane >> 4;
    __syncthreads();
#pragma unroll
    for (int i = 0; i < 2; ++i) {
      const int q_ = tid + i * 256, j = q_ & 63, ck = q_ >> 6;
      const u32x4 kv = pk[i];
      *(u32x4*)(sQ + j * 144 + ck * 16) = pq[i]; *(u32x4*)(sK + j * 144 + ck * 16) = kv;
      const float kd = __builtin_amdgcn_exp2f((float)(Lc - 1 - j) * lg2);
#pragma unroll
      for (int e = 0; e < 4; ++e) {
        *(bf16_t*)(sKdT + (ck * 8 + 2 * e) * 144 + j * 2) = (bf16_t)f2bf(__uint_as_float(kv[e] << 16) * kd);
        *(bf16_t*)(sKdT + (ck * 8 + 2 * e + 1) * 144 + j * 2) = (bf16_t)f2bf(__uint_as_float(kv[e] & 0xffff0000u) * kd);
      }
    }
#pragma unroll
    for (int i = 0; i < 4; ++i) {
      const int q_ = tid + i * 256, j = q_ & 63, cv = q_ >> 6;
      const u32x4 vv = pv[i];
#pragma unroll
      for (int e = 0; e < 4; ++e) {
        *(bf16_t*)(sVT + (cv * 8 + 2 * e) * 144 + j * 2) = (bf16_t)(vv[e] & 0xffffu);
        *(bf16_t*)(sVT + (cv * 8 + 2 * e + 1) * 144 + j * 2) = (bf16_t)(vv[e] >> 16);
      }
    }
    if (c + 1 < ce) prefetch(t0 + 64, tid);
    __syncthreads();
    {
      f32x4 sc[4];
#pragma unroll
      for (int jt = 0; jt < 4; ++jt) sc[jt] = (f32x4){0.f, 0.f, 0.f, 0.f};
#pragma unroll
      for (int kk = 0; kk < 2; ++kk) {
        const bf16x8 aq = *(const bf16x8*)(sQ + (16 * w + l15) * 144 + kk * 64 + l4 * 16);
#pragma unroll
        for (int jt = 0; jt < 4; ++jt) { const bf16x8 bk = *(const bf16x8*)(sK + (jt * 16 + l15) * 144 + kk * 64 + l4 * 16); sc[jt] = __builtin_amdgcn_mfma_f32_16x16x32_bf16(aq, bk, sc[jt], 0, 0, 0); }
      }
#pragma unroll
      for (int jt = 0; jt < 4; ++jt)
#pragma unroll
        for (int jj = 0; jj < 4; ++jj) {
          const int i = 16 * w + l4 * 4 + jj, j = jt * 16 + l15;
          const float pv = i >= j ? sc[jt][jj] * __builtin_amdgcn_exp2f((float)(i - j) * lg2) : 0.f;
          *(bf16_t*)(sP + i * 144 + j * 2) = (bf16_t)f2bf(pv);
        }
    }
    __syncthreads();
    f32x4 o[4][2];
    {
      bf16x8 bV[2][2], bS[2][2];
#pragma unroll
      for (int vt = 0; vt < 2; ++vt)
#pragma unroll
        for (int kk = 0; kk < 2; ++kk) {
          bV[vt][kk] = *(const bf16x8*)(sVT + (32 * w + vt * 16 + l15) * 144 + kk * 64 + l4 * 16);
          bS[vt][kk] = *(const bf16x8*)(sST + (32 * w + vt * 16 + l15) * 144 + kk * 64 + l4 * 16);
        }
#pragma unroll
      for (int it = 0; it < 4; ++it) {
        bf16x8 aP[2], aQ[2];
#pragma unroll
        for (int kk = 0; kk < 2; ++kk) { aP[kk] = *(const bf16x8*)(sP + (it * 16 + l15) * 144 + kk * 64 + l4 * 16); aQ[kk] = *(const bf16x8*)(sQ + (it * 16 + l15) * 144 + kk * 64 + l4 * 16); }
#pragma unroll
        for (int vt = 0; vt < 2; ++vt) {
          f32x4 a1 = (f32x4){0.f, 0.f, 0.f, 0.f}, a2 = (f32x4){0.f, 0.f, 0.f, 0.f};
#pragma unroll
          for (int kk = 0; kk < 2; ++kk) { a1 = __builtin_amdgcn_mfma_f32_16x16x32_bf16(aP[kk], bV[vt][kk], a1, 0, 0, 0); a2 = __builtin_amdgcn_mfma_f32_16x16x32_bf16(aQ[kk], bS[vt][kk], a2, 0, 0, 0); }
#pragma unroll
          for (int jj = 0; jj < 4; ++jj) { const int i = it * 16 + l4 * 4 + jj; o[it][vt][jj] = a1[jj] + __builtin_amdgcn_exp2f((float)(i + 1) * lg2) * a2[jj]; }
        }
      }
      const float gl = __builtin_amdgcn_exp2f((float)Lc * lg2);
#pragma unroll
      for (int dt = 0; dt < 4; ++dt) {
        bf16x8 bK[2];
#pragma unroll
        for (int kk = 0; kk < 2; ++kk) bK[kk] = *(const bf16x8*)(sKdT + (dt * 16 + l15) * 144 + kk * 64 + l4 * 16);
#pragma unroll
        for (int vt = 0; vt < 2; ++vt) {
          f32x4 a = ST[vt][dt] * gl;
#pragma unroll
          for (int kk = 0; kk < 2; ++kk) a = __builtin_amdgcn_mfma_f32_16x16x32_bf16(bV[vt][kk], bK[kk], a, 0, 0, 0);
          ST[vt][dt] = a;
#pragma unroll
          for (int jj = 0; jj < 4; ++jj) *(bf16_t*)(sST + (32 * w + vt * 16 + l4 * 4 + jj) * 144 + (dt * 16 + l15) * 2) = (bf16_t)f2bf(a[jj]);
        }
      }
    }
    unsigned short grv[4][4][2];
#pragma unroll
    for (int it = 0; it < 4; ++it)
#pragma unroll
      for (int jj = 0; jj < 4; ++jj) {
        const int i = it * 16 + l4 * 4 + jj;
#pragma unroll
        for (int vt = 0; vt < 2; ++vt) grv[it][jj][vt] = i < Lc ? GR[(size_t)(rowbase + t0 + i) * 512 + h * 128 + 32 * w + vt * 16 + l15] : (unsigned short)0;
      }
#pragma unroll
    for (int it = 0; it < 4; ++it)
#pragma unroll
      for (int jj = 0; jj < 4; ++jj) {
        float s1 = o[it][0][jj] + o[it][1][jj], s2 = o[it][0][jj] * o[it][0][jj] + o[it][1][jj] * o[it][1][jj];
        s1 = rowsum16(s1); s2 = rowsum16(s2);
        if (l15 == 0) { const int i = it * 16 + l4 * 4 + jj; part[(w * 64 + i) * 2] = s1; part[(w * 64 + i) * 2 + 1] = s2; }
      }
    const float gn[2] = {p.ret_gn_g[h * 128 + 32 * w + l15], p.ret_gn_g[h * 128 + 32 * w + 16 + l15]};
    __syncthreads();
#pragma unroll
    for (int it = 0; it < 4; ++it)
#pragma unroll
      for (int jj = 0; jj < 4; ++jj) {
        const int i = it * 16 + l4 * 4 + jj;
        float s1 = 0.f, s2 = 0.f;
#pragma unroll
        for (int ww = 0; ww < 4; ++ww) { s1 += part[(ww * 64 + i) * 2]; s2 += part[(ww * 64 + i) * 2 + 1]; }
        const float mean = s1 * (1.f / 128.f), var = fmaxf(s2 * (1.f / 128.f) - mean * mean, 0.f), rstd = rsqrtf(var + 1e-6f);
        if (i < Lc) {
#pragma unroll
          for (int vt = 0; vt < 2; ++vt) {
            const int v = 32 * w + vt * 16 + l15;
            bf16_t* gp = GR + (size_t)(rowbase + t0 + i) * 512 + h * 128 + v;
            *gp = (bf16_t)f2bf((o[it][vt][jj] - mean) * rstd * gn[vt] * bf2f(grv[it][jj][vt]));
          }
        }
      }
  }
  if (S_out)
#pragma unroll
  for (int vt = 0; vt < 2; ++vt)
#pragma unroll
    for (int dt = 0; dt < 4; ++dt)
      *(float4*)(S_out + (size_t)(dt * 16 + l15) * 128 + 32 * w + vt * 16 + l4 * 4) = make_float4(ST[vt][dt][0], ST[vt][dt][1], ST[vt][dt][2], ST[vt][dt][3]);
}

constexpr size_t OO_LOC = 56000000;
constexpr int NQ_LIGHT = 4608, NQ_TOTAL = 4608 + 3 * 704;
__device__ __forceinline__ void phase_scan(const Params& p, unsigned char* lds, volatile LAS unsigned* qslot) {
  const int G = gridDim.x;
  unsigned* flags_all = (unsigned*)(p.ws + OFF_BAR + 14336);
  unsigned* qctr = (unsigned*)(p.ws + OFF_BAR + 15360);
  float* loc_all = (float*)((unsigned char*)p.out + OO_LOC);
  int hid = blockIdx.x;
  bool heavy = true;
#pragma unroll 1
  while (true) {
    int item;
    if (heavy) { if (hid < 384) { item = hid; hid += G; } else { heavy = false; continue; } }
    else {
      __syncthreads();
      if (threadIdx.x == 0) *qslot = atomicAdd(qctr, 1u);
      __syncthreads();
      const int qi = (int)*qslot;
      if (qi >= NQ_TOTAL) break;
      item = 384 + qi;
    }
    int kind; int rowbase = 0, T = 0, h = 0, rb = 0, cb = 0, ce = 0, seg = -1; const float* shp = nullptr; const float* sin = nullptr; float* sout = nullptr; float* loc = nullptr; unsigned* flg = nullptr;
    if (item < 256) { const int j = item >> 3, seq = (item & 7) * 8 + (j >> 2), b = seq >> 3; rb = j & 3; h = seq & 7; kind = 0; rowbase = b * TP; T = TP; sout = p.out + O_WKVP + (size_t)seq * 4096; }
    else if (item < 384) { const int idx = item - 256, bh = idx >> 2, b = bh >> 2; seg = idx & 3; h = bh & 3; kind = 1; rowbase = b * TP; T = TP; cb = seg * 8; ce = seg == 3 ? 33 : cb + 8;
      sout = seg == 3 ? p.out + O_RETP + (size_t)bh * 8192 : nullptr; loc = loc_all + (size_t)bh * 3 * 8192; flg = flags_all + bh * 4; }
    else if (item < 384 + 4096) { const int it = item - 384, seq = it >> 2, b = seq >> 3; rb = it & 3; h = seq & 7; kind = 0; rowbase = MP + b * 4; T = 4;
      shp = p.state_shift + (size_t)b * 1792; sin = p.state_wkv + (size_t)seq * 4096; sout = p.out + O_WKVS + (size_t)seq * 4096; }
    else if (item < 384 + NQ_LIGHT) { const int bh = item - 384 - 4096, b = bh >> 2; h = bh & 3; kind = 1; rowbase = MP + b * 4; T = 4; cb = 0; ce = 1; sin = p.state_ret + (size_t)bh * 8192; sout = p.out + O_RETS + (size_t)bh * 8192; }
    else kind = 2;
    if (kind == 0) {
      if (item < 256) __builtin_amdgcn_s_setprio(3);
      const int nrep = ((DUP6 == 1 && item < 256) || (DUP6 == 2 && item >= 384)) ? 2 : 1;
#pragma unroll 1
      for (int rep = 0; rep < nrep; ++rep) rwkv_item(p, rowbase, T, h, rb, shp, sin, sout, lds);
      if (item < 256) __builtin_amdgcn_s_setprio(0);
    }
    else if (kind == 1) ret_item(p, rowbase, T, h, sin, sout, lds, cb, ce, seg, loc, flg);
    else {
      const int tt = item - 384 - NQ_LIGHT, job = tt / 704, t = tt - job * 704;
      const float* src = job == 0 ? p.ffn2_wg : (job == 1 ? p.ffn2_wu : p.ffn2_wd);
      transpose_tile(src, job == 2 ? 2816 : 1024, job == 2 ? 1024 : 2816, (bf16_t*)(p.ws + (job == 2 ? OFF_W1D : OFF_W1GU)), job == 2 ? 1 : 2, job == 1 ? 1 : 0, t, lds);
    }
  }
}

__device__ __forceinline__ void phase_post(const Params& p, unsigned char* lds) {
  const int tid = threadIdx.x, h = (tid >> 4) & 7, c4 = tid & 15, ch = h * 64 + c4 * 4;
  bf16_t* Y = (bf16_t*)(p.ws + OFF_Y); const bf16_t* PR = (const bf16_t*)(p.ws + OFF_PR);
  const bf16_t* GG = (const bf16_t*)((unsigned char*)p.out + OO_GG); const float* RHO = (const float*)((unsigned char*)p.out + OO_RHO);
  float muv[4], lg[4], lb[4];
#pragma unroll
  for (int e = 0; e < 4; ++e) { muv[e] = p.mu[1024 + ch + e]; lg[e] = p.lnx_g[ch + e]; lb[e] = p.lnx_b[ch + e]; }
  for (int pr = blockIdx.x; pr < M_TOK / 2; pr += gridDim.x) {
    const int row = pr * 2 + (tid >> 7);
    float y[4], cv[4], qv[4], g[4];
    unpk4(*(const uint2*)(Y + (size_t)row * 512 + ch), y);
    unpk4(*(const uint2*)(PR + (size_t)row * 1792 + 1024 + ch), cv);
    unpk4(*(const uint2*)(GG + (size_t)row * 512 + ch), g);
    bool first; const float* sprev = nullptr;
    if (row < MP) first = (row % TP) == 0; else { const int r2 = row - MP; first = (r2 & 3) == 0; sprev = p.state_shift + (size_t)(r2 >> 2) * 1792 + 1024 + ch; }
    if (!first) unpk4(*(const uint2*)(PR + (size_t)(row - 1) * 1792 + 1024 + ch), qv);
    else {
#pragma unroll
      for (int e = 0; e < 4; ++e) qv[e] = sprev ? sprev[e] : 0.f;
    }
    const float rho = RHO[(size_t)row * 8 + h];
    float s = y[0] + y[1] + y[2] + y[3]; s = rowsum16(s);
    const float mean = s * (1.f / 64.f);
    float d[4], q = 0.f;
#pragma unroll
    for (int e = 0; e < 4; ++e) { d[e] = y[e] - mean; q += d[e] * d[e]; }
    q = rowsum16(q);
    const float rstd = rsqrtf(q * (1.f / 64.f) + 64e-5f);
    float o[4];
#pragma unroll
    for (int e = 0; e < 4; ++e) { const float v = cv[e] + (qv[e] - cv[e]) * muv[e]; o[e] = (d[e] * rstd * lg[e] + lb[e] + rho * v) * g[e]; }
    *(uint2*)(Y + (size_t)row * 512 + ch) = pk4(o[0], o[1], o[2], o[3]);
  }
}

__device__ __forceinline__ void phase_merge(const Params& p, unsigned char* lds) {
  const bf16_t* OR = (const bf16_t*)(p.ws + OFF_GR); const bf16_t* OW = (const bf16_t*)(p.ws + OFF_Y);
  const bf16_t* WR = (const bf16_t*)(p.ws + OFF_WR); const bf16_t* WWp = (const bf16_t*)(p.ws + OFF_WW);
  const bf16_t* GA = (const bf16_t*)((unsigned char*)p.out + OO_GA); const bf16_t* GB = (const bf16_t*)(p.ws + OFF_GB);
  bf16_t* MG = (bf16_t*)(p.ws + OFF_MG);
  const int nM = NMT5, nN = 8;
  for (int L = blockIdx.x; L < nM * nN; L += gridDim.x) {
    int tm, tn; tile_coords(L, nM, nN, tm, tn);
    f32x4 acc[5][4]; ZERO_ACC5(acc);
    gemm_tile_dma<5>(OR, 512, WR, 512, 512, tm * 160, tn * 128, acc, lds);
    EPI_VARS5;
#pragma unroll
    for (int mi = 0; mi < 5; ++mi) {
      const int row = rbase + mi * 16;
      if (row < M_TOK) {
#pragma unroll
        for (int ni = 0; ni < 4; ++ni) { float g[4]; unpk4(*(const uint2*)(GA + (size_t)row * 1024 + cbase + ni * 16), g);
          *(uint2*)(MG + (size_t)row * 1024 + cbase + ni * 16) = pk4(acc[mi][ni][0] * g[0], acc[mi][ni][1] * g[1], acc[mi][ni][2] * g[2], acc[mi][ni][3] * g[3]); }
      }
    }
    ZERO_ACC5(acc);
    gemm_tile_dma<5>(OW, 512, WWp, 512, 512, tm * 160, tn * 128, acc, lds);
#pragma unroll
    for (int mi = 0; mi < 5; ++mi) {
      const int row = rbase + mi * 16;
      if (row < M_TOK) {
#pragma unroll
        for (int ni = 0; ni < 4; ++ni) { float g[4], t[4]; unpk4(*(const uint2*)(GB + (size_t)row * 1024 + cbase + ni * 16), g);
          uint2* mp = (uint2*)(MG + (size_t)row * 1024 + cbase + ni * 16); unpk4(*mp, t);
          *mp = pk4(t[0] + acc[mi][ni][0] * g[0], t[1] + acc[mi][ni][1] * g[1], t[2] + acc[mi][ni][2] * g[2], t[3] + acc[mi][ni][3] * g[3]); }
      }
    }
  }
}

__device__ __forceinline__ void phase_wout(const Params& p, unsigned char* lds) {
  const bf16_t* A = (const bf16_t*)(p.ws + OFF_MG); const bf16_t* W = (const bf16_t*)(p.ws + OFF_WO); bf16_t* H = (bf16_t*)(p.ws + OFF_H);
  const int nM = NMT5, nN = 8;
  for (int L = blockIdx.x; L < nM * nN; L += gridDim.x) {
    int tm, tn; tile_coords(L, nM, nN, tm, tn);
    f32x4 acc[5][4]; ZERO_ACC5(acc);
    gemm_tile_dma<5>(A, 1024, W, 1024, 1024, tm * 160, tn * 128, acc, lds);
    EPI_VARS5;
#pragma unroll
    for (int mi = 0; mi < 5; ++mi) {
      const int row = rbase + mi * 16;
      if (row < M_TOK) {
#pragma unroll
        for (int ni = 0; ni < 4; ++ni) { bf16_t* hp = H + (size_t)row * 1024 + cbase + ni * 16; float h[4]; unpk4(*(const uint2*)hp, h); const f32x4 a = acc[mi][ni];
          *(uint2*)hp = pk4(h[0] + a[0], h[1] + a[1], h[2] + a[2], h[3] + a[3]); }
      }
    }
  }
}

__global__ void __launch_bounds__(256, 2) mega(Params p) {
  extern __shared__ __attribute__((aligned(16))) unsigned char lds[];
  cg::grid_group grid = cg::this_grid();
  const int lo = p.phase_lo, hi = p.phase_hi;
  __shared__ uint4 xb_words;
  if (threadIdx.x == 0) xb_words = make_uint4(0u, 0u, 0u, 0u);
  __syncthreads();
  XcdBarrier xb = xcd_barrier_post((unsigned*)(p.ws + OFF_BAR), (volatile LAS unsigned*)&xb_words);
  if (hi > 1000) grid.sync();
  unsigned long long tp0 = 0;
#define PROBE_WAIT() do { if (blockIdx.x == 0) { const unsigned long long t1 = __builtin_amdgcn_s_memrealtime(); while (__builtin_amdgcn_s_memrealtime() < t1 + (t1 - tp0)) __builtin_amdgcn_s_sleep(8); } } while (0)
#define RUN_PHASE(k, call) if (PEN(k) && lo <= (k) && (k) < hi) { if ((k) > lo) xcd_barrier(xb); \
    if (PROBE_PHASE >= 0 && (k) == PROBE_PHASE + 1) PROBE_WAIT(); \
    if (PROBE_PHASE == (k)) tp0 = __builtin_amdgcn_s_memrealtime(); \
    call; if (((DUPMASK) >> (k)) & 1) { call; } }
  RUN_PHASE(0, phase0(p, lds))
  RUN_PHASE(1, phase_ffn_up<true>(p, lds))
  RUN_PHASE(2, phase_ffn_down<true>(p, lds))
  RUN_PHASE(3, (rmsnorm_phase<1, 0>(p, p.mix_norm, (bf16_t*)(p.ws + OFF_A))))
  RUN_PHASE(4, phase_win(p, lds))
  RUN_PHASE(5, phase_lora_mfma(p, lds))
  RUN_PHASE(6, phase_scan(p, lds, ((volatile LAS unsigned*)&xb_words) + 2))
  RUN_PHASE(7, phase_post(p, lds))
  RUN_PHASE(8, phase_merge(p, lds))
  RUN_PHASE(9, phase_wout(p, lds))
  RUN_PHASE(10, (rmsnorm_phase<1, 0>(p, p.ffn2_norm, (bf16_t*)(p.ws + OFF_A))))
  RUN_PHASE(11, phase_ffn_up<false>(p, lds))
  RUN_PHASE(12, phase_ffn_down<false>(p, lds))
  RUN_PHASE(13, (rmsnorm_phase<2, 1>(p, p.final_norm, nullptr)))
  if (PROBE_PHASE == 13) { xcd_barrier(xb); PROBE_WAIT(); }
}

extern "C" void kernel_launch(void* const* d_in, const int* in_sizes, int n_in, void* d_out, int out_size, void* d_ws, size_t ws_size, hipStream_t stream) {
  static int grid_blocks = 0;
  if (grid_blocks == 0) {
    if (n_in != 32 || ws_size < WS_NEED || out_size != 26458112) { fprintf(stderr, "kernel_launch: unexpected sizes n_in %d ws %zu out %d\n", n_in, ws_size, out_size); grid_blocks = -1; return; }
    int dev = 0, cus = 0, per_cu = 0;
    hipGetDevice(&dev);
    hipDeviceGetAttribute(&cus, hipDeviceAttributeMultiprocessorCount, dev);
    if (hipFuncSetAttribute((const void*)mega, hipFuncAttributeMaxDynamicSharedMemorySize, LDS_BYTES) != hipSuccess) { fprintf(stderr, "hipFuncSetAttribute failed\n"); grid_blocks = -1; return; }
    hipOccupancyMaxActiveBlocksPerMultiprocessor(&per_cu, (const void*)mega, NT, LDS_BYTES);
    if (per_cu < 1) { fprintf(stderr, "occupancy query returned %d\n", per_cu); grid_blocks = -1; return; }
    if (per_cu > 2) per_cu = 2;
    grid_blocks = cus * per_cu;
  }
  if (grid_blocks < 0) return;
  if (hipMemsetAsync((unsigned char*)d_ws + OFF_BAR, 0, 16384, stream) != hipSuccess) { fprintf(stderr, "memset failed\n"); return; }
  Params p{};
  const float** pp = (const float**)&p;
  for (int i = 0; i < 32; ++i) pp[i] = (const float*)d_in[i];
  p.out = (float*)d_out; p.ws = (unsigned char*)d_ws;
  for (int j = 0; j < 32; ++j) p.invf[j] = (float)pow(10000.0, -(double)j / 32.0);
  for (int h = 0; h < 4; ++h) p.lg2g[h] = (float)log2(1.0 - exp2(-5.0 - (double)h));
#if SINGLE_LAUNCH
  p.phase_lo = 0; p.phase_hi = NPHASE;
  void* args[] = {&p};
  hipError_t e = hipLaunchCooperativeKernel((const void*)mega, dim3(grid_blocks), dim3(NT), args, LDS_BYTES, stream);
  if (e != hipSuccess) fprintf(stderr, "cooperative launch failed: %s (grid %d)\n", hipGetErrorString(e), grid_blocks);
#else
  for (int ph = 0; ph < NPHASE; ++ph) {
    p.phase_lo = ph; p.phase_hi = ph + 1;
    hipLaunchKernelGGL(mega, dim3(grid_blocks), dim3(NT), LDS_BYTES, stream, p);
  }
#endif
}
```

```cpp
#include <hip/hip_runtime.h>
#include <hip/hip_cooperative_groups.h>
#include <cstdio>
#include <cmath>
namespace cg = cooperative_groups;

#ifndef PHMASK
#define PHMASK 0xffff
#endif
#define PEN(k) (((PHMASK) >> (k)) & 1)
#ifndef DUPMASK
#define DUPMASK 0
#endif
#ifndef DUP6
#define DUP6 0
#endif
#ifndef PROBE_PHASE
#define PROBE_PHASE (-1)
#endif
#ifndef SINGLE_LAUNCH
#define SINGLE_LAUNCH 1
#endif

typedef unsigned short bf16_t;
typedef short bf16x8 __attribute__((ext_vector_type(8)));
typedef float f32x4 __attribute__((ext_vector_type(4)));
typedef unsigned u32x4 __attribute__((ext_vector_type(4)));
typedef float f32x2 __attribute__((ext_vector_type(2)));

constexpr int NT = 256;
constexpr int M_TOK = 17024, MP = 16512, TP = 2064;
constexpr int PAST = 16384;
constexpr int LDS_BYTES = 73728;
constexpr int NPHASE = 14;

constexpr size_t S1024 = (size_t)M_TOK * 1024 * 2;
constexpr size_t S512 = S1024 / 2;
constexpr size_t OFF_W1GU = 0;
constexpr size_t OFF_W1D = OFF_W1GU + 11534336;
constexpr size_t OFF_WIN = OFF_W1D + 5767168;
constexpr size_t OFF_WR = OFF_WIN + 11010048;
constexpr size_t OFF_WW = OFF_WR + 1048576;
constexpr size_t OFF_WO = OFF_WW + 1048576;
constexpr size_t OFF_H = OFF_WO + 2097152;
constexpr size_t OFF_T = OFF_H + S1024;
constexpr size_t OFF_A = OFF_T;
constexpr size_t OFF_HF = OFF_T + S1024;
constexpr size_t OFF_QK = OFF_HF;
constexpr size_t OFF_V = OFF_QK + S512;
constexpr size_t OFF_GR = OFF_V + S512;
constexpr size_t OFF_PR = OFF_GR + S512;
constexpr size_t OFF_GB = OFF_PR + (size_t)M_TOK * 1792 * 2;
constexpr size_t OFF_Y = OFF_GB + S1024;
constexpr size_t OFF_END = OFF_Y + S512;
constexpr size_t OFF_MG = OFF_QK;
constexpr size_t OFF_BAR = OFF_END;
constexpr size_t OFF_W2T = OFF_BAR + 16384, OFF_A2T = OFF_W2T + 65536, OFF_G2T = OFF_A2T + 65536;
constexpr size_t WS_NEED = OFF_G2T + 131072;
constexpr size_t OFF_H3 = OFF_HF + (size_t)M_TOK * 2816 * 2;
constexpr size_t OFF_LD = OFF_A, OFF_AA = OFF_A + S512;
static_assert(OFF_H3 + (size_t)M_TOK * 1024 * 4 == OFF_END, "map");
constexpr size_t OO_GA = 0, OO_GG = S1024, OO_RHO = S1024 + S512;
constexpr size_t O_YP = 0, O_YS = 16777216, O_RETP = 17301504, O_WKVP = 17563648, O_SHP = 17825792, O_RETS = 17840128, O_WKVS = 22034432, O_SHS = 26228736;

struct Params {
  const float *x_prompt, *x_sample, *state_ret, *state_wkv, *state_shift, *meta;
  const float *ffn1_norm, *ffn1_wg, *ffn1_wu, *ffn1_wd, *mix_norm, *w_in, *ret_gn_g, *mu, *w0, *w2, *a0, *a2, *g2, *k_k, *k_a, *r_k, *lnx_g, *lnx_b;
  const float *w_out_ret, *w_out_rwkv, *w_out, *ffn2_norm, *ffn2_wg, *ffn2_wu, *ffn2_wd, *final_norm;
  float* out;
  unsigned char* ws;
  float invf[32];
  float lg2g[4];
  int phase_lo, phase_hi;
};


#define XB_TMO      128
#define XB_XCNT(j)  (256  + 64 * (j))
#define XB_XSUB(j)  (1280 + 64 * (j))
#define XB_XGEN(j)  (2304 + 64 * (j))
#define XB_TOP      3328
#define XB_TOPGEN   3392
#define XCD_BAR_WORDS 3456
#define XB_SPIN_CAP (1u << 18)
#define LAS __attribute__((address_space(3)))
__device__ __forceinline__ unsigned xb_ld(unsigned* p)              { return __hip_atomic_load(p, __ATOMIC_RELAXED, __HIP_MEMORY_SCOPE_AGENT); }
__device__ __forceinline__ unsigned xb_add(unsigned* p, unsigned v) { return __hip_atomic_fetch_add(p, v, __ATOMIC_RELAXED, __HIP_MEMORY_SCOPE_AGENT); }
__device__ __forceinline__ unsigned xb_xcc_id() { return (unsigned)__builtin_amdgcn_s_getreg((3 << 11) | 20) & 0xFu; }
#define XB_SPIN(cond, bar) do { unsigned _sp = 0; while (cond) { __builtin_amdgcn_s_sleep(1); \
    if ((++_sp & 255u) == 0u) { if (xb_ld(&(bar)[XB_TMO])) break; if (_sp > XB_SPIN_CAP) { atomicAdd(&(bar)[XB_TMO], 1u); break; } } } } while (0)
struct XcdBarrier { unsigned* bar; unsigned x; volatile LAS unsigned* st; };
__device__ __forceinline__ XcdBarrier xcd_barrier_post(unsigned* bar, volatile LAS unsigned* st) {
    XcdBarrier b; b.bar = bar; b.x = xb_xcc_id(); b.st = st;
    if (threadIdx.x == 0) (void)xb_add(&bar[XB_XCNT(b.x)], 1u);
    return b;
}
__device__ __forceinline__ void xcd_barrier_complete(unsigned* bar, unsigned x, unsigned& nloc, unsigned& nx) {
    const unsigned G = gridDim.x * gridDim.y * gridDim.z;
    unsigned sum, cnt, mine, sp = 0u;
    for (;;) {
        sum = 0u; cnt = 0u; mine = 0u;
#pragma unroll
        for (unsigned j = 0; j < 16; ++j) { const unsigned c = xb_ld(&bar[XB_XCNT(j)]); sum += c; cnt += (c > 0u) ? 1u : 0u; mine = (j == x) ? c : mine; }
        if (sum == G) break;
        __builtin_amdgcn_s_sleep(1);
        if ((++sp & 255u) == 0u) { if (xb_ld(&bar[XB_TMO])) break; if (sp > XB_SPIN_CAP) { atomicAdd(&bar[XB_TMO], 1u); break; } }
    }
    nloc = mine > 0u ? mine : 1u; nx = cnt > 0u ? cnt : 1u;
}
__device__ __forceinline__ void xcd_barrier(const XcdBarrier& b) {
    asm volatile("s_waitcnt vmcnt(0)" ::: "memory");
    __syncthreads();
    if (threadIdx.x == 0) {
        unsigned* bar = b.bar;
        __builtin_amdgcn_s_waitcnt(0);
        unsigned nloc = b.st[0], nx = b.st[1];
        if (nloc == 0u) { xcd_barrier_complete(bar, b.x, nloc, nx); b.st[0] = nloc; b.st[1] = nx; }
        const unsigned old = xb_add(&bar[XB_XSUB(b.x)], 1u);
        const unsigned gen = old / nloc;
        if (old + 1u == (gen + 1u) * nloc) {
            __builtin_amdgcn_fence(__ATOMIC_RELEASE, "agent");
            asm volatile("s_waitcnt vmcnt(0)" ::: "memory");
            const unsigned og = xb_add(&bar[XB_TOP], 1u);
            const unsigned tg = og / nx;
            if (og + 1u == (tg + 1u) * nx) xb_add(&bar[XB_TOPGEN], 1u);
            else XB_SPIN(xb_ld(&bar[XB_TOPGEN]) == tg, bar);
            __builtin_amdgcn_fence(__ATOMIC_ACQUIRE, "agent");
            xb_add(&bar[XB_XGEN(b.x)], 1u);
            asm volatile("s_waitcnt vmcnt(0)" ::: "memory");
        } else {
            XB_SPIN(xb_ld(&bar[XB_XGEN(b.x)]) == gen, bar);
            __builtin_amdgcn_fence(__ATOMIC_ACQUIRE, "agent");
            asm volatile("s_waitcnt vmcnt(0)" ::: "memory");
        }
    }
    __syncthreads();
}

__device__ __forceinline__ float bf2f(unsigned h) { return __uint_as_float(h << 16); }
__device__ __forceinline__ unsigned f2bf(float f) { unsigned u = __float_as_uint(f); return (u + 0x7fffu + ((u >> 16) & 1u)) >> 16; }
__device__ __forceinline__ unsigned pk2(float a, float b) { return f2bf(a) | (f2bf(b) << 16); }
__device__ __forceinline__ uint2 pk4(float a, float b, float c, float d) { uint2 r; r.x = pk2(a, b); r.y = pk2(c, d); return r; }
__device__ __forceinline__ void unpk4(uint2 u, float (&o)[4]) { o[0] = __uint_as_float(u.x << 16); o[1] = __uint_as_float(u.x & 0xffff0000u); o[2] = __uint_as_float(u.y << 16); o[3] = __uint_as_float(u.y & 0xffff0000u); }
template <int CTRL> __device__ __forceinline__ float dppf(float x) { return __builtin_bit_cast(float, __builtin_amdgcn_update_dpp(0, __builtin_bit_cast(int, x), CTRL, 0xf, 0xf, true)); }
__device__ __forceinline__ float rowsum16(float x) { x += dppf<0xB1>(x); x += dppf<0x4E>(x); x += dppf<0x141>(x); x += dppf<0x140>(x); return x; }
__device__ __forceinline__ float wavesum(float x) {
#pragma unroll
  for (int o = 32; o >= 1; o >>= 1) x += __shfl_xor(x, o);
  return x;
}
__device__ __forceinline__ float sigmoidf(float x) { return 1.f / (1.f + __expf(-x)); }
__device__ __forceinline__ float siluf(float x) { return x / (1.f + __expf(-x)); }

__device__ __forceinline__ const float* x_row(const Params& p, int row) {
  if (row < MP) { const int b = row / TP, t = row - b * TP; return t < 16 ? p.meta + t * 1024 : p.x_prompt + (size_t)(b * 2048 + t - 16) * 1024; }
  return p.x_sample + (size_t)(row - MP) * 1024;
}

__device__ __forceinline__ void transpose_tile(const float* __restrict__ src, int K, int N, bf16_t* __restrict__ dst, int rs, int ro, int t, unsigned char* lds) {
  float* tile = (float*)lds;
  const int tid = threadIdx.x;
  const int tn = N / 64;
  const int k0 = (t / tn) * 64, n0 = (t % tn) * 64;
  __syncthreads();
  { const int n = tid & 63, kq = tid >> 6;
#pragma unroll
    for (int i = 0; i < 16; ++i) { const int k = kq + 4 * i; tile[k * 65 + n] = src[(size_t)(k0 + k) * N + n0 + n]; } }
  __syncthreads();
  { const int kp = tid & 31, nq = tid >> 5;
#pragma unroll
    for (int i = 0; i < 8; ++i) { const int n = nq + 8 * i; const float v0 = tile[(2 * kp) * 65 + n], v1 = tile[(2 * kp + 1) * 65 + n];
      *(unsigned*)(dst + (size_t)((n0 + n) * rs + ro) * K + k0 + 2 * kp) = pk2(v0, v1); } }
}
__device__ __forceinline__ void transpose_tiles(const float* __restrict__ src, int K, int N, bf16_t* __restrict__ dst, int rs, int ro, unsigned char* lds, int bi, int nb) {
  const int nt = (K / 64) * (N / 64);
#pragma unroll 1
  for (int t = bi; t < nt; t += nb) transpose_tile(src, K, N, dst, rs, ro, t, lds);
}

template <int SRC, int DST> __device__ __forceinline__ void rmsnorm_phase(const Params& p, const float* __restrict__ g, bf16_t* dstb) {
  const int lane = threadIdx.x & 63, wid = threadIdx.x >> 6;
  const bf16_t* H = (const bf16_t*)(p.ws + OFF_H);
  const float* H3 = (const float*)(p.ws + OFF_H3);
  for (int row = blockIdx.x * 4 + wid; row < M_TOK; row += gridDim.x * 4) {
    float v[16];
    const float* xr = SRC == 0 ? x_row(p, row) : nullptr;
#pragma unroll
    for (int i = 0; i < 4; ++i) {
      const int col = i * 256 + lane * 4;
      if (SRC == 0) { const float4 t = *(const float4*)(xr + col); v[4 * i] = t.x; v[4 * i + 1] = t.y; v[4 * i + 2] = t.z; v[4 * i + 3] = t.w; }
      else if (SRC == 1) { const uint2 u = *(const uint2*)(H + (size_t)row * 1024 + col); float o[4]; unpk4(u, o); v[4 * i] = o[0]; v[4 * i + 1] = o[1]; v[4 * i + 2] = o[2]; v[4 * i + 3] = o[3]; }
      else { const float4 t = *(const float4*)(H3 + (size_t)row * 1024 + col); v[4 * i] = t.x; v[4 * i + 1] = t.y; v[4 * i + 2] = t.z; v[4 * i + 3] = t.w; }
    }
    float ss = 0.f;
#pragma unroll
    for (int i = 0; i < 16; ++i) ss += v[i] * v[i];
    ss = wavesum(ss);
    const float rstd = rsqrtf(ss * (1.f / 1024.f) + 1e-6f);
    float* orow = nullptr;
    if (DST == 1) {
      if (row < MP) { const int b = row / TP, t = row - b * TP; if (t >= 16) orow = p.out + O_YP + (size_t)(b * 2048 + t - 16) * 1024; }
      else orow = p.out + O_YS + (size_t)(row - MP) * 1024;
    }
#pragma unroll
    for (int i = 0; i < 4; ++i) {
      const int col = i * 256 + lane * 4;
      const float4 gv = *(const float4*)(g + col);
      const float y0 = v[4 * i] * rstd * gv.x, y1 = v[4 * i + 1] * rstd * gv.y, y2 = v[4 * i + 2] * rstd * gv.z, y3 = v[4 * i + 3] * rstd * gv.w;
      if (DST == 0) *(uint2*)(dstb + (size_t)row * 1024 + col) = pk4(y0, y1, y2, y3);
      else if (orow) *(float4*)(orow + col) = make_float4(y0, y1, y2, y3);
    }
  }
}

#define RAW_BARRIER() do { asm volatile("s_waitcnt lgkmcnt(0)" ::: "memory"); __builtin_amdgcn_s_barrier(); asm volatile("" ::: "memory"); } while (0)
template <int MI> __device__ __forceinline__ void gemm_tile_dma(const bf16_t* __restrict__ A, int lda, const bf16_t* __restrict__ Bt, int ldb, int K, int m0, int n0, f32x4 (&acc)[MI][4], unsigned char* lds) {
  constexpr int BMT = 32 * MI, NA = 2 * MI, NAW = (NA + 3) / 4, STG = (BMT + 128) * 64;
  static_assert(3 * STG <= LDS_BYTES, "ring does not fit");
  const int tid = threadIdx.x, lane = tid & 63, wid = tid >> 6, wm = wid >> 1, wn = wid & 1, l15 = lane & 15, l4 = lane >> 4;
  const int nk = K >> 5;
  const int qd = (lane >> 4) & 3, cs = ((lane & 3) ^ (((qd << 1) ^ ((qd >> 1) * 3)) & 3)) * 8;
  const bf16_t* ag[NAW]; const bf16_t* bg[2];
#pragma unroll
  for (int i = 0; i < NAW; ++i) { int row = m0 + (wid + 4 * i) * 16 + (lane >> 2); row = row < M_TOK ? row : M_TOK - 1; ag[i] = A + (size_t)row * lda + cs; }
#pragma unroll
  for (int i = 0; i < 2; ++i) { const int row = n0 + (wid * 2 + i) * 16 + (lane >> 2); bg[i] = Bt + (size_t)row * ldb + cs; }
  auto issue = [&](int kt, int buf) {
    unsigned char* sb = lds + buf * STG + lane * 16;
#pragma unroll
    for (int i = 0; i < NAW; ++i) if (wid + 4 * i < NA) __builtin_amdgcn_global_load_lds((const unsigned*)(ag[i] + kt * 32), (LAS unsigned*)(sb + (wid + 4 * i) * 1024), 16, 0, 0);
#pragma unroll
    for (int i = 0; i < 2; ++i) __builtin_amdgcn_global_load_lds((const unsigned*)(bg[i] + kt * 32), (LAS unsigned*)(sb + BMT * 64 + (wid * 2 + i) * 1024), 16, 0, 0);
  };
  const int qr = (l15 >> 2) & 3, sw = ((l4 ^ ((qr << 1) ^ ((qr >> 1) * 3))) & 3) * 16;
  const int aofs = (wm * 16 * MI + l15) * 64 + sw, bofs = BMT * 64 + (wn * 64 + l15) * 64 + sw;
  const bool big = (NA % 4 == 0) || (wid < NA % 4);
  RAW_BARRIER();
  issue(0, 0);
  if (nk > 1) issue(1, 1);
  int bc = 0, bi = 2;
  for (int kt = 0; kt < nk; ++kt) {
    if (kt + 1 < nk) {
      if (MI == 8) asm volatile("s_waitcnt vmcnt(6)" ::: "memory");
      else if (big) asm volatile("s_waitcnt vmcnt(5)" ::: "memory");
      else asm volatile("s_waitcnt vmcnt(4)" ::: "memory");
    } else asm volatile("s_waitcnt vmcnt(0)" ::: "memory");
    RAW_BARRIER();
    if (kt + 2 < nk) issue(kt + 2, bi);
    const unsigned char* st = lds + bc * STG;
    bf16x8 af[MI], bfr[4];
#pragma unroll
    for (int i = 0; i < MI; ++i) af[i] = *(const bf16x8*)(st + aofs + i * 1024);
#pragma unroll
    for (int i = 0; i < 4; ++i) bfr[i] = *(const bf16x8*)(st + bofs + i * 1024);
#pragma unroll
    for (int mi = 0; mi < MI; ++mi)
#pragma unroll
      for (int ni = 0; ni < 4; ++ni) acc[mi][ni] = __builtin_amdgcn_mfma_f32_16x16x32_bf16(bfr[ni], af[mi], acc[mi][ni], 0, 0, 0);
    bc = bc == 2 ? 0 : bc + 1; bi = bi == 2 ? 0 : bi + 1;
  }
}

#ifndef GMT
#define GMT 4
#endif
__device__ __forceinline__ void tile_coords(int L, int nM, int nN, int& tm, int& tn) {
  const int nwg = nM * nN, q = nwg / 8, r = nwg % 8, xcd = L % 8, off = L / 8;
  const int wg = (xcd < r ? xcd * (q + 1) : r * (q + 1) + (xcd - r) * q) + off;
  const int nig = GMT * nN, gid = wg / nig, fm = gid * GMT, gsz = min(nM - fm, GMT);
  tm = fm + (wg % nig) % gsz; tn = (wg % nig) / gsz;
}

#define ZERO_ACC(a) _Pragma("unroll") for (int _i = 0; _i < 4; ++_i) _Pragma("unroll") for (int _j = 0; _j < 4; ++_j) a[_i][_j] = (f32x4){0.f, 0.f, 0.f, 0.f}
#define ZERO_ACC8(a) _Pragma("unroll") for (int _i = 0; _i < 8; ++_i) _Pragma("unroll") for (int _j = 0; _j < 4; ++_j) a[_i][_j] = (f32x4){0.f, 0.f, 0.f, 0.f}
#define EPI_VARS8 const int lane = threadIdx.x & 63, wid = threadIdx.x >> 6, wm = wid >> 1, wn = wid & 1; const int rbase = tm * 256 + wm * 128 + (lane & 15), cbase = tn * 128 + wn * 64 + (lane >> 4) * 4
#define NMT 67
#define NMT5 107
#define ZERO_ACC5(a) _Pragma("unroll") for (int _i = 0; _i < 5; ++_i) _Pragma("unroll") for (int _j = 0; _j < 4; ++_j) a[_i][_j] = (f32x4){0.f, 0.f, 0.f, 0.f}
#define EPI_VARS5 const int lane = threadIdx.x & 63, wid = threadIdx.x >> 6, wm = wid >> 1, wn = wid & 1; const int rbase = tm * 160 + wm * 80 + (lane & 15), cbase = tn * 128 + wn * 64 + (lane >> 4) * 4
#define EPI_VARS const int lane = threadIdx.x & 63, wid = threadIdx.x >> 6, wm = wid >> 1, wn = wid & 1; const int rbase = tm * 128 + wm * 64 + (lane & 15), cbase = tn * 128 + wn * 64 + (lane >> 4) * 4

__device__ __forceinline__ void transpose_jobs(const Params& p, int jlo, int jhi, unsigned char* lds, int bi, int nb) {
  unsigned char* ws = p.ws;
#pragma unroll 1
  for (int j = jlo; j < jhi; ++j) {
    const float* src; int K, N, rs = 1, ro = 0; size_t off;
    switch (j) {
      case 0: src = p.ffn1_wg; K = 1024; N = 2816; off = OFF_W1GU; rs = 2; break;
      case 1: src = p.ffn1_wu; K = 1024; N = 2816; off = OFF_W1GU; rs = 2; ro = 1; break;
      case 2: src = p.ffn1_wd; K = 2816; N = 1024; off = OFF_W1D; break;
      case 3: src = p.w_in; K = 1024; N = 5376; off = OFF_WIN; break;
      case 4: src = p.w_out_ret; K = 512; N = 1024; off = OFF_WR; break;
      case 5: src = p.w_out_rwkv; K = 512; N = 1024; off = OFF_WW; break;
      case 6: src = p.w_out; K = 1024; N = 1024; off = OFF_WO; break;
      case 7: src = p.ffn2_wg; K = 1024; N = 2816; off = OFF_W1GU; rs = 2; break;
      case 8: src = p.ffn2_wu; K = 1024; N = 2816; off = OFF_W1GU; rs = 2; ro = 1; break;
      case 9: src = p.ffn2_wd; K = 2816; N = 1024; off = OFF_W1D; break;
      case 10: src = p.w2; K = 64; N = 512; off = OFF_W2T; break;
      case 11: src = p.a2; K = 64; N = 512; off = OFF_A2T; break;
      default: src = p.g2; K = 128; N = 512; off = OFF_G2T; break;
    }
    transpose_tiles(src, K, N, (bf16_t*)(ws + off), rs, ro, lds, bi, nb);
  }
}
__device__ __forceinline__ void phase0(const Params& p, unsigned char* lds) {
  transpose_jobs(p, 0, 2, lds, blockIdx.x, gridDim.x);
  transpose_jobs(p, 10, 13, lds, blockIdx.x, gridDim.x);
  rmsnorm_phase<0, 0>(p, p.ffn1_norm, (bf16_t*)(p.ws + OFF_A));
}

template <bool TAILFILL> __device__ __forceinline__ void phase_ffn_up(const Params& p, unsigned char* lds) {
  const bf16_t* A = (const bf16_t*)(p.ws + OFF_A); const bf16_t* W = (const bf16_t*)(p.ws + OFF_W1GU); bf16_t* HF = (bf16_t*)(p.ws + OFF_HF);
  const int nM = NMT, nN = 5632 / 128;
  const int nt_all = nM * nN, Gs = gridDim.x, nfull = nt_all / Gs, remt = nt_all - nfull * Gs;
  const bool slotdeal = Gs == 512 && remt > 0;
  const int nmine = slotdeal ? nfull + (blockIdx.x < 256 ? ((int)blockIdx.x < remt ? 1 : 0) + ((int)blockIdx.x + 256 < remt ? 1 : 0) : 0)
                             : nfull + ((int)blockIdx.x < remt ? 1 : 0);
  for (int it = 0; it < nmine; ++it) {
    int L = (int)blockIdx.x + it * Gs;
    if (slotdeal && it >= nfull) L = nfull * Gs + (int)blockIdx.x + (it - nfull) * 256 - (((int)blockIdx.x < remt) ? 0 : 256);
    int tm, tn; tile_coords(L, nM, nN, tm, tn);
    f32x4 acc[8][4]; ZERO_ACC8(acc);
    gemm_tile_dma<8>(A, 1024, W, 1024, 1024, tm * 256, tn * 128, acc, lds);
    EPI_VARS8;
#pragma unroll
    for (int mi = 0; mi < 8; ++mi) {
      const int row = rbase + mi * 16;
      if (row < M_TOK) {
#pragma unroll
        for (int ni = 0; ni < 4; ++ni) {
          const int c = (cbase + ni * 16) >> 1; const f32x4 a = acc[mi][ni];
          *(unsigned*)(HF + (size_t)row * 2816 + c) = pk2(siluf(a[0]) * a[1], siluf(a[2]) * a[3]);
        }
      }
    }
  }
  if (TAILFILL) {
    int bi = blockIdx.x, nb = gridDim.x;
    if (slotdeal && remt > 256 && remt < 512) { const int lo2 = remt - 256; bi = (blockIdx.x >= (unsigned)lo2 && blockIdx.x < 256) ? (int)blockIdx.x - lo2 : -1; nb = 256 - lo2; }
    if (bi >= 0) transpose_jobs(p, 2, 7, lds, bi, nb);
  }
}

template <bool FIRST> __device__ __forceinline__ void phase_ffn_down(const Params& p, unsigned char* lds) {
  const bf16_t* A = (const bf16_t*)(p.ws + OFF_HF); const bf16_t* W = (const bf16_t*)(p.ws + OFF_W1D);
  bf16_t* H = (bf16_t*)(p.ws + OFF_H); float* H3 = (float*)(p.ws + OFF_H3);
  const int nM = NMT5, nN = 8;
  for (int L = blockIdx.x; L < nM * nN; L += gridDim.x) {
    int tm, tn; tile_coords(L, nM, nN, tm, tn);
    f32x4 acc[5][4]; ZERO_ACC5(acc);
    gemm_tile_dma<5>(A, 2816, W, 2816, 2816, tm * 160, tn * 128, acc, lds);
    EPI_VARS5;
#pragma unroll
    for (int mi = 0; mi < 5; ++mi) {
      const int row = rbase + mi * 16;
      if (row < M_TOK) {
        const float* xr = FIRST ? x_row(p, row) : nullptr;
#pragma unroll
        for (int ni = 0; ni < 4; ++ni) {
          const int col = cbase + ni * 16; const f32x4 a = acc[mi][ni];
          if (FIRST) { const float4 xv = *(const float4*)(xr + col);
            *(uint2*)(H + (size_t)row * 1024 + col) = pk4(xv.x + 0.5f * a[0], xv.y + 0.5f * a[1], xv.z + 0.5f * a[2], xv.w + 0.5f * a[3]); }
          else { float h[4]; unpk4(*(const uint2*)(H + (size_t)row * 1024 + col), h);
            *(float4*)(H3 + (size_t)row * 1024 + col) = make_float4(h[0] + 0.5f * a[0], h[1] + 0.5f * a[1], h[2] + 0.5f * a[2], h[3] + 0.5f * a[3]); }
        }
      }
    }
  }
}

__device__ __forceinline__ void rope_cs(float ang, float& c, float& s) {
  double rev = (double)ang * 0.15915494309189535; rev -= rint(rev); const float fr = (float)rev;
  s = __builtin_amdgcn_sinf(fr); c = __builtin_amdgcn_cosf(fr);
}
__device__ __forceinline__ void phase_win(const Params& p, unsigned char* lds) {
  const bf16_t* A = (const bf16_t*)(p.ws + OFF_A); const bf16_t* W = (const bf16_t*)(p.ws + OFF_WIN);
  bf16_t* QK = (bf16_t*)(p.ws + OFF_QK); bf16_t* V = (bf16_t*)(p.ws + OFF_V); bf16_t* GR = (bf16_t*)(p.ws + OFF_GR); bf16_t* PR = (bf16_t*)(p.ws + OFF_PR);
  bf16_t* GB = (bf16_t*)(p.ws + OFF_GB); bf16_t* GA = (bf16_t*)((unsigned char*)p.out + OO_GA);
  const int nM = NMT, nN = 5376 / 128;
  for (int L = blockIdx.x; L < nM * nN; L += gridDim.x) {
    int tm, tn; tile_coords(L, nM, nN, tm, tn);
    f32x4 acc[8][4]; ZERO_ACC8(acc);
    gemm_tile_dma<8>(A, 1024, W, 1024, 1024, tm * 256, tn * 128, acc, lds);
    EPI_VARS8;
    const int n0 = tn * 128;
    if (n0 < 512) {
      const float sc = n0 >= 256 ? 0.125f : 1.0f;
      const int hb = n0 + wn * 64;
#pragma unroll
      for (int mi = 0; mi < 8; ++mi) {
        const int row = rbase + mi * 16;
        if (row >= M_TOK) continue;
        const float pos = row < MP ? (float)(row % TP) : (float)(PAST + ((row - MP) & 3));
#pragma unroll
        for (int ni = 0; ni < 2; ++ni) {
          float o1[4], o2[4];
#pragma unroll
          for (int jj = 0; jj < 4; ++jj) {
            const int j = ni * 16 + (lane >> 4) * 4 + jj;
            float c, s; rope_cs(pos * p.invf[j], c, s);
            const float x1 = acc[mi][ni][jj], x2 = acc[mi][ni + 2][jj];
            o1[jj] = (x1 * c - x2 * s) * sc; o2[jj] = (x1 * s + x2 * c) * sc;
          }
          const int j0 = ni * 16 + (lane >> 4) * 4;
          *(uint2*)(QK + (size_t)row * 512 + hb + j0) = pk4(o1[0], o1[1], o1[2], o1[3]);
          *(uint2*)(QK + (size_t)row * 512 + hb + 32 + j0) = pk4(o2[0], o2[1], o2[2], o2[3]);
        }
      }
    } else {
#pragma unroll
      for (int mi = 0; mi < 8; ++mi) {
        const int row = rbase + mi * 16;
        if (row >= M_TOK) continue;
        float* sh = nullptr;
        if (row < MP) { const int b = row / TP; if (row - b * TP == TP - 1) sh = p.out + O_SHP + (size_t)b * 1792; }
        else { const int r2 = row - MP; if ((r2 & 3) == 3) sh = p.out + O_SHS + (size_t)(r2 >> 2) * 1792; }
#pragma unroll
        for (int ni = 0; ni < 4; ++ni) {
          const int col = cbase + ni * 16; const f32x4 a = acc[mi][ni];
          if (n0 < 1024) *(uint2*)(V + (size_t)row * 512 + (col - 512)) = pk4(a[0], a[1], a[2], a[3]);
          else if (n0 < 1536) *(uint2*)(GR + (size_t)row * 512 + (col - 1024)) = pk4(siluf(a[0]), siluf(a[1]), siluf(a[2]), siluf(a[3]));
          else if (n0 < 3328) { *(uint2*)(PR + (size_t)row * 1792 + (col - 1536)) = pk4(a[0], a[1], a[2], a[3]);
            if (sh) *(float4*)(sh + (col - 1536)) = make_float4(a[0], a[1], a[2], a[3]); }
          else if (n0 < 4352) *(uint2*)(GA + (size_t)row * 1024 + (col - 3328)) = pk4(sigmoidf(a[0]), sigmoidf(a[1]), sigmoidf(a[2]), sigmoidf(a[3]));
          else *(uint2*)(GB + (size_t)row * 1024 + (col - 4352)) = pk4(sigmoidf(a[0]), sigmoidf(a[1]), sigmoidf(a[2]), sigmoidf(a[3]));
        }
      }
    }
  }
}

__device__ __forceinline__ void phase_lora(const Params& p, unsigned char* lds) {
  float* sS = (float*)lds;
  const int tid = threadIdx.x;
  const bf16_t* PR = (const bf16_t*)(p.ws + OFF_PR);
  bf16_t* LD = (bf16_t*)(p.ws + OFF_LD); bf16_t* AA = (bf16_t*)(p.ws + OFF_AA); bf16_t* GG = (bf16_t*)((unsigned char*)p.out + OO_GG);
  const float mu_j = p.mu[1536 + tid];
  for (int tile = blockIdx.x; tile < M_TOK / 16; tile += gridDim.x) {
    const int row0 = tile * 16;
    __syncthreads();
#pragma unroll 4
    for (int tt = 0; tt < 16; ++tt) {
      const int row = row0 + tt;
      const float pc = bf2f(PR[(size_t)row * 1792 + 1536 + tid]);
      float pp;
      if (row < MP) { const int t = row % TP; pp = t == 0 ? 0.f : bf2f(PR[(size_t)(row - 1) * 1792 + 1536 + tid]); }
      else { const int r2 = row - MP; pp = (r2 & 3) == 0 ? p.state_shift[(size_t)(r2 >> 2) * 1792 + 1536 + tid] : bf2f(PR[(size_t)(row - 1) * 1792 + 1536 + tid]); }
      const float pm = pc + (pp - pc) * mu_j;
      sS[tt * 256 + tid] = tid < 64 ? tanhf(pm) : (tid < 128 ? pm : sigmoidf(pm));
    }
    __syncthreads();
#pragma unroll 1
    for (int which = 0; which < 3; ++which) {
      const float* Wm = which == 0 ? p.w2 : (which == 1 ? p.a2 : p.g2);
      const int jb = which == 0 ? 0 : (which == 1 ? 64 : 128), nj = which == 2 ? 128 : 64;
      float acc0[16], acc1[16];
#pragma unroll
      for (int tt = 0; tt < 16; ++tt) { acc0[tt] = 0.f; acc1[tt] = 0.f; }
      for (int j = 0; j < nj; j += 4) {
        float wa[4], wb[4];
#pragma unroll
        for (int e = 0; e < 4; ++e) { wa[e] = Wm[(size_t)(j + e) * 512 + tid]; wb[e] = Wm[(size_t)(j + e) * 512 + tid + 256]; }
#pragma unroll
        for (int tt = 0; tt < 16; ++tt) {
          const float4 s4 = *(const float4*)(sS + tt * 256 + jb + j);
          acc0[tt] += s4.x * wa[0] + s4.y * wa[1] + s4.z * wa[2] + s4.w * wa[3];
          acc1[tt] += s4.x * wb[0] + s4.y * wb[1] + s4.z * wb[2] + s4.w * wb[3];
        }
      }
      if (which == 0) {
        const float b0 = p.w0[tid], b1 = p.w0[tid + 256];
#pragma unroll
        for (int tt = 0; tt < 16; ++tt) {
          const float x0 = -(b0 + acc0[tt]), x1 = -(b1 + acc1[tt]);
          const float sp0 = fmaxf(x0, 0.f) + log1pf(expf(-fabsf(x0))), sp1 = fmaxf(x1, 0.f) + log1pf(expf(-fabsf(x1)));
          LD[(size_t)(row0 + tt) * 512 + tid] = (bf16_t)f2bf(-expf(-sp0 - 0.5f));
          LD[(size_t)(row0 + tt) * 512 + tid + 256] = (bf16_t)f2bf(-expf(-sp1 - 0.5f));
        }
      } else if (which == 1) {
        const float b0 = p.a0[tid], b1 = p.a0[tid + 256];
#pragma unroll
        for (int tt = 0; tt < 16; ++tt) {
          AA[(size_t)(row0 + tt) * 512 + tid] = (bf16_t)f2bf(sigmoidf(b0 + acc0[tt]));
          AA[(size_t)(row0 + tt) * 512 + tid + 256] = (bf16_t)f2bf(sigmoidf(b1 + acc1[tt]));
        }
      } else {
#pragma unroll
        for (int tt = 0; tt < 16; ++tt) {
          GG[(size_t)(row0 + tt) * 512 + tid] = (bf16_t)f2bf(acc0[tt]);
          GG[(size_t)(row0 + tt) * 512 + tid + 256] = (bf16_t)f2bf(acc1[tt]);
        }
      }
    }
  }
}


__device__ __forceinline__ void phase_lora_mfma(const Params& p, unsigned char* lds) {
  constexpr int LSTR = 272;
  unsigned char* sA = lds; unsigned char* sB = lds + 128 * LSTR;
  const bf16_t* PR = (const bf16_t*)(p.ws + OFF_PR);
  bf16_t* LD = (bf16_t*)(p.ws + OFF_LD); bf16_t* AA = (bf16_t*)(p.ws + OFF_AA); bf16_t* GG = (bf16_t*)((unsigned char*)p.out + OO_GG);
  for (int grp = blockIdx.x; grp < (M_TOK / 128) * 3; grp += gridDim.x) {
    int tid_o = threadIdx.x; asm volatile("" : "+v"(tid_o));
    const int tid = tid_o, lane = tid & 63, wid = tid >> 6, wm = wid >> 1, wn = wid & 1, l15 = lane & 15, l4 = lane >> 4;
    const int tm = grp / 3, which = grp - tm * 3;
    const int Kc = which == 2 ? 128 : 64, jb = which == 0 ? 0 : (which == 1 ? 64 : 128), cpr = Kc >> 3;
    const bf16_t* Wt = (const bf16_t*)(p.ws + (which == 0 ? OFF_W2T : (which == 1 ? OFF_A2T : OFF_G2T)));
    __syncthreads();
    for (int q = tid; q < 128 * cpr; q += NT) {
      const int r = q / cpr, ck = q - r * cpr, row = tm * 128 + r, col = 1536 + jb + ck * 8;
      const u32x4 cu = *(const u32x4*)(PR + (size_t)row * 1792 + col);
      float pc[8], pp[8];
#pragma unroll
      for (int e = 0; e < 4; ++e) { pc[2 * e] = __uint_as_float(cu[e] << 16); pc[2 * e + 1] = __uint_as_float(cu[e] & 0xffff0000u); }
      bool first; const float* sprev = nullptr;
      if (row < MP) first = (row % TP) == 0; else { const int r2 = row - MP; first = (r2 & 3) == 0; sprev = p.state_shift + (size_t)(r2 >> 2) * 1792 + col; }
      if (!first) { const u32x4 pu = *(const u32x4*)(PR + (size_t)(row - 1) * 1792 + col);
#pragma unroll
        for (int e = 0; e < 4; ++e) { pp[2 * e] = __uint_as_float(pu[e] << 16); pp[2 * e + 1] = __uint_as_float(pu[e] & 0xffff0000u); } }
      else {
#pragma unroll
        for (int e = 0; e < 8; ++e) pp[e] = sprev ? sprev[e] : 0.f;
      }
      float sv[8];
#pragma unroll
      for (int e = 0; e < 8; ++e) {
        const float pm = pc[e] + (pp[e] - pc[e]) * p.mu[col + e];
        float t;
        if (which == 0) { const float ex = __expf(-2.f * fabsf(pm)); t = (1.f - ex) / (1.f + ex); t = pm < 0.f ? -t : t; }
        else if (which == 1) t = pm;
        else t = sigmoidf(pm);
        sv[e] = t;
      }
      u32x4 o; o[0] = pk2(sv[0], sv[1]); o[1] = pk2(sv[2], sv[3]); o[2] = pk2(sv[4], sv[5]); o[3] = pk2(sv[6], sv[7]);
      *(u32x4*)(sA + r * LSTR + ck * 16) = o;
    }
    for (int tn = 0; tn < 4; ++tn) {
      if (tn > 0) __syncthreads();
      for (int q = tid; q < 128 * cpr; q += NT) { const int r = q / cpr, ck = q - r * cpr; *(u32x4*)(sB + r * LSTR + ck * 16) = *(const u32x4*)(Wt + (size_t)(tn * 128 + r) * Kc + ck * 8); }
      __syncthreads();
      f32x4 acc[4][4]; ZERO_ACC(acc);
      for (int kk = 0; kk < (Kc >> 5); ++kk) {
        bf16x8 af[4], bfr[4];
#pragma unroll
        for (int i = 0; i < 4; ++i) { af[i] = *(const bf16x8*)(sA + (wm * 64 + i * 16 + l15) * LSTR + kk * 64 + l4 * 16); bfr[i] = *(const bf16x8*)(sB + (wn * 64 + i * 16 + l15) * LSTR + kk * 64 + l4 * 16); }
#pragma unroll
        for (int mi = 0; mi < 4; ++mi)
#pragma unroll
          for (int ni = 0; ni < 4; ++ni) acc[mi][ni] = __builtin_amdgcn_mfma_f32_16x16x32_bf16(bfr[ni], af[mi], acc[mi][ni], 0, 0, 0);
      }
#pragma unroll
      for (int ni = 0; ni < 4; ++ni) {
        const int col = tn * 128 + wn * 64 + ni * 16 + l4 * 4;
        float bias[4] = {0.f, 0.f, 0.f, 0.f};
        if (which == 0) { const float4 b4 = *(const float4*)(p.w0 + col); bias[0] = b4.x; bias[1] = b4.y; bias[2] = b4.z; bias[3] = b4.w; }
        else if (which == 1) { const float4 b4 = *(const float4*)(p.a0 + col); bias[0] = b4.x; bias[1] = b4.y; bias[2] = b4.z; bias[3] = b4.w; }
#pragma unroll
        for (int mi = 0; mi < 4; ++mi) {
          const int row = tm * 128 + wm * 64 + mi * 16 + l15;
          float o[4];
#pragma unroll
          for (int jj = 0; jj < 4; ++jj) {
            const float a = acc[mi][ni][jj] + bias[jj];
            if (which == 0) o[jj] = -0.87503879f * sigmoidf(a);
            else if (which == 1) o[jj] = sigmoidf(a);
            else o[jj] = a;
          }
          bf16_t* dst = which == 0 ? LD : (which == 1 ? AA : GG);
          *(uint2*)(dst + (size_t)row * 512 + col) = pk4(o[0], o[1], o[2], o[3]);
        }
      }
    }
  }
}

struct StageRegs { uint2 cr, ck, cv, qr, qk, qv, ld, aa; };

__device__ __forceinline__ void rwkv_item(const Params& p, int rowbase, int T, int h, int rb, const float* shift_prev, const float* S_in, float* S_out, unsigned char* lds) {
  float* stage = (float*)lds;
  float* ypart = (float*)(lds + 49152);
  int tid_f = threadIdx.x; asm volatile("" : "+v"(tid_f));
  const int tid = tid_f, lane = tid & 63, wid = tid >> 6;
  const int t_l = tid >> 4, c4 = tid & 15, ch = h * 64 + c4 * 4;
  const int kg = lane & 15, vloc = wid * 4 + (lane >> 4), vrow = rb * 16 + vloc;
  const bf16_t* PR = (const bf16_t*)(p.ws + OFF_PR); const bf16_t* LD = (const bf16_t*)(p.ws + OFF_LD); const bf16_t* AA = (const bf16_t*)(p.ws + OFF_AA);
  bf16_t* Y = (bf16_t*)(p.ws + OFF_Y); float* RHO = (float*)((unsigned char*)p.out + OO_RHO);
  float mur[4], muk[4], muv[4], kkc[4], kac[4], rkc[4];
#pragma unroll
  for (int e = 0; e < 4; ++e) { mur[e] = p.mu[ch + e]; muk[e] = p.mu[512 + ch + e]; muv[e] = p.mu[1024 + ch + e]; kkc[e] = p.k_k[ch + e]; kac[e] = p.k_a[ch + e]; rkc[e] = p.r_k[ch + e]; }
  f32x4 S;
  if (S_in) S = *(const f32x4*)(S_in + (size_t)vrow * 64 + kg * 4); else S = (f32x4){0.f, 0.f, 0.f, 0.f};
  f32x2 Sa = S.xy, Sb = S.zw;

  float rho_keep = 0.f; unsigned y_keep = 0u;
  auto load = [&](int t0, StageRegs& r) {
    int t = t0 + t_l; if (t > T - 1) t = T - 1;
    const bf16_t* cur = PR + (size_t)(rowbase + t) * 1792 + ch;
    r.cr = *(const uint2*)cur; r.ck = *(const uint2*)(cur + 512); r.cv = *(const uint2*)(cur + 1024);
    { const bf16_t* pv = t > 0 ? cur - 1792 : cur; r.qr = *(const uint2*)pv; r.qk = *(const uint2*)(pv + 512); r.qv = *(const uint2*)(pv + 1024); }
    r.ld = *(const uint2*)(LD + (size_t)(rowbase + t) * 512 + ch); r.aa = *(const uint2*)(AA + (size_t)(rowbase + t) * 512 + ch);
  };
  auto process = [&](int t0, const StageRegs& r, int buf, bool first) {
    float cr[4], ck[4], cv[4], qr[4], qk[4], qv[4], ld[4], aa[4];
    unpk4(r.cr, cr); unpk4(r.ck, ck); unpk4(r.cv, cv); unpk4(r.qr, qr); unpk4(r.qk, qk); unpk4(r.qv, qv); unpk4(r.ld, ld); unpk4(r.aa, aa);
    const int t = t0 + t_l;
    if (first && t == 0) {
#pragma unroll
      for (int e = 0; e < 4; ++e) { qr[e] = 0.f; qk[e] = 0.f; qv[e] = 0.f; }
    }
    if (first && t == 0 && shift_prev) {
#pragma unroll
      for (int e = 0; e < 4; ++e) { qr[e] = shift_prev[ch + e]; qk[e] = shift_prev[512 + ch + e]; qv[e] = shift_prev[1024 + ch + e]; }
    }
    float rr[4], k[4], v[4], kk[4], kp[4], bb[4], w[4];
    float ss = 0.f, rho = 0.f;
#pragma unroll
    for (int e = 0; e < 4; ++e) {
      rr[e] = cr[e] + (qr[e] - cr[e]) * mur[e]; k[e] = ck[e] + (qk[e] - ck[e]) * muk[e]; v[e] = cv[e] + (qv[e] - cv[e]) * muv[e];
      kk[e] = k[e] * kkc[e]; ss += kk[e] * kk[e];
      kp[e] = k[e] * (1.f + (aa[e] - 1.f) * kac[e]);
      rho += rr[e] * kp[e] * rkc[e];
      w[e] = __builtin_amdgcn_exp2f(ld[e]);
    }
    ss = rowsum16(ss); rho = rowsum16(rho);
    const float inv = rsqrtf(fmaxf(ss, 1e-24f));
#pragma unroll
    for (int e = 0; e < 4; ++e) { kk[e] *= inv; bb[e] = kk[e] * aa[e]; }
    float* sp = stage + (size_t)((buf * 16 + t_l) * 6) * 64 + c4 * 4;
    *(float4*)(sp) = make_float4(rr[0], rr[1], rr[2], rr[3]);
    *(float4*)(sp + 64) = make_float4(w[0], w[1], w[2], w[3]);
    *(float4*)(sp + 128) = make_float4(kp[0], kp[1], kp[2], kp[3]);
    *(float4*)(sp + 192) = make_float4(v[0], v[1], v[2], v[3]);
    *(float4*)(sp + 256) = make_float4(-kk[0], -kk[1], -kk[2], -kk[3]);
    *(float4*)(sp + 320) = make_float4(bb[0], bb[1], bb[2], bb[3]);
    rho_keep = rho;
    if (rb == 0 && c4 == 0 && t < T) RHO[(size_t)(rowbase + t) * 8 + h] = rho_keep;
  };

  const int nch = (T + 15) >> 4;
  StageRegs rgA, rgB;
  __syncthreads();
  load(0, rgA); process(0, rgA, 0, true);
  if (nch > 1) load(16, rgB);
  if (nch > 2) load(32, rgA);
  __syncthreads();
  auto chunk_body = [&](int c, StageRegs& rg) {
    const int buf = c & 1, t0 = c * 16;
    const int nsteps = min(16, T - t0);
    const float* st = stage + (size_t)(buf * 16) * 384;
    struct StepOps { f32x4 r[2], w[2], kp[2], nk[2], b[2]; float vv[2]; };
    auto loadg = [&](StepOps& g, int s0) {
#pragma unroll
      for (int u = 0; u < 2; ++u) {
        const float* sp = st + (s0 + u) * 384;
        g.r[u] = *(const f32x4*)(sp + kg * 4); g.w[u] = *(const f32x4*)(sp + 64 + kg * 4); g.kp[u] = *(const f32x4*)(sp + 128 + kg * 4);
        g.nk[u] = *(const f32x4*)(sp + 256 + kg * 4); g.b[u] = *(const f32x4*)(sp + 320 + kg * 4); g.vv[u] = sp[192 + vrow];
      }
    };
    auto compg = [&](const StepOps& g, int s0) {
      float yp[2];
#pragma unroll
      for (int u = 0; u < 2; ++u) {
        f32x2 pa = Sa * g.nk[u].xy; pa = Sb * g.nk[u].zw + pa;
        const float sa = rowsum16(pa.x + pa.y);
        const f32x2 sa2 = {sa, sa}, vv2 = {g.vv[u], g.vv[u]};
        const f32x2 Xa = sa2 * g.b[u].xy + vv2 * g.kp[u].xy, Xb = sa2 * g.b[u].zw + vv2 * g.kp[u].zw;
        Sa = Sa * g.w[u].xy + Xa; Sb = Sb * g.w[u].zw + Xb;
        f32x2 ya = Sa * g.r[u].xy; ya = Sb * g.r[u].zw + ya;
        yp[u] = ya.x + ya.y;
      }
#pragma unroll
      for (int u = 0; u < 2; ++u) ypart[((s0 + u) * 16 + vloc) * 16 + kg] = yp[u];
    };
    {
      StepOps ga, gb, gc;
      loadg(ga, 0); loadg(gb, 2);
      if (4 < nsteps) loadg(gc, 4);
      compg(ga, 0);
      if (6 < nsteps) loadg(ga, 6);
      compg(gb, 2);
      if (nsteps > 4) {
        loadg(gb, 8);  compg(gc, 4);
        loadg(gc, 10); compg(ga, 6);
        loadg(ga, 12); compg(gb, 8);
        loadg(gb, 14); compg(gc, 10);
        compg(ga, 12);
        compg(gb, 14);
      }
    }
    asm volatile("" :: "v"(y_keep), "v"(rho_keep));
    if (c + 1 < nch) process(t0 + 16, rg, buf ^ 1, false);
    if (c + 3 < nch) load(t0 + 48, rg);
    RAW_BARRIER();
    if (t_l < nsteps) {
      const f32x4* yp = (const f32x4*)(ypart + (t_l * 16 + c4) * 16);
      const f32x4 y0 = yp[0], y1 = yp[1], y2 = yp[2], y3 = yp[3];
      const float y = ((y0[0] + y0[1]) + (y0[2] + y0[3])) + ((y1[0] + y1[1]) + (y1[2] + y1[3])) + ((y2[0] + y2[1]) + (y2[2] + y2[3])) + ((y3[0] + y3[1]) + (y3[2] + y3[3]));
      y_keep = f2bf(y);
      Y[(size_t)(rowbase + t0 + t_l) * 512 + h * 64 + rb * 16 + c4] = (bf16_t)y_keep;
    }
    RAW_BARRIER();
  };
  for (int c = 0; c < nch; c += 2) {
    chunk_body(c, rgB);
    if (c + 1 < nch) chunk_body(c + 1, rgA);
  }
  S.xy = Sa; S.zw = Sb;
  *(f32x4*)(S_out + (size_t)vrow * 64 + kg * 4) = S;
}

__device__ __forceinline__ void ret_item(const Params& p, int rowbase, int T, int h, const float* S_in, float* S_out, unsigned char* lds, int cb, int ce, int seg, float* loc, unsigned* flags) {
  unsigned char* sQ = lds; unsigned char* sK = lds + 9216; unsigned char* sKdT = lds + 18432; unsigned char* sVT = lds + 27648; unsigned char* sP = lds + 46080; unsigned char* sST = lds + 55296;
  float* part = (float*)sK;
  int tid_f = threadIdx.x; asm volatile("" : "+v"(tid_f));
  const int tid = tid_f, lane = tid & 63, w = tid >> 6, l15 = lane & 15, l4 = lane >> 4;
  const bf16_t* QK = (const bf16_t*)(p.ws + OFF_QK); const bf16_t* V = (const bf16_t*)(p.ws + OFF_V); bf16_t* GR = (bf16_t*)(p.ws + OFF_GR);
  const float lg2 = p.lg2g[h];
  f32x4 ST[2][4];
#pragma unroll
  for (int vt = 0; vt < 2; ++vt)
#pragma unroll
    for (int dt = 0; dt < 4; ++dt) ST[vt][dt] = (f32x4){0.f, 0.f, 0.f, 0.f};
  u32x4 pq[2], pk[2], pv[4];
  auto prefetch = [&](int t0n, int tidp) {
    const int Ln = min(64, T - t0n);
#pragma unroll
    for (int i = 0; i < 2; ++i) {
      const int q_ = tidp + i * 256, j = q_ & 63, ck = q_ >> 6;
      pq[i] = (u32x4){0u, 0u, 0u, 0u}; pk[i] = pq[i];
      if (j < Ln) { const bf16_t* src = QK + (size_t)(rowbase + t0n + j) * 512 + h * 64 + ck * 8; pq[i] = *(const u32x4*)src; pk[i] = *(const u32x4*)(src + 256); }
    }
#pragma unroll
    for (int i = 0; i < 4; ++i) {
      const int q_ = tidp + i * 256, j = q_ & 63, cv = q_ >> 6;
      pv[i] = (u32x4){0u, 0u, 0u, 0u};
      if (j < Ln) pv[i] = *(const u32x4*)(V + (size_t)(rowbase + t0n + j) * 512 + h * 128 + cv * 8);
    }
  };
  if (seg >= 0 && seg < 3) {
    prefetch(cb * 64, threadIdx.x);
    for (int c = cb; c < ce; ++c) {
      const int t0 = c * 64, Lc = min(64, T - t0);
      int tid_o = threadIdx.x; asm volatile("" : "+v"(tid_o));
      const int tid = tid_o, lane = tid & 63, w = tid >> 6, l15 = lane & 15, l4 = lane >> 4;
      __syncthreads();
#pragma unroll
      for (int i = 0; i < 2; ++i) {
        const int q_ = tid + i * 256, j = q_ & 63, ck = q_ >> 6;
        const u32x4 kv = pk[i];
        const float kd = __builtin_amdgcn_exp2f((float)(Lc - 1 - j) * lg2);
#pragma unroll
        for (int e = 0; e < 4; ++e) {
          *(bf16_t*)(sKdT + (ck * 8 + 2 * e) * 144 + j * 2) = (bf16_t)f2bf(__uint_as_float(kv[e] << 16) * kd);
          *(bf16_t*)(sKdT + (ck * 8 + 2 * e + 1) * 144 + j * 2) = (bf16_t)f2bf(__uint_as_float(kv[e] & 0xffff0000u) * kd);
        }
      }
#pragma unroll
      for (int i = 0; i < 4; ++i) {
        const int q_ = tid + i * 256, j = q_ & 63, cv = q_ >> 6;
        const u32x4 vv = pv[i];
#pragma unroll
        for (int e = 0; e < 4; ++e) {
          *(bf16_t*)(sVT + (cv * 8 + 2 * e) * 144 + j * 2) = (bf16_t)(vv[e] & 0xffffu);
          *(bf16_t*)(sVT + (cv * 8 + 2 * e + 1) * 144 + j * 2) = (bf16_t)(vv[e] >> 16);
        }
      }
      if (c + 1 < ce) prefetch(t0 + 64, tid);
      __syncthreads();
      const float gl = __builtin_amdgcn_exp2f((float)Lc * lg2);
      bf16x8 bV[2][2];
#pragma unroll
      for (int vt = 0; vt < 2; ++vt)
#pragma unroll
        for (int kk = 0; kk < 2; ++kk) bV[vt][kk] = *(const bf16x8*)(sVT + (32 * w + vt * 16 + l15) * 144 + kk * 64 + l4 * 16);
#pragma unroll
      for (int dt = 0; dt < 4; ++dt) {
        bf16x8 bK[2];
#pragma unroll
        for (int kk = 0; kk < 2; ++kk) bK[kk] = *(const bf16x8*)(sKdT + (dt * 16 + l15) * 144 + kk * 64 + l4 * 16);
#pragma unroll
        for (int vt = 0; vt < 2; ++vt) {
          f32x4 a = ST[vt][dt] * gl;
#pragma unroll
          for (int kk = 0; kk < 2; ++kk) a = __builtin_amdgcn_mfma_f32_16x16x32_bf16(bV[vt][kk], bK[kk], a, 0, 0, 0);
          ST[vt][dt] = a;
        }
      }
    }
    float* lp = loc + (size_t)seg * 8192;
#pragma unroll
    for (int vt = 0; vt < 2; ++vt)
#pragma unroll
      for (int dt = 0; dt < 4; ++dt)
        *(float4*)(lp + (size_t)(dt * 16 + l15) * 128 + 32 * w + vt * 16 + l4 * 4) = make_float4(ST[vt][dt][0], ST[vt][dt][1], ST[vt][dt][2], ST[vt][dt][3]);
    __threadfence();
    __syncthreads();
    if (threadIdx.x == 0) { asm volatile("s_waitcnt vmcnt(0)" ::: "memory"); __hip_atomic_store(flags + seg, 1u, __ATOMIC_RELAXED, __HIP_MEMORY_SCOPE_AGENT); }
  }
#pragma unroll
  for (int vt = 0; vt < 2; ++vt)
#pragma unroll
    for (int dt = 0; dt < 4; ++dt) ST[vt][dt] = (f32x4){0.f, 0.f, 0.f, 0.f};
  if (seg > 0) {
    if (threadIdx.x == 0) {
      for (int s2 = 0; s2 < seg; ++s2) { unsigned sp = 0; while (__hip_atomic_load(flags + s2, __ATOMIC_RELAXED, __HIP_MEMORY_SCOPE_AGENT) == 0u) { __builtin_amdgcn_s_sleep(2); if (++sp > (1u << 22)) break; } }
      __builtin_amdgcn_fence(__ATOMIC_ACQUIRE, "agent");
      asm volatile("s_waitcnt vmcnt(0)" ::: "memory");
    }
    __syncthreads();
    for (int s2 = 0; s2 < seg; ++s2) {
      const float dk = __builtin_amdgcn_exp2f((float)(64 * (cb - 8 * (s2 + 1))) * lg2);
      const float* lp = loc + (size_t)s2 * 8192;
#pragma unroll
      for (int vt = 0; vt < 2; ++vt)
#pragma unroll
        for (int dt = 0; dt < 4; ++dt) {
          const float4 t4 = *(const float4*)(lp + (size_t)(dt * 16 + l15) * 128 + 32 * w + vt * 16 + l4 * 4);
          ST[vt][dt][0] += dk * t4.x; ST[vt][dt][1] += dk * t4.y; ST[vt][dt][2] += dk * t4.z; ST[vt][dt][3] += dk * t4.w;
        }
    }
  } else if (S_in) {
#pragma unroll
    for (int vt = 0; vt < 2; ++vt)
#pragma unroll
      for (int dt = 0; dt < 4; ++dt) {
        const float4 t4 = *(const float4*)(S_in + (size_t)(dt * 16 + l15) * 128 + 32 * w + vt * 16 + l4 * 4);
        ST[vt][dt][0] = t4.x; ST[vt][dt][1] = t4.y; ST[vt][dt][2] = t4.z; ST[vt][dt][3] = t4.w;
      }
  }
  __syncthreads();
#pragma unroll
  for (int vt = 0; vt < 2; ++vt)
#pragma unroll
    for (int dt = 0; dt < 4; ++dt)
#pragma unroll
      for (int jj = 0; jj < 4; ++jj) *(bf16_t*)(sST + (32 * w + vt * 16 + l4 * 4 + jj) * 144 + (dt * 16 + l15) * 2) = (bf16_t)f2bf(ST[vt][dt][jj]);
  prefetch(cb * 64, threadIdx.x);
  for (int c = cb; c < ce; ++c) {
    const int t0 = c * 64, Lc = min(64, T - t0);
    int tid_o = threadIdx.x; asm volatile("" : "+v"(tid_o));
    const int tid = tid_o, lane = tid & 63, w = tid >> 6, l15 = lane & 15, l4 = lane >> 4;
    __syncthreads();
#pragma unroll
    for (int i = 0; i < 2; ++i) {
      const int q_ = tid + i * 256, j = q_ & 63, ck = q_ >> 6;
      const u32x4 kv = pk[i];
      *(u32x4*)(sQ + j * 144 + ck * 16) = pq[i]; *(u32x4*)(sK + j * 144 + ck * 16) = kv;
      const float kd = __builtin_amdgcn_exp2f((float)(Lc - 1 - j) * lg2);
#pragma unroll
      for (int e = 0; e < 4; ++e) {
        *(bf16_t*)(sKdT + (ck * 8 + 2 * e) * 144 + j * 2) = (bf16_t)f2bf(__uint_as_float(kv[e] << 16) * kd);
        *(bf16_t*)(sKdT + (ck * 8 + 2 * e + 1) * 144 + j * 2) = (bf16_t)f2bf(__uint_as_float(kv[e] & 0xffff0000u) * kd);
      }
    }
#pragma unroll
    for (int i = 0; i < 4; ++i) {
      const int q_ = tid + i * 256, j = q_ & 63, cv = q_ >> 6;
      const u32x4 vv = pv[i];
#pragma unroll
      for (int e = 0; e < 4; ++e) {
        *(bf16_t*)(sVT + (cv * 8 + 2 * e) * 144 + j * 2) = (bf16_t)(vv[e] & 0xffffu);
        *(bf16_t*)(sVT + (cv * 8 + 2 * e + 1) * 144 + j * 2) = (bf16_t)(vv[e] >> 16);
      }
    }
    if (c + 1 < ce) prefetch(t0 + 64, tid);
    __syncthreads();
    {
      f32x4 sc[4];
#pragma unroll
      for (int jt = 0; jt < 4; ++jt) sc[jt] = (f32x4){0.f, 0.f, 0.f, 0.f};
#pragma unroll
      for (int kk = 0; kk < 2; ++kk) {
        const bf16x8 aq = *(const bf16x8*)(sQ + (16 * w + l15) * 144 + kk * 64 + l4 * 16);
#pragma unroll
        for (int jt = 0; jt < 4; ++jt) { const bf16x8 bk = *(const bf16x8*)(sK + (jt * 16 + l15) * 144 + kk * 64 + l4 * 16); sc[jt] = __builtin_amdgcn_mfma_f32_16x16x32_bf16(aq, bk, sc[jt], 0, 0, 0); }
      }
#pragma unroll
      for (int jt = 0; jt < 4; ++jt)
#pragma unroll
        for (int jj = 0; jj < 4; ++jj) {
          const int i = 16 * w + l4 * 4 + jj, j = jt * 16 + l15;
          const float pv = i >= j ? sc[jt][jj] * __builtin_amdgcn_exp2f((float)(i - j) * lg2) : 0.f;
          *(bf16_t*)(sP + i * 144 + j * 2) = (bf16_t)f2bf(pv);
        }
    }
    __syncthreads();
    f32x4 o[4][2];
    {
      bf16x8 bV[2][2], bS[2][2];
#pragma unroll
      for (int vt = 0; vt < 2; ++vt)
#pragma unroll
        for (int kk = 0; kk < 2; ++kk) {
          bV[vt][kk] = *(const bf16x8*)(sVT + (32 * w + vt * 16 + l15) * 144 + kk * 64 + l4 * 16);
          bS[vt][kk] = *(const bf16x8*)(sST + (32 * w + vt * 16 + l15) * 144 + kk * 64 + l4 * 16);
        }
#pragma unroll
      for (int it = 0; it < 4; ++it) {
        bf16x8 aP[2], aQ[2];
#pragma unroll
        for (int kk = 0; kk < 2; ++kk) { aP[kk] = *(const bf16x8*)(sP + (it * 16 + l15) * 144 + kk * 64 + l4 * 16); aQ[kk] = *(const bf16x8*)(sQ + (it * 16 + l15) * 144 + kk * 64 + l4 * 16); }
#pragma unroll
        for (int vt = 0; vt < 2; ++vt) {
          f32x4 a1 = (f32x4){0.f, 0.f, 0.f, 0.f}, a2 = (f32x4){0.f, 0.f, 0.f, 0.f};
#pragma unroll
          for (int kk = 0; kk < 2; ++kk) { a1 = __builtin_amdgcn_mfma_f32_16x16x32_bf16(aP[kk], bV[vt][kk], a1, 0, 0, 0); a2 = __builtin_amdgcn_mfma_f32_16x16x32_bf16(aQ[kk], bS[vt][kk], a2, 0, 0, 0); }
#pragma unroll
          for (int jj = 0; jj < 4; ++jj) { const int i = it * 16 + l4 * 4 + jj; o[it][vt][jj] = a1[jj] + __builtin_amdgcn_exp2f((float)(i + 1) * lg2) * a2[jj]; }
        }
      }
      const float gl = __builtin_amdgcn_exp2f((float)Lc * lg2);
#pragma unroll
      for (int dt = 0; dt < 4; ++dt) {
        bf16x8 bK[2];
#pragma unroll
        for (int kk = 0; kk < 2; ++kk) bK[kk] = *(const bf16x8*)(sKdT + (dt * 16 + l15) * 144 + kk * 64 + l4 * 16);
#pragma unroll
        for (int vt = 0; vt < 2; ++vt) {
          f32x4 a = ST[vt][dt] * gl;
#pragma unroll
          for (int kk = 0; kk < 2; ++kk) a = __builtin_amdgcn_mfma_f32_16x16x32_bf16(bV[vt][kk], bK[kk], a, 0, 0, 0);
          ST[vt][dt] = a;
#pragma unroll
          for (int jj = 0; jj < 4; ++jj) *(bf16_t*)(sST + (32 * w + vt * 16 + l4 * 4 + jj) * 144 + (dt * 16 + l15) * 2) = (bf16_t)f2bf(a[jj]);
        }
      }
    }
    unsigned short grv[4][4][2];
#pragma unroll
    for (int it = 0; it < 4; ++it)
#pragma unroll
      for (int jj = 0; jj < 4; ++jj) {
        const int i = it * 16 + l4 * 4 + jj;
#pragma unroll
        for (int vt = 0; vt < 2; ++vt) grv[it][jj][vt] = i < Lc ? GR[(size_t)(rowbase + t0 + i) * 512 + h * 128 + 32 * w + vt * 16 + l15] : (unsigned short)0;
      }
#pragma unroll
    for (int it = 0; it < 4; ++it)
#pragma unroll
      for (int jj = 0; jj < 4; ++jj) {
        float s1 = o[it][0][jj] + o[it][1][jj], s2 = o[it][0][jj] * o[it][0][jj] + o[it][1][jj] * o[it][1][jj];
        s1 = rowsum16(s1); s2 = rowsum16(s2);
        if (l15 == 0) { const int i = it * 16 + l4 * 4 + jj; part[(w * 64 + i) * 2] = s1; part[(w * 64 + i) * 2 + 1] = s2; }
      }
    const float gn[2] = {p.ret_gn_g[h * 128 + 32 * w + l15], p.ret_gn_g[h * 128 + 32 * w + 16 + l15]};
    __syncthreads();
#pragma unroll
    for (int it = 0; it < 4; ++it)
#pragma unroll
      for (int jj = 0; jj < 4; ++jj) {
        const int i = it * 16 + l4 * 4 + jj;
        float s1 = 0.f, s2 = 0.f;
#pragma unroll
        for (int ww = 0; ww < 4; ++ww) { s1 += part[(ww * 64 + i) * 2]; s2 += part[(ww * 64 + i) * 2 + 1]; }
        const float mean = s1 * (1.f / 128.f), var = fmaxf(s2 * (1.f / 128.f) - mean * mean, 0.f), rstd = rsqrtf(var + 1e-6f);
        if (i < Lc) {
#pragma unroll
          for (int vt = 0; vt < 2; ++vt) {
            const int v = 32 * w + vt * 16 + l15;
            bf16_t* gp = GR + (size_t)(rowbase + t0 + i) * 512 + h * 128 + v;
            *gp = (bf16_t)f2bf((o[it][vt][jj] - mean) * rstd * gn[vt] * bf2f(grv[it][jj][vt]));
          }
        }
      }
  }
  if (S_out)
#pragma unroll
  for (int vt = 0; vt < 2; ++vt)
#pragma unroll
    for (int dt = 0; dt < 4; ++dt)
      *(float4*)(S_out + (size_t)(dt * 16 + l15) * 128 + 32 * w + vt * 16 + l4 * 4) = make_float4(ST[vt][dt][0], ST[vt][dt][1], ST[vt][dt][2], ST[vt][dt][3]);
}

constexpr size_t OO_LOC = 56000000;
constexpr int NQ_LIGHT = 4608, NQ_TOTAL = 4608 + 3 * 704;
__device__ __forceinline__ void phase_scan(const Params& p, unsigned char* lds, volatile LAS unsigned* qslot) {
  const int G = gridDim.x;
  unsigned* flags_all = (unsigned*)(p.ws + OFF_BAR + 14336);
  unsigned* qctr = (unsigned*)(p.ws + OFF_BAR + 15360);
  float* loc_all = (float*)((unsigned char*)p.out + OO_LOC);
  int hid = blockIdx.x;
  bool heavy = true;
#pragma unroll 1
  while (true) {
    int item;
    if (heavy) { if (hid < 384) { item = hid; hid += G; } else { heavy = false; continue; } }
    else {
      __syncthreads();
      if (threadIdx.x == 0) *qslot = atomicAdd(qctr, 1u);
      __syncthreads();
      const int qi = (int)*qslot;
      if (qi >= NQ_TOTAL) break;
      item = 384 + qi;
    }
    int kind; int rowbase = 0, T = 0, h = 0, rb = 0, cb = 0, ce = 0, seg = -1; const float* shp = nullptr; const float* sin = nullptr; float* sout = nullptr; float* loc = nullptr; unsigned* flg = nullptr;
    if (item < 256) { const int j = item >> 3, seq = (item & 7) * 8 + (j >> 2), b = seq >> 3; rb = j & 3; h = seq & 7; kind = 0; rowbase = b * TP; T = TP; sout = p.out + O_WKVP + (size_t)seq * 4096; }
    else if (item < 384) { const int idx = item - 256, bh = idx >> 2, b = bh >> 2; seg = idx & 3; h = bh & 3; kind = 1; rowbase = b * TP; T = TP; cb = seg * 8; ce = seg == 3 ? 33 : cb + 8;
      sout = seg == 3 ? p.out + O_RETP + (size_t)bh * 8192 : nullptr; loc = loc_all + (size_t)bh * 3 * 8192; flg = flags_all + bh * 4; }
    else if (item < 384 + 4096) { const int it = item - 384, seq = it >> 2, b = seq >> 3; rb = it & 3; h = seq & 7; kind = 0; rowbase = MP + b * 4; T = 4;
      shp = p.state_shift + (size_t)b * 1792; sin = p.state_wkv + (size_t)seq * 4096; sout = p.out + O_WKVS + (size_t)seq * 4096; }
    else if (item < 384 + NQ_LIGHT) { const int bh = item - 384 - 4096, b = bh >> 2; h = bh & 3; kind = 1; rowbase = MP + b * 4; T = 4; cb = 0; ce = 1; sin = p.state_ret + (size_t)bh * 8192; sout = p.out + O_RETS + (size_t)bh * 8192; }
    else kind = 2;
    if (kind == 0) {
      if (item < 256) __builtin_amdgcn_s_setprio(3);
      const int nrep = ((DUP6 == 1 && item < 256) || (DUP6 == 2 && item >= 384)) ? 2 : 1;
#pragma unroll 1
      for (int rep = 0; rep < nrep; ++rep) rwkv_item(p, rowbase, T, h, rb, shp, sin, sout, lds);
      if (item < 256) __builtin_amdgcn_s_setprio(0);
    }
    else if (kind == 1) ret_item(p, rowbase, T, h, sin, sout, lds, cb, ce, seg, loc, flg);
    else {
      const int tt = item - 384 - NQ_LIGHT, job = tt / 704, t = tt - job * 704;
      const float* src = job == 0 ? p.ffn2_wg : (job == 1 ? p.ffn2_wu : p.ffn2_wd);
      transpose_tile(src, job == 2 ? 2816 : 1024, job == 2 ? 1024 : 2816, (bf16_t*)(p.ws + (job == 2 ? OFF_W1D : OFF_W1GU)), job == 2 ? 1 : 2, job == 1 ? 1 : 0, t, lds);
    }
  }
}

__device__ __forceinline__ void phase_post(const Params& p, unsigned char* lds) {
  const int tid = threadIdx.x, h = (tid >> 4) & 7, c4 = tid & 15, ch = h * 64 + c4 * 4;
  bf16_t* Y = (bf16_t*)(p.ws + OFF_Y); const bf16_t* PR = (const bf16_t*)(p.ws + OFF_PR);
  const bf16_t* GG = (const bf16_t*)((unsigned char*)p.out + OO_GG); const float* RHO = (const float*)((unsigned char*)p.out + OO_RHO);
  float muv[4], lg[4], lb[4];
#pragma unroll
  for (int e = 0; e < 4; ++e) { muv[e] = p.mu[1024 + ch + e]; lg[e] = p.lnx_g[ch + e]; lb[e] = p.lnx_b[ch + e]; }
  for (int pr = blockIdx.x; pr < M_TOK / 2; pr += gridDim.x) {
    const int row = pr * 2 + (tid >> 7);
    float y[4], cv[4], qv[4], g[4];
    unpk4(*(const uint2*)(Y + (size_t)row * 512 + ch), y);
    unpk4(*(const uint2*)(PR + (size_t)row * 1792 + 1024 + ch), cv);
    unpk4(*(const uint2*)(GG + (size_t)row * 512 + ch), g);
    bool first; const float* sprev = nullptr;
    if (row < MP) first = (row % TP) == 0; else { const int r2 = row - MP; first = (r2 & 3) == 0; sprev = p.state_shift + (size_t)(r2 >> 2) * 1792 + 1024 + ch; }
    if (!first) unpk4(*(const uint2*)(PR + (size_t)(row - 1) * 1792 + 1024 + ch), qv);
    else {
#pragma unroll
      for (int e = 0; e < 4; ++e) qv[e] = sprev ? sprev[e] : 0.f;
    }
    const float rho = RHO[(size_t)row * 8 + h];
    float s = y[0] + y[1] + y[2] + y[3]; s = rowsum16(s);
    const float mean = s * (1.f / 64.f);
    float d[4], q = 0.f;
#pragma unroll
    for (int e = 0; e < 4; ++e) { d[e] = y[e] - mean; q += d[e] * d[e]; }
    q = rowsum16(q);
    const float rstd = rsqrtf(q * (1.f / 64.f) + 64e-5f);
    float o[4];
#pragma unroll
    for (int e = 0; e < 4; ++e) { const float v = cv[e] + (qv[e] - cv[e]) * muv[e]; o[e] = (d[e] * rstd * lg[e] + lb[e] + rho * v) * g[e]; }
    *(uint2*)(Y + (size_t)row * 512 + ch) = pk4(o[0], o[1], o[2], o[3]);
  }
}

__device__ __forceinline__ void phase_merge(const Params& p, unsigned char* lds) {
  const bf16_t* OR = (const bf16_t*)(p.ws + OFF_GR); const bf16_t* OW = (const bf16_t*)(p.ws + OFF_Y);
  const bf16_t* WR = (const bf16_t*)(p.ws + OFF_WR); const bf16_t* WWp = (const bf16_t*)(p.ws + OFF_WW);
  const bf16_t* GA = (const bf16_t*)((unsigned char*)p.out + OO_GA); const bf16_t* GB = (const bf16_t*)(p.ws + OFF_GB);
  bf16_t* MG = (bf16_t*)(p.ws + OFF_MG);
  const int nM = NMT5, nN = 8;
  for (int L = blockIdx.x; L < nM * nN; L += gridDim.x) {
    int tm, tn; tile_coords(L, nM, nN, tm, tn);
    f32x4 acc[5][4]; ZERO_ACC5(acc);
    gemm_tile_dma<5>(OR, 512, WR, 512, 512, tm * 160, tn * 128, acc, lds);
    EPI_VARS5;
#pragma unroll
    for (int mi = 0; mi < 5; ++mi) {
      const int row = rbase + mi * 16;
      if (row < M_TOK) {
#pragma unroll
        for (int ni = 0; ni < 4; ++ni) { float g[4]; unpk4(*(const uint2*)(GA + (size_t)row * 1024 + cbase + ni * 16), g);
          *(uint2*)(MG + (size_t)row * 1024 + cbase + ni * 16) = pk4(acc[mi][ni][0] * g[0], acc[mi][ni][1] * g[1], acc[mi][ni][2] * g[2], acc[mi][ni][3] * g[3]); }
      }
    }
    ZERO_ACC5(acc);
    gemm_tile_dma<5>(OW, 512, WWp, 512, 512, tm * 160, tn * 128, acc, lds);
#pragma unroll
    for (int mi = 0; mi < 5; ++mi) {
      const int row = rbase + mi * 16;
      if (row < M_TOK) {
#pragma unroll
        for (int ni = 0; ni < 4; ++ni) { float g[4], t[4]; unpk4(*(const uint2*)(GB + (size_t)row * 1024 + cbase + ni * 16), g);
          uint2* mp = (uint2*)(MG + (size_t)row * 1024 + cbase + ni * 16); unpk4(*mp, t);
          *mp = pk4(t[0] + acc[mi][ni][0] * g[0], t[1] + acc[mi][ni][1] * g[1], t[2] + acc[mi][ni][2] * g[2], t[3] + acc[mi][ni][3] * g[3]); }
      }
    }
  }
}

__device__ __forceinline__ void phase_wout(const Params& p, unsigned char* lds) {
  const bf16_t* A = (const bf16_t*)(p.ws + OFF_MG); const bf16_t* W = (const bf16_t*)(p.ws + OFF_WO); bf16_t* H = (bf16_t*)(p.ws + OFF_H);
  const int nM = NMT5, nN = 8;
  for (int L = blockIdx.x; L < nM * nN; L += gridDim.x) {
    int tm, tn; tile_coords(L, nM, nN, tm, tn);
    f32x4 acc[5][4]; ZERO_ACC5(acc);
    gemm_tile_dma<5>(A, 1024, W, 1024, 1024, tm * 160, tn * 128, acc, lds);
    EPI_VARS5;
#pragma unroll
    for (int mi = 0; mi < 5; ++mi) {
      const int row = rbase + mi * 16;
      if (row < M_TOK) {
#pragma unroll
        for (int ni = 0; ni < 4; ++ni) { bf16_t* hp = H + (size_t)row * 1024 + cbase + ni * 16; float h[4]; unpk4(*(const uint2*)hp, h); const f32x4 a = acc[mi][ni];
          *(uint2*)hp = pk4(h[0] + a[0], h[1] + a[1], h[2] + a[2], h[3] + a[3]); }
      }
    }
  }
}

__global__ void __launch_bounds__(256, 2) mega(Params p) {
  extern __shared__ __attribute__((aligned(16))) unsigned char lds[];
  cg::grid_group grid = cg::this_grid();
  const int lo = p.phase_lo, hi = p.phase_hi;
  __shared__ uint4 xb_words;
  if (threadIdx.x == 0) xb_words = make_uint4(0u, 0u, 0u, 0u);
  __syncthreads();
  XcdBarrier xb = xcd_barrier_post((unsigned*)(p.ws + OFF_BAR), (volatile LAS unsigned*)&xb_words);
  if (hi > 1000) grid.sync();
  unsigned long long tp0 = 0;
#define PROBE_WAIT() do { if (blockIdx.x == 0) { const unsigned long long t1 = __builtin_amdgcn_s_memrealtime(); while (__builtin_amdgcn_s_memrealtime() < t1 + (t1 - tp0)) __builtin_amdgcn_s_sleep(8); } } while (0)
#define RUN_PHASE(k, call) if (PEN(k) && lo <= (k) && (k) < hi) { if ((k) > lo) xcd_barrier(xb); \
    if (PROBE_PHASE >= 0 && (k) == PROBE_PHASE + 1) PROBE_WAIT(); \
    if (PROBE_PHASE == (k)) tp0 = __builtin_amdgcn_s_memrealtime(); \
    call; if (((DUPMASK) >> (k)) & 1) { call; } }
  RUN_PHASE(0, phase0(p, lds))
  RUN_PHASE(1, phase_ffn_up<true>(p, lds))
  RUN_PHASE(2, phase_ffn_down<true>(p, lds))
  RUN_PHASE(3, (rmsnorm_phase<1, 0>(p, p.mix_norm, (bf16_t*)(p.ws + OFF_A))))
  RUN_PHASE(4, phase_win(p, lds))
  RUN_PHASE(5, phase_lora_mfma(p, lds))
  RUN_PHASE(6, phase_scan(p, lds, ((volatile LAS unsigned*)&xb_words) + 2))
  RUN_PHASE(7, phase_post(p, lds))
  RUN_PHASE(8, phase_merge(p, lds))
  RUN_PHASE(9, phase_wout(p, lds))
  RUN_PHASE(10, (rmsnorm_phase<1, 0>(p, p.ffn2_norm, (bf16_t*)(p.ws + OFF_A))))
  RUN_PHASE(11, phase_ffn_up<false>(p, lds))
  RUN_PHASE(12, phase_ffn_down<false>(p, lds))
  RUN_PHASE(13, (rmsnorm_phase<2, 1>(p, p.final_norm, nullptr)))
  if (PROBE_PHASE == 13) { xcd_barrier(xb); PROBE_WAIT(); }
}

extern "C" void kernel_launch(void* const* d_in, const int* in_sizes, int n_in, void* d_out, int out_size, void* d_ws, size_t ws_size, hipStream_t stream) {
  static int grid_blocks = 0;
  if (grid_blocks == 0) {
    if (n_in != 32 || ws_size < WS_NEED || out_size != 26458112) { fprintf(stderr, "kernel_launch: unexpected sizes n_in %d ws %zu out %d\n", n_in, ws_size, out_size); grid_blocks = -1; return; }
    int dev = 0, cus = 0, per_cu = 0;
    hipGetDevice(&dev);
    hipDeviceGetAttribute(&cus, hipDeviceAttributeMultiprocessorCount, dev);
    if (hipFuncSetAttribute((const void*)mega, hipFuncAttributeMaxDynamicSharedMemorySize, LDS_BYTES) != hipSuccess) { fprintf(stderr, "hipFuncSetAttribute failed\n"); grid_blocks = -1; return; }
    hipOccupancyMaxActiveBlocksPerMultiprocessor(&per_cu, (const void*)mega, NT, LDS_BYTES);
    if (per_cu < 1) { fprintf(stderr, "occupancy query returned %d\n", per_cu); grid_blocks = -1; return; }
    if (per_cu > 2) per_cu = 2;
    grid_blocks = cus * per_cu;
  }
  if (grid_blocks < 0) return;
  if (hipMemsetAsync((unsigned char*)d_ws + OFF_BAR, 0, 16384, stream) != hipSuccess) { fprintf(stderr, "memset failed\n"); return; }
  Params p{};
  const float** pp = (const float**)&p;
  for (int i = 0; i < 32; ++i) pp[i] = (const float*)d_in[i];
  p.out = (float*)d_out; p.ws = (unsigned char*)d_ws;
  for (int j = 0; j < 32; ++j) p.invf[j] = (float)pow(10000.0, -(double)j / 32.0);
  for (int h = 0; h < 4; ++h) p.lg2g[h] = (float)log2(1.0 - exp2(-5.0 - (double)h));
#if SINGLE_LAUNCH
  p.phase_lo = 0; p.phase_hi = NPHASE;
  void* args[] = {&p};
  hipError_t e = hipLaunchCooperativeKernel((const void*)mega, dim3(grid_blocks), dim3(NT), args, LDS_BYTES, stream);
  if (e != hipSuccess) fprintf(stderr, "cooperative launch failed: %s (grid %d)\n", hipGetErrorString(e), grid_blocks);
#else
  for (int ph = 0; ph < NPHASE; ++ph) {
    p.phase_lo = ph; p.phase_hi = ph + 1;
    hipLaunchKernelGGL(mega, dim3(grid_blocks), dim3(NT), LDS_BYTES, stream, p);
  }
#endif
}
```

```cpp
#include <hip/hip_runtime.h>
#include <hip/hip_cooperative_groups.h>
#include <cstdio>
#include <cmath>
namespace cg = cooperative_groups;

#ifndef PHMASK
#define PHMASK 0xffff
#endif
#define PEN(k) (((PHMASK) >> (k)) & 1)
#ifndef DUPMASK
#define DUPMASK 0
#endif
#ifndef DUP6
#define DUP6 0
#endif
#ifndef PROBE_PHASE
#define PROBE_PHASE (-1)
#endif
#ifndef SINGLE_LAUNCH
#define SINGLE_LAUNCH 1
#endif

typedef unsigned short bf16_t;
typedef short bf16x8 __attribute__((ext_vector_type(8)));
typedef float f32x4 __attribute__((ext_vector_type(4)));
typedef unsigned u32x4 __attribute__((ext_vector_type(4)));
typedef float f32x2 __attribute__((ext_vector_type(2)));

constexpr int NT = 256;
constexpr int M_TOK = 17024, MP = 16512, TP = 2064;
constexpr int PAST = 16384;
constexpr int LDS_BYTES = 73728;
constexpr int NPHASE = 14;

constexpr size_t S1024 = (size_t)M_TOK * 1024 * 2;
constexpr size_t S512 = S1024 / 2;
constexpr size_t OFF_W1GU = 0;
constexpr size_t OFF_W1D = OFF_W1GU + 11534336;
constexpr size_t OFF_WIN = OFF_W1D + 5767168;
constexpr size_t OFF_WR = OFF_WIN + 11010048;
constexpr size_t OFF_WW = OFF_WR + 1048576;
constexpr size_t OFF_WO = OFF_WW + 1048576;
constexpr size_t OFF_H = OFF_WO + 2097152;
constexpr size_t OFF_T = OFF_H + S1024;
constexpr size_t OFF_A = OFF_T;
constexpr size_t OFF_HF = OFF_T + S1024;
constexpr size_t OFF_QK = OFF_HF;
constexpr size_t OFF_V = OFF_QK + S512;
constexpr size_t OFF_GR = OFF_V + S512;
constexpr size_t OFF_PR = OFF_GR + S512;
constexpr size_t OFF_GB = OFF_PR + (size_t)M_TOK * 1792 * 2;
constexpr size_t OFF_Y = OFF_GB + S1024;
constexpr size_t OFF_END = OFF_Y + S512;
constexpr size_t OFF_MG = OFF_QK;
constexpr size_t OFF_BAR = OFF_END;
constexpr size_t OFF_W2T = OFF_BAR + 16384, OFF_A2T = OFF_W2T + 65536, OFF_G2T = OFF_A2T + 65536;
constexpr size_t WS_NEED = OFF_G2T + 131072;
constexpr size_t OFF_H3 = OFF_HF + (size_t)M_TOK * 2816 * 2;
constexpr size_t OFF_LD = OFF_A, OFF_AA = OFF_A + S512;
static_assert(OFF_H3 + (size_t)M_TOK * 1024 * 4 == OFF_END, "map");
constexpr size_t OO_GA = 0, OO_GG = S1024, OO_RHO = S1024 + S512;
constexpr size_t O_YP = 0, O_YS = 16777216, O_RETP = 17301504, O_WKVP = 17563648, O_SHP = 17825792, O_RETS = 17840128, O_WKVS = 22034432, O_SHS = 26228736;

struct Params {
  const float *x_prompt, *x_sample, *state_ret, *state_wkv, *state_shift, *meta;
  const float *ffn1_norm, *ffn1_wg, *ffn1_wu, *ffn1_wd, *mix_norm, *w_in, *ret_gn_g, *mu, *w0, *w2, *a0, *a2, *g2, *k_k, *k_a, *r_k, *lnx_g, *lnx_b;
  const float *w_out_ret, *w_out_rwkv, *w_out, *ffn2_norm, *ffn2_wg, *ffn2_wu, *ffn2_wd, *final_norm;
  float* out;
  unsigned char* ws;
  float invf[32];
  float lg2g[4];
  int phase_lo, phase_hi;
};


#define XB_TMO      128
#define XB_XCNT(j)  (256  + 64 * (j))
#define XB_XSUB(j)  (1280 + 64 * (j))
#define XB_XGEN(j)  (2304 + 64 * (j))
#define XB_TOP      3328
#define XB_TOPGEN   3392
#define XCD_BAR_WORDS 3456
#define XB_SPIN_CAP (1u << 18)
#define LAS __attribute__((address_space(3)))
__device__ __forceinline__ unsigned xb_ld(unsigned* p)              { return __hip_atomic_load(p, __ATOMIC_RELAXED, __HIP_MEMORY_SCOPE_AGENT); }
__device__ __forceinline__ unsigned xb_add(unsigned* p, unsigned v) { return __hip_atomic_fetch_add(p, v, __ATOMIC_RELAXED, __HIP_MEMORY_SCOPE_AGENT); }
__device__ __forceinline__ unsigned xb_xcc_id() { return (unsigned)__builtin_amdgcn_s_getreg((3 << 11) | 20) & 0xFu; }
#define XB_SPIN(cond, bar) do { unsigned _sp = 0; while (cond) { __builtin_amdgcn_s_sleep(1); \
    if ((++_sp & 255u) == 0u) { if (xb_ld(&(bar)[XB_TMO])) break; if (_sp > XB_SPIN_CAP) { atomicAdd(&(bar)[XB_TMO], 1u); break; } } } } while (0)
struct XcdBarrier { unsigned* bar; unsigned x; volatile LAS unsigned* st; };
__device__ __forceinline__ XcdBarrier xcd_barrier_post(unsigned* bar, volatile LAS unsigned* st) {
    XcdBarrier b; b.bar = bar; b.x = xb_xcc_id(); b.st = st;
    if (threadIdx.x == 0) (void)xb_add(&bar[XB_XCNT(b.x)], 1u);
    return b;
}
__device__ __forceinline__ void xcd_barrier_complete(unsigned* bar, unsigned x, unsigned& nloc, unsigned& nx) {
    const unsigned G = gridDim.x * gridDim.y * gridDim.z;
    unsigned sum, cnt, mine, sp = 0u;
    for (;;) {
        sum = 0u; cnt = 0u; mine = 0u;
#pragma unroll
        for (unsigned j = 0; j < 16; ++j) { const unsigned c = xb_ld(&bar[XB_XCNT(j)]); sum += c; cnt += (c > 0u) ? 1u : 0u; mine = (j == x) ? c : mine; }
        if (sum == G) break;
        __builtin_amdgcn_s_sleep(1);
        if ((++sp & 255u) == 0u) { if (xb_ld(&bar[XB_TMO])) break; if (sp > XB_SPIN_CAP) { atomicAdd(&bar[XB_TMO], 1u); break; } }
    }
    nloc = mine > 0u ? mine : 1u; nx = cnt > 0u ? cnt : 1u;
}
__device__ __forceinline__ void xcd_barrier(const XcdBarrier& b) {
    asm volatile("s_waitcnt vmcnt(0)" ::: "memory");
    __syncthreads();
    if (threadIdx.x == 0) {
        unsigned* bar = b.bar;
        __builtin_amdgcn_s_waitcnt(0);
        unsigned nloc = b.st[0], nx = b.st[1];
        if (nloc == 0u) { xcd_barrier_complete(bar, b.x, nloc, nx); b.st[0] = nloc; b.st[1] = nx; }
        const unsigned old = xb_add(&bar[XB_XSUB(b.x)], 1u);
        const unsigned gen = old / nloc;
        if (old + 1u == (gen + 1u) * nloc) {
            __builtin_amdgcn_fence(__ATOMIC_RELEASE, "agent");
            asm volatile("s_waitcnt vmcnt(0)" ::: "memory");
            const unsigned og = xb_add(&bar[XB_TOP], 1u);
            const unsigned tg = og / nx;
            if (og + 1u == (tg + 1u) * nx) xb_add(&bar[XB_TOPGEN], 1u);
            else XB_SPIN(xb_ld(&bar[XB_TOPGEN]) == tg, bar);
            __builtin_amdgcn_fence(__ATOMIC_ACQUIRE, "agent");
            xb_add(&bar[XB_XGEN(b.x)], 1u);
            asm volatile("s_waitcnt vmcnt(0)" ::: "memory");
        } else {
            XB_SPIN(xb_ld(&bar[XB_XGEN(b.x)]) == gen, bar);
            __builtin_amdgcn_fence(__ATOMIC_ACQUIRE, "agent");
            asm volatile("s_waitcnt vmcnt(0)" ::: "memory");
        }
    }
    __syncthreads();
}

__device__ __forceinline__ float bf2f(unsigned h) { return __uint_as_float(h << 16); }
__device__ __forceinline__ unsigned f2bf(float f) { unsigned u = __float_as_uint(f); return (u + 0x7fffu + ((u >> 16) & 1u)) >> 16; }
__device__ __forceinline__ unsigned pk2(float a, float b) { return f2bf(a) | (f2bf(b) << 16); }
__device__ __forceinline__ uint2 pk4(float a, float b, float c, float d) { uint2 r; r.x = pk2(a, b); r.y = pk2(c, d); return r; }
__device__ __forceinline__ void unpk4(uint2 u, float (&o)[4]) { o[0] = __uint_as_float(u.x << 16); o[1] = __uint_as_float(u.x & 0xffff0000u); o[2] = __uint_as_float(u.y << 16); o[3] = __uint_as_float(u.y & 0xffff0000u); }
template <int CTRL> __device__ __forceinline__ float dppf(float x) { return __builtin_bit_cast(float, __builtin_amdgcn_update_dpp(0, __builtin_bit_cast(int, x), CTRL, 0xf, 0xf, true)); }
__device__ __forceinline__ float rowsum16(float x) { x += dppf<0xB1>(x); x += dppf<0x4E>(x); x += dppf<0x141>(x); x += dppf<0x140>(x); return x; }
__device__ __forceinline__ float wavesum(float x) {
#pragma unroll
  for (int o = 32; o >= 1; o >>= 1) x += __shfl_xor(x, o);
  return x;
}
__device__ __forceinline__ float sigmoidf(float x) { return 1.f / (1.f + __expf(-x)); }
__device__ __forceinline__ float siluf(float x) { return x / (1.f + __expf(-x)); }

__device__ __forceinline__ const float* x_row(const Params& p, int row) {
  if (row < MP) { const int b = row / TP, t = row - b * TP; return t < 16 ? p.meta + t * 1024 : p.x_prompt + (size_t)(b * 2048 + t - 16) * 1024; }
  return p.x_sample + (size_t)(row - MP) * 1024;
}

__device__ __forceinline__ void transpose_tile(const float* __restrict__ src, int K, int N, bf16_t* __restrict__ dst, int rs, int ro, int t, unsigned char* lds) {
  float* tile = (float*)lds;
  const int tid = threadIdx.x;
  const int tn = N / 64;
  const int k0 = (t / tn) * 64, n0 = (t % tn) * 64;
  __syncthreads();
  { const int n = tid & 63, kq = tid >> 6;
#pragma unroll
    for (int i = 0; i < 16; ++i) { const int k = kq + 4 * i; tile[k * 65 + n] = src[(size_t)(k0 + k) * N + n0 + n]; } }
  __syncthreads();
  { const int kp = tid & 31, nq = tid >> 5;
#pragma unroll
    for (int i = 0; i < 8; ++i) { const int n = nq + 8 * i; const float v0 = tile[(2 * kp) * 65 + n], v1 = tile[(2 * kp + 1) * 65 + n];
      *(unsigned*)(dst + (size_t)((n0 + n) * rs + ro) * K + k0 + 2 * kp) = pk2(v0, v1); } }
}
__device__ __forceinline__ void transpose_tiles(const float* __restrict__ src, int K, int N, bf16_t* __restrict__ dst, int rs, int ro, unsigned char* lds, int bi, int nb) {
  const int nt = (K / 64) * (N / 64);
#pragma unroll 1
  for (int t = bi; t < nt; t += nb) transpose_tile(src, K, N, dst, rs, ro, t, lds);
}

template <int SRC, int DST> __device__ __forceinline__ void rmsnorm_phase(const Params& p, const float* __restrict__ g, bf16_t* dstb) {
  const int lane = threadIdx.x & 63, wid = threadIdx.x >> 6;
  const bf16_t* H = (const bf16_t*)(p.ws + OFF_H);
  const float* H3 = (const float*)(p.ws + OFF_H3);
  for (int row = blockIdx.x * 4 + wid; row < M_TOK; row += gridDim.x * 4) {
    float v[16];
    const float* xr = SRC == 0 ? x_row(p, row) : nullptr;
#pragma unroll
    for (int i = 0; i < 4; ++i) {
      const int col = i * 256 + lane * 4;
      if (SRC == 0) { const float4 t = *(const float4*)(xr + col); v[4 * i] = t.x; v[4 * i + 1] = t.y; v[4 * i + 2] = t.z; v[4 * i + 3] = t.w; }
      else if (SRC == 1) { const uint2 u = *(const uint2*)(H + (size_t)row * 1024 + col); float o[4]; unpk4(u, o); v[4 * i] = o[0]; v[4 * i + 1] = o[1]; v[4 * i + 2] = o[2]; v[4 * i + 3] = o[3]; }
      else { const float4 t = *(const float4*)(H3 + (size_t)row * 1024 + col); v[4 * i] = t.x; v[4 * i + 1] = t.y; v[4 * i + 2] = t.z; v[4 * i + 3] = t.w; }
    }
    float ss = 0.f;
#pragma unroll
    for (int i = 0; i < 16; ++i) ss += v[i] * v[i];
    ss = wavesum(ss);
    const float rstd = rsqrtf(ss * (1.f / 1024.f) + 1e-6f);
    float* orow = nullptr;
    if (DST == 1) {
      if (row < MP) { const int b = row / TP, t = row - b * TP; if (t >= 16) orow = p.out + O_YP + (size_t)(b * 2048 + t - 16) * 1024; }
      else orow = p.out + O_YS + (size_t)(row - MP) * 1024;
    }
#pragma unroll
    for (int i = 0; i < 4; ++i) {
      const int col = i * 256 + lane * 4;
      const float4 gv = *(const float4*)(g + col);
      const float y0 = v[4 * i] * rstd * gv.x, y1 = v[4 * i + 1] * rstd * gv.y, y2 = v[4 * i + 2] * rstd * gv.z, y3 = v[4 * i + 3] * rstd * gv.w;
      if (DST == 0) *(uint2*)(dstb + (size_t)row * 1024 + col) = pk4(y0, y1, y2, y3);
      else if (orow) *(float4*)(orow + col) = make_float4(y0, y1, y2, y3);
    }
  }
}

#define RAW_BARRIER() do { asm volatile("s_waitcnt lgkmcnt(0)" ::: "memory"); __builtin_amdgcn_s_barrier(); asm volatile("" ::: "memory"); } while (0)
template <int MI> __device__ __forceinline__ void gemm_tile_dma(const bf16_t* __restrict__ A, int lda, const bf16_t* __restrict__ Bt, int ldb, int K, int m0, int n0, f32x4 (&acc)[MI][4], unsigned char* lds) {
  constexpr int BMT = 32 * MI, NA = 2 * MI, NAW = (NA + 3) / 4, STG = (BMT + 128) * 64;
  static_assert(3 * STG <= LDS_BYTES, "ring does not fit");
  const int tid = threadIdx.x, lane = tid & 63, wid = tid >> 6, wm = wid >> 1, wn = wid & 1, l15 = lane & 15, l4 = lane >> 4;
  const int nk = K >> 5;
  const int qd = (lane >> 4) & 3, cs = ((lane & 3) ^ (((qd << 1) ^ ((qd >> 1) * 3)) & 3)) * 8;
  const bf16_t* ag[NAW]; const bf16_t* bg[2];
#pragma unroll
  for (int i = 0; i < NAW; ++i) { int row = m0 + (wid + 4 * i) * 16 + (lane >> 2); row = row < M_TOK ? row : M_TOK - 1; ag[i] = A + (size_t)row * lda + cs; }
#pragma unroll
  for (int i = 0; i < 2; ++i) { const int row = n0 + (wid * 2 + i) * 16 + (lane >> 2); bg[i] = Bt + (size_t)row * ldb + cs; }
  auto issue = [&](int kt, int buf) {
    unsigned char* sb = lds + buf * STG + lane * 16;
#pragma unroll
    for (int i = 0; i < NAW; ++i) if (wid + 4 * i < NA) __builtin_amdgcn_global_load_lds((const unsigned*)(ag[i] + kt * 32), (LAS unsigned*)(sb + (wid + 4 * i) * 1024), 16, 0, 0);
#pragma unroll
    for (int i = 0; i < 2; ++i) __builtin_amdgcn_global_load_lds((const unsigned*)(bg[i] + kt * 32), (LAS unsigned*)(sb + BMT * 64 + (wid * 2 + i) * 1024), 16, 0, 0);
  };
  const int qr = (l15 >> 2) & 3, sw = ((l4 ^ ((qr << 1) ^ ((qr >> 1) * 3))) & 3) * 16;
  const int aofs = (wm * 16 * MI + l15) * 64 + sw, bofs = BMT * 64 + (wn * 64 + l15) * 64 + sw;
  const bool big = (NA % 4 == 0) || (wid < NA % 4);
  RAW_BARRIER();
  issue(0, 0);
  if (nk > 1) issue(1, 1);
  int bc = 0, bi = 2;
  for (int kt = 0; kt < nk; ++kt) {
    if (kt + 1 < nk) {
      if (MI == 8) asm volatile("s_waitcnt vmcnt(6)" ::: "memory");
      else if (big) asm volatile("s_waitcnt vmcnt(5)" ::: "memory");
      else asm volatile("s_waitcnt vmcnt(4)" ::: "memory");
    } else asm volatile("s_waitcnt vmcnt(0)" ::: "memory");
    RAW_BARRIER();
    if (kt + 2 < nk) issue(kt + 2, bi);
    const unsigned char* st = lds + bc * STG;
    bf16x8 af[MI], bfr[4];
#pragma unroll
    for (int i = 0; i < MI; ++i) af[i] = *(const bf16x8*)(st + aofs + i * 1024);
#pragma unroll
    for (int i = 0; i < 4; ++i) bfr[i] = *(const bf16x8*)(st + bofs + i * 1024);
    __builtin_amdgcn_s_setprio(1);
#pragma unroll
    for (int mi = 0; mi < MI; ++mi)
#pragma unroll
      for (int ni = 0; ni < 4; ++ni) acc[mi][ni] = __builtin_amdgcn_mfma_f32_16x16x32_bf16(bfr[ni], af[mi], acc[mi][ni], 0, 0, 0);
    __builtin_amdgcn_s_setprio(0);
    bc = bc == 2 ? 0 : bc + 1; bi = bi == 2 ? 0 : bi + 1;
  }
}

#ifndef GMT
#define GMT 4
#endif
__device__ __forceinline__ void tile_coords(int L, int nM, int nN, int& tm, int& tn) {
  const int nwg = nM * nN, q = nwg / 8, r = nwg % 8, xcd = L % 8, off = L / 8;
  const int wg = (xcd < r ? xcd * (q + 1) : r * (q + 1) + (xcd - r) * q) + off;
  const int nig = GMT * nN, gid = wg / nig, fm = gid * GMT, gsz = min(nM - fm, GMT);
  tm = fm + (wg % nig) % gsz; tn = (wg % nig) / gsz;
}

#define ZERO_ACC(a) _Pragma("unroll") for (int _i = 0; _i < 4; ++_i) _Pragma("unroll") for (int _j = 0; _j < 4; ++_j) a[_i][_j] = (f32x4){0.f, 0.f, 0.f, 0.f}
#define ZERO_ACC8(a) _Pragma("unroll") for (int _i = 0; _i < 8; ++_i) _Pragma("unroll") for (int _j = 0; _j < 4; ++_j) a[_i][_j] = (f32x4){0.f, 0.f, 0.f, 0.f}
#define EPI_VARS8 const int lane = threadIdx.x & 63, wid = threadIdx.x >> 6, wm = wid >> 1, wn = wid & 1; const int rbase = tm * 256 + wm * 128 + (lane & 15), cbase = tn * 128 + wn * 64 + (lane >> 4) * 4
#define NMT 67
#define NMT5 107
#define ZERO_ACC5(a) _Pragma("unroll") for (int _i = 0; _i < 5; ++_i) _Pragma("unroll") for (int _j = 0; _j < 4; ++_j) a[_i][_j] = (f32x4){0.f, 0.f, 0.f, 0.f}
#define EPI_VARS5 const int lane = threadIdx.x & 63, wid = threadIdx.x >> 6, wm = wid >> 1, wn = wid & 1; const int rbase = tm * 160 + wm * 80 + (lane & 15), cbase = tn * 128 + wn * 64 + (lane >> 4) * 4
#define EPI_VARS const int lane = threadIdx.x & 63, wid = threadIdx.x >> 6, wm = wid >> 1, wn = wid & 1; const int rbase = tm * 128 + wm * 64 + (lane & 15), cbase = tn * 128 + wn * 64 + (lane >> 4) * 4

__device__ __forceinline__ void transpose_jobs(const Params& p, int jlo, int jhi, unsigned char* lds, int bi, int nb) {
  unsigned char* ws = p.ws;
#pragma unroll 1
  for (int j = jlo; j < jhi; ++j) {
    const float* src; int K, N, rs = 1, ro = 0; size_t off;
    switch (j) {
      case 0: src = p.ffn1_wg; K = 1024; N = 2816; off = OFF_W1GU; rs = 2; break;
      case 1: src = p.ffn1_wu; K = 1024; N = 2816; off = OFF_W1GU; rs = 2; ro = 1; break;
      case 2: src = p.ffn1_wd; K = 2816; N = 1024; off = OFF_W1D; break;
      case 3: src = p.w_in; K = 1024; N = 5376; off = OFF_WIN; break;
      case 4: src = p.w_out_ret; K = 512; N = 1024; off = OFF_WR; break;
      case 5: src = p.w_out_rwkv; K = 512; N = 1024; off = OFF_WW; break;
      case 6: src = p.w_out; K = 1024; N = 1024; off = OFF_WO; break;
      case 7: src = p.ffn2_wg; K = 1024; N = 2816; off = OFF_W1GU; rs = 2; break;
      case 8: src = p.ffn2_wu; K = 1024; N = 2816; off = OFF_W1GU; rs = 2; ro = 1; break;
      case 9: src = p.ffn2_wd; K = 2816; N = 1024; off = OFF_W1D; break;
      case 10: src = p.w2; K = 64; N = 512; off = OFF_W2T; break;
      case 11: src = p.a2; K = 64; N = 512; off = OFF_A2T; break;
      default: src = p.g2; K = 128; N = 512; off = OFF_G2T; break;
    }
    transpose_tiles(src, K, N, (bf16_t*)(ws + off), rs, ro, lds, bi, nb);
  }
}
__device__ __forceinline__ void phase0(const Params& p, unsigned char* lds) {
  transpose_jobs(p, 0, 2, lds, blockIdx.x, gridDim.x);
  transpose_jobs(p, 10, 13, lds, blockIdx.x, gridDim.x);
  rmsnorm_phase<0, 0>(p, p.ffn1_norm, (bf16_t*)(p.ws + OFF_A));
}

template <bool TAILFILL> __device__ __forceinline__ void phase_ffn_up(const Params& p, unsigned char* lds) {
  const bf16_t* A = (const bf16_t*)(p.ws + OFF_A); const bf16_t* W = (const bf16_t*)(p.ws + OFF_W1GU); bf16_t* HF = (bf16_t*)(p.ws + OFF_HF);
  const int nM = NMT, nN = 5632 / 128;
  const int nt_all = nM * nN, Gs = gridDim.x, nfull = nt_all / Gs, remt = nt_all - nfull * Gs;
  const bool slotdeal = Gs == 512 && remt > 0;
  const int nmine = slotdeal ? nfull + (blockIdx.x < 256 ? ((int)blockIdx.x < remt ? 1 : 0) + ((int)blockIdx.x + 256 < remt ? 1 : 0) : 0)
                             : nfull + ((int)blockIdx.x < remt ? 1 : 0);
  for (int it = 0; it < nmine; ++it) {
    int L = (int)blockIdx.x + it * Gs;
    if (slotdeal && it >= nfull) L = nfull * Gs + (int)blockIdx.x + (it - nfull) * 256 - (((int)blockIdx.x < remt) ? 0 : 256);
    int tm, tn; tile_coords(L, nM, nN, tm, tn);
    f32x4 acc[8][4]; ZERO_ACC8(acc);
    gemm_tile_dma<8>(A, 1024, W, 1024, 1024, tm * 256, tn * 128, acc, lds);
    EPI_VARS8;
#pragma unroll
    for (int mi = 0; mi < 8; ++mi) {
      const int row = rbase + mi * 16;
      if (row < M_TOK) {
#pragma unroll
        for (int ni = 0; ni < 4; ++ni) {
          const int c = (cbase + ni * 16) >> 1; const f32x4 a = acc[mi][ni];
          *(unsigned*)(HF + (size_t)row * 2816 + c) = pk2(siluf(a[0]) * a[1], siluf(a[2]) * a[3]);
        }
      }
    }
  }
  if (TAILFILL) {
    int bi = blockIdx.x, nb = gridDim.x;
    if (slotdeal && remt > 256 && remt < 512) { const int lo2 = remt - 256; bi = (blockIdx.x >= (unsigned)lo2 && blockIdx.x < 256) ? (int)blockIdx.x - lo2 : -1; nb = 256 - lo2; }
    if (bi >= 0) transpose_jobs(p, 2, 7, lds, bi, nb);
  }
}

template <bool FIRST> __device__ __forceinline__ void phase_ffn_down(const Params& p, unsigned char* lds) {
  const bf16_t* A = (const bf16_t*)(p.ws + OFF_HF); const bf16_t* W = (const bf16_t*)(p.ws + OFF_W1D);
  bf16_t* H = (bf16_t*)(p.ws + OFF_H); float* H3 = (float*)(p.ws + OFF_H3);
  const int nM = NMT5, nN = 8;
  for (int L = blockIdx.x; L < nM * nN; L += gridDim.x) {
    int tm, tn; tile_coords(L, nM, nN, tm, tn);
    f32x4 acc[5][4]; ZERO_ACC5(acc);
    gemm_tile_dma<5>(A, 2816, W, 2816, 2816, tm * 160, tn * 128, acc, lds);
    EPI_VARS5;
#pragma unroll
    for (int mi = 0; mi < 5; ++mi) {
      const int row = rbase + mi * 16;
      if (row < M_TOK) {
        const float* xr = FIRST ? x_row(p, row) : nullptr;
#pragma unroll
        for (int ni = 0; ni < 4; ++ni) {
          const int col = cbase + ni * 16; const f32x4 a = acc[mi][ni];
          if (FIRST) { const float4 xv = *(const float4*)(xr + col);
            *(uint2*)(H + (size_t)row * 1024 + col) = pk4(xv.x + 0.5f * a[0], xv.y + 0.5f * a[1], xv.z + 0.5f * a[2], xv.w + 0.5f * a[3]); }
          else { float h[4]; unpk4(*(const uint2*)(H + (size_t)row * 1024 + col), h);
            *(float4*)(H3 + (size_t)row * 1024 + col) = make_float4(h[0] + 0.5f * a[0], h[1] + 0.5f * a[1], h[2] + 0.5f * a[2], h[3] + 0.5f * a[3]); }
        }
      }
    }
  }
}

__device__ __forceinline__ void rope_cs(float ang, float& c, float& s) {
  double rev = (double)ang * 0.15915494309189535; rev -= rint(rev); const float fr = (float)rev;
  s = __builtin_amdgcn_sinf(fr); c = __builtin_amdgcn_cosf(fr);
}
__device__ __forceinline__ void phase_win(const Params& p, unsigned char* lds) {
  const bf16_t* A = (const bf16_t*)(p.ws + OFF_A); const bf16_t* W = (const bf16_t*)(p.ws + OFF_WIN);
  bf16_t* QK = (bf16_t*)(p.ws + OFF_QK); bf16_t* V = (bf16_t*)(p.ws + OFF_V); bf16_t* GR = (bf16_t*)(p.ws + OFF_GR); bf16_t* PR = (bf16_t*)(p.ws + OFF_PR);
  bf16_t* GB = (bf16_t*)(p.ws + OFF_GB); bf16_t* GA = (bf16_t*)((unsigned char*)p.out + OO_GA);
  const int nM = NMT, nN = 5376 / 128;
  for (int L = blockIdx.x; L < nM * nN; L += gridDim.x) {
    int tm, tn; tile_coords(L, nM, nN, tm, tn);
    f32x4 acc[8][4]; ZERO_ACC8(acc);
    gemm_tile_dma<8>(A, 1024, W, 1024, 1024, tm * 256, tn * 128, acc, lds);
    EPI_VARS8;
    const int n0 = tn * 128;
    if (n0 < 512) {
      const float sc = n0 >= 256 ? 0.125f : 1.0f;
      const int hb = n0 + wn * 64;
#pragma unroll
      for (int mi = 0; mi < 8; ++mi) {
        const int row = rbase + mi * 16;
        if (row >= M_TOK) continue;
        const float pos = row < MP ? (float)(row % TP) : (float)(PAST + ((row - MP) & 3));
#pragma unroll
        for (int ni = 0; ni < 2; ++ni) {
          float o1[4], o2[4];
#pragma unroll
          for (int jj = 0; jj < 4; ++jj) {
            const int j = ni * 16 + (lane >> 4) * 4 + jj;
            float c, s; rope_cs(pos * p.invf[j], c, s);
            const float x1 = acc[mi][ni][jj], x2 = acc[mi][ni + 2][jj];
            o1[jj] = (x1 * c - x2 * s) * sc; o2[jj] = (x1 * s + x2 * c) * sc;
          }
          const int j0 = ni * 16 + (lane >> 4) * 4;
          *(uint2*)(QK + (size_t)row * 512 + hb + j0) = pk4(o1[0], o1[1], o1[2], o1[3]);
          *(uint2*)(QK + (size_t)row * 512 + hb + 32 + j0) = pk4(o2[0], o2[1], o2[2], o2[3]);
        }
      }
    } else {
#pragma unroll
      for (int mi = 0; mi < 8; ++mi) {
        const int row = rbase + mi * 16;
        if (row >= M_TOK) continue;
        float* sh = nullptr;
        if (row < MP) { const int b = row / TP; if (row - b * TP == TP - 1) sh = p.out + O_SHP + (size_t)b * 1792; }
        else { const int r2 = row - MP; if ((r2 & 3) == 3) sh = p.out + O_SHS + (size_t)(r2 >> 2) * 1792; }
#pragma unroll
        for (int ni = 0; ni < 4; ++ni) {
          const int col = cbase + ni * 16; const f32x4 a = acc[mi][ni];
          if (n0 < 1024) *(uint2*)(V + (size_t)row * 512 + (col - 512)) = pk4(a[0], a[1], a[2], a[3]);
          else if (n0 < 1536) *(uint2*)(GR + (size_t)row * 512 + (col - 1024)) = pk4(siluf(a[0]), siluf(a[1]), siluf(a[2]), siluf(a[3]));
          else if (n0 < 3328) { *(uint2*)(PR + (size_t)row * 1792 + (col - 1536)) = pk4(a[0], a[1], a[2], a[3]);
            if (sh) *(float4*)(sh + (col - 1536)) = make_float4(a[0], a[1], a[2], a[3]); }
          else if (n0 < 4352) *(uint2*)(GA + (size_t)row * 1024 + (col - 3328)) = pk4(sigmoidf(a[0]), sigmoidf(a[1]), sigmoidf(a[2]), sigmoidf(a[3]));
          else *(uint2*)(GB + (size_t)row * 1024 + (col - 4352)) = pk4(sigmoidf(a[0]), sigmoidf(a[1]), sigmoidf(a[2]), sigmoidf(a[3]));
        }
      }
    }
  }
}

__device__ __forceinline__ void phase_lora(const Params& p, unsigned char* lds) {
  float* sS = (float*)lds;
  const int tid = threadIdx.x;
  const bf16_t* PR = (const bf16_t*)(p.ws + OFF_PR);
  bf16_t* LD = (bf16_t*)(p.ws + OFF_LD); bf16_t* AA = (bf16_t*)(p.ws + OFF_AA); bf16_t* GG = (bf16_t*)((unsigned char*)p.out + OO_GG);
  const float mu_j = p.mu[1536 + tid];
  for (int tile = blockIdx.x; tile < M_TOK / 16; tile += gridDim.x) {
    const int row0 = tile * 16;
    __syncthreads();
#pragma unroll 4
    for (int tt = 0; tt < 16; ++tt) {
      const int row = row0 + tt;
      const float pc = bf2f(PR[(size_t)row * 1792 + 1536 + tid]);
      float pp;
      if (row < MP) { const int t = row % TP; pp = t == 0 ? 0.f : bf2f(PR[(size_t)(row - 1) * 1792 + 1536 + tid]); }
      else { const int r2 = row - MP; pp = (r2 & 3) == 0 ? p.state_shift[(size_t)(r2 >> 2) * 1792 + 1536 + tid] : bf2f(PR[(size_t)(row - 1) * 1792 + 1536 + tid]); }
      const float pm = pc + (pp - pc) * mu_j;
      sS[tt * 256 + tid] = tid < 64 ? tanhf(pm) : (tid < 128 ? pm : sigmoidf(pm));
    }
    __syncthreads();
#pragma unroll 1
    for (int which = 0; which < 3; ++which) {
      const float* Wm = which == 0 ? p.w2 : (which == 1 ? p.a2 : p.g2);
      const int jb = which == 0 ? 0 : (which == 1 ? 64 : 128), nj = which == 2 ? 128 : 64;
      float acc0[16], acc1[16];
#pragma unroll
      for (int tt = 0; tt < 16; ++tt) { acc0[tt] = 0.f; acc1[tt] = 0.f; }
      for (int j = 0; j < nj; j += 4) {
        float wa[4], wb[4];
#pragma unroll
        for (int e = 0; e < 4; ++e) { wa[e] = Wm[(size_t)(j + e) * 512 + tid]; wb[e] = Wm[(size_t)(j + e) * 512 + tid + 256]; }
#pragma unroll
        for (int tt = 0; tt < 16; ++tt) {
          const float4 s4 = *(const float4*)(sS + tt * 256 + jb + j);
          acc0[tt] += s4.x * wa[0] + s4.y * wa[1] + s4.z * wa[2] + s4.w * wa[3];
          acc1[tt] += s4.x * wb[0] + s4.y * wb[1] + s4.z * wb[2] + s4.w * wb[3];
        }
      }
      if (which == 0) {
        const float b0 = p.w0[tid], b1 = p.w0[tid + 256];
#pragma unroll
        for (int tt = 0; tt < 16; ++tt) {
          const float x0 = -(b0 + acc0[tt]), x1 = -(b1 + acc1[tt]);
          const float sp0 = fmaxf(x0, 0.f) + log1pf(expf(-fabsf(x0))), sp1 = fmaxf(x1, 0.f) + log1pf(expf(-fabsf(x1)));
          LD[(size_t)(row0 + tt) * 512 + tid] = (bf16_t)f2bf(-expf(-sp0 - 0.5f));
          LD[(size_t)(row0 + tt) * 512 + tid + 256] = (bf16_t)f2bf(-expf(-sp1 - 0.5f));
        }
      } else if (which == 1) {
        const float b0 = p.a0[tid], b1 = p.a0[tid + 256];
#pragma unroll
        for (int tt = 0; tt < 16; ++tt) {
          AA[(size_t)(row0 + tt) * 512 + tid] = (bf16_t)f2bf(sigmoidf(b0 + acc0[tt]));
          AA[(size_t)(row0 + tt) * 512 + tid + 256] = (bf16_t)f2bf(sigmoidf(b1 + acc1[tt]));
        }
      } else {
#pragma unroll
        for (int tt = 0; tt < 16; ++tt) {
          GG[(size_t)(row0 + tt) * 512 + tid] = (bf16_t)f2bf(acc0[tt]);
          GG[(size_t)(row0 + tt) * 512 + tid + 256] = (bf16_t)f2bf(acc1[tt]);
        }
      }
    }
  }
}


__device__ __forceinline__ void phase_lora_mfma(const Params& p, unsigned char* lds) {
  constexpr int LSTR = 272;
  unsigned char* sA = lds; unsigned char* sB = lds + 128 * LSTR;
  const bf16_t* PR = (const bf16_t*)(p.ws + OFF_PR);
  bf16_t* LD = (bf16_t*)(p.ws + OFF_LD); bf16_t* AA = (bf16_t*)(p.ws + OFF_AA); bf16_t* GG = (bf16_t*)((unsigned char*)p.out + OO_GG);
  for (int grp = blockIdx.x; grp < (M_TOK / 128) * 3; grp += gridDim.x) {
    int tid_o = threadIdx.x; asm volatile("" : "+v"(tid_o));
    const int tid = tid_o, lane = tid & 63, wid = tid >> 6, wm = wid >> 1, wn = wid & 1, l15 = lane & 15, l4 = lane >> 4;
    const int tm = grp / 3, which = grp - tm * 3;
    const int Kc = which == 2 ? 128 : 64, jb = which == 0 ? 0 : (which == 1 ? 64 : 128), cpr = Kc >> 3;
    const bf16_t* Wt = (const bf16_t*)(p.ws + (which == 0 ? OFF_W2T : (which == 1 ? OFF_A2T : OFF_G2T)));
    __syncthreads();
    for (int q = tid; q < 128 * cpr; q += NT) {
      const int r = q / cpr, ck = q - r * cpr, row = tm * 128 + r, col = 1536 + jb + ck * 8;
      const u32x4 cu = *(const u32x4*)(PR + (size_t)row * 1792 + col);
      float pc[8], pp[8];
#pragma unroll
      for (int e = 0; e < 4; ++e) { pc[2 * e] = __uint_as_float(cu[e] << 16); pc[2 * e + 1] = __uint_as_float(cu[e] & 0xffff0000u); }
      bool first; const float* sprev = nullptr;
      if (row < MP) first = (row % TP) == 0; else { const int r2 = row - MP; first = (r2 & 3) == 0; sprev = p.state_shift + (size_t)(r2 >> 2) * 1792 + col; }
      if (!first) { const u32x4 pu = *(const u32x4*)(PR + (size_t)(row - 1) * 1792 + col);
#pragma unroll
        for (int e = 0; e < 4; ++e) { pp[2 * e] = __uint_as_float(pu[e] << 16); pp[2 * e + 1] = __uint_as_float(pu[e] & 0xffff0000u); } }
      else {
#pragma unroll
        for (int e = 0; e < 8; ++e) pp[e] = sprev ? sprev[e] : 0.f;
      }
      float sv[8];
#pragma unroll
      for (int e = 0; e < 8; ++e) {
        const float pm = pc[e] + (pp[e] - pc[e]) * p.mu[col + e];
        float t;
        if (which == 0) { const float ex = __expf(-2.f * fabsf(pm)); t = (1.f - ex) / (1.f + ex); t = pm < 0.f ? -t : t; }
        else if (which == 1) t = pm;
        else t = sigmoidf(pm);
        sv[e] = t;
      }
      u32x4 o; o[0] = pk2(sv[0], sv[1]); o[1] = pk2(sv[2], sv[3]); o[2] = pk2(sv[4], sv[5]); o[3] = pk2(sv[6], sv[7]);
      *(u32x4*)(sA + r * LSTR + ck * 16) = o;
    }
    for (int tn = 0; tn < 4; ++tn) {
      if (tn > 0) __syncthreads();
      for (int q = tid; q < 128 * cpr; q += NT) { const int r = q / cpr, ck = q - r * cpr; *(u32x4*)(sB + r * LSTR + ck * 16) = *(const u32x4*)(Wt + (size_t)(tn * 128 + r) * Kc + ck * 8); }
      __syncthreads();
      f32x4 acc[4][4]; ZERO_ACC(acc);
      for (int kk = 0; kk < (Kc >> 5); ++kk) {
        bf16x8 af[4], bfr[4];
#pragma unroll
        for (int i = 0; i < 4; ++i) { af[i] = *(const bf16x8*)(sA + (wm * 64 + i * 16 + l15) * LSTR + kk * 64 + l4 * 16); bfr[i] = *(const bf16x8*)(sB + (wn * 64 + i * 16 + l15) * LSTR + kk * 64 + l4 * 16); }
#pragma unroll
        for (int mi = 0; mi < 4; ++mi)
#pragma unroll
          for (int ni = 0; ni < 4; ++ni) acc[mi][ni] = __builtin_amdgcn_mfma_f32_16x16x32_bf16(bfr[ni], af[mi], acc[mi][ni], 0, 0, 0);
      }
#pragma unroll
      for (int ni = 0; ni < 4; ++ni) {
        const int col = tn * 128 + wn * 64 + ni * 16 + l4 * 4;
        float bias[4] = {0.f, 0.f, 0.f, 0.f};
        if (which == 0) { const float4 b4 = *(const float4*)(p.w0 + col); bias[0] = b4.x; bias[1] = b4.y; bias[2] = b4.z; bias[3] = b4.w; }
        else if (which == 1) { const float4 b4 = *(const float4*)(p.a0 + col); bias[0] = b4.x; bias[1] = b4.y; bias[2] = b4.z; bias[3] = b4.w; }
#pragma unroll
        for (int mi = 0; mi < 4; ++mi) {
          const int row = tm * 128 + wm * 64 + mi * 16 + l15;
          float o[4];
#pragma unroll
          for (int jj = 0; jj < 4; ++jj) {
            const float a = acc[mi][ni][jj] + bias[jj];
            if (which == 0) o[jj] = -0.87503879f * sigmoidf(a);
            else if (which == 1) o[jj] = sigmoidf(a);
            else o[jj] = a;
          }
          bf16_t* dst = which == 0 ? LD : (which == 1 ? AA : GG);
          *(uint2*)(dst + (size_t)row * 512 + col) = pk4(o[0], o[1], o[2], o[3]);
        }
      }
    }
  }
}

struct StageRegs { uint2 cr, ck, cv, qr, qk, qv, ld, aa; };

__device__ __forceinline__ void rwkv_item(const Params& p, int rowbase, int T, int h, int rb, const float* shift_prev, const float* S_in, float* S_out, unsigned char* lds) {
  float* stage = (float*)lds;
  float* ypart = (float*)(lds + 49152);
  int tid_f = threadIdx.x; asm volatile("" : "+v"(tid_f));
  const int tid = tid_f, lane = tid & 63, wid = tid >> 6;
  const int t_l = tid >> 4, c4 = tid & 15, ch = h * 64 + c4 * 4;
  const int kg = lane & 15, vloc = wid * 4 + (lane >> 4), vrow = rb * 16 + vloc;
  const bf16_t* PR = (const bf16_t*)(p.ws + OFF_PR); const bf16_t* LD = (const bf16_t*)(p.ws + OFF_LD); const bf16_t* AA = (const bf16_t*)(p.ws + OFF_AA);
  bf16_t* Y = (bf16_t*)(p.ws + OFF_Y); float* RHO = (float*)((unsigned char*)p.out + OO_RHO);
  float mur[4], muk[4], muv[4], kkc[4], kac[4], rkc[4];
#pragma unroll
  for (int e = 0; e < 4; ++e) { mur[e] = p.mu[ch + e]; muk[e] = p.mu[512 + ch + e]; muv[e] = p.mu[1024 + ch + e]; kkc[e] = p.k_k[ch + e]; kac[e] = p.k_a[ch + e]; rkc[e] = p.r_k[ch + e]; }
  f32x4 S;
  if (S_in) S = *(const f32x4*)(S_in + (size_t)vrow * 64 + kg * 4); else S = (f32x4){0.f, 0.f, 0.f, 0.f};
  f32x2 Sa = S.xy, Sb = S.zw;

  float rho_keep = 0.f; unsigned y_keep = 0u;
  auto load = [&](int t0, StageRegs& r) {
    int t = t0 + t_l; if (t > T - 1) t = T - 1;
    const bf16_t* cur = PR + (size_t)(rowbase + t) * 1792 + ch;
    r.cr = *(const uint2*)cur; r.ck = *(const uint2*)(cur + 512); r.cv = *(const uint2*)(cur + 1024);
    { const bf16_t* pv = t > 0 ? cur - 1792 : cur; r.qr = *(const uint2*)pv; r.qk = *(const uint2*)(pv + 512); r.qv = *(const uint2*)(pv + 1024); }
    r.ld = *(const uint2*)(LD + (size_t)(rowbase + t) * 512 + ch); r.aa = *(const uint2*)(AA + (size_t)(rowbase + t) * 512 + ch);
  };
  auto process = [&](int t0, const StageRegs& r, int buf, bool first) {
    float cr[4], ck[4], cv[4], qr[4], qk[4], qv[4], ld[4], aa[4];
    unpk4(r.cr, cr); unpk4(r.ck, ck); unpk4(r.cv, cv); unpk4(r.qr, qr); unpk4(r.qk, qk); unpk4(r.qv, qv); unpk4(r.ld, ld); unpk4(r.aa, aa);
    const int t = t0 + t_l;
    if (first && t == 0) {
#pragma unroll
      for (int e = 0; e < 4; ++e) { qr[e] = 0.f; qk[e] = 0.f; qv[e] = 0.f; }
    }
    if (first && t == 0 && shift_prev) {
#pragma unroll
      for (int e = 0; e < 4; ++e) { qr[e] = shift_prev[ch + e]; qk[e] = shift_prev[512 + ch + e]; qv[e] = shift_prev[1024 + ch + e]; }
    }
    float rr[4], k[4], v[4], kk[4], kp[4], bb[4], w[4];
    float ss = 0.f, rho = 0.f;
#pragma unroll
    for (int e = 0; e < 4; ++e) {
      rr[e] = cr[e] + (qr[e] - cr[e]) * mur[e]; k[e] = ck[e] + (qk[e] - ck[e]) * muk[e]; v[e] = cv[e] + (qv[e] - cv[e]) * muv[e];
      kk[e] = k[e] * kkc[e]; ss += kk[e] * kk[e];
      kp[e] = k[e] * (1.f + (aa[e] - 1.f) * kac[e]);
      rho += rr[e] * kp[e] * rkc[e];
      w[e] = __builtin_amdgcn_exp2f(ld[e]);
    }
    ss = rowsum16(ss); rho = rowsum16(rho);
    const float inv = rsqrtf(fmaxf(ss, 1e-24f));
#pragma unroll
    for (int e = 0; e < 4; ++e) { kk[e] *= inv; bb[e] = kk[e] * aa[e]; }
    float* sp = stage + (size_t)((buf * 16 + t_l) * 6) * 64 + c4 * 4;
    *(float4*)(sp) = make_float4(rr[0], rr[1], rr[2], rr[3]);
    *(float4*)(sp + 64) = make_float4(w[0], w[1], w[2], w[3]);
    *(float4*)(sp + 128) = make_float4(kp[0], kp[1], kp[2], kp[3]);
    *(float4*)(sp + 192) = make_float4(v[0], v[1], v[2], v[3]);
    *(float4*)(sp + 256) = make_float4(-kk[0], -kk[1], -kk[2], -kk[3]);
    *(float4*)(sp + 320) = make_float4(bb[0], bb[1], bb[2], bb[3]);
    rho_keep = rho;
    if (rb == 0 && c4 == 0 && t < T) RHO[(size_t)(rowbase + t) * 8 + h] = rho_keep;
  };

  const int nch = (T + 15) >> 4;
  StageRegs rgA, rgB;
  __syncthreads();
  load(0, rgA); process(0, rgA, 0, true);
  if (nch > 1) load(16, rgB);
  if (nch > 2) load(32, rgA);
  __syncthreads();
  auto chunk_body = [&](int c, StageRegs& rg) {
    const int buf = c & 1, t0 = c * 16;
    const int nsteps = min(16, T - t0);
    const float* st = stage + (size_t)(buf * 16) * 384;
    struct StepOps { f32x4 r[2], w[2], kp[2], nk[2], b[2]; float vv[2]; };
    auto loadg = [&](StepOps& g, int s0) {
#pragma unroll
      for (int u = 0; u < 2; ++u) {
        const float* sp = st + (s0 + u) * 384;
        g.r[u] = *(const f32x4*)(sp + kg * 4); g.w[u] = *(const f32x4*)(sp + 64 + kg * 4); g.kp[u] = *(const f32x4*)(sp + 128 + kg * 4);
        g.nk[u] = *(const f32x4*)(sp + 256 + kg * 4); g.b[u] = *(const f32x4*)(sp + 320 + kg * 4); g.vv[u] = sp[192 + vrow];
      }
    };
    auto compg = [&](const StepOps& g, int s0) {
      float yp[2];
#pragma unroll
      for (int u = 0; u < 2; ++u) {
        f32x2 pa = Sa * g.nk[u].xy; pa = Sb * g.nk[u].zw + pa;
        const float sa = rowsum16(pa.x + pa.y);
        const f32x2 sa2 = {sa, sa}, vv2 = {g.vv[u], g.vv[u]};
        const f32x2 Xa = sa2 * g.b[u].xy + vv2 * g.kp[u].xy, Xb = sa2 * g.b[u].zw + vv2 * g.kp[u].zw;
        Sa = Sa * g.w[u].xy + Xa; Sb = Sb * g.w[u].zw + Xb;
        f32x2 ya = Sa * g.r[u].xy; ya = Sb * g.r[u].zw + ya;
        yp[u] = ya.x + ya.y;
      }
#pragma unroll
      for (int u = 0; u < 2; ++u) ypart[((s0 + u) * 16 + vloc) * 16 + kg] = yp[u];
    };
    {
      StepOps ga, gb, gc;
      loadg(ga, 0); loadg(gb, 2);
      if (4 < nsteps) loadg(gc, 4);
      compg(ga, 0);
      if (6 < nsteps) loadg(ga, 6);
      compg(gb, 2);
      if (nsteps > 4) {
        loadg(gb, 8);  compg(gc, 4);
        loadg(gc, 10); compg(ga, 6);
        loadg(ga, 12); compg(gb, 8);
        loadg(gb, 14); compg(gc, 10);
        compg(ga, 12);
        compg(gb, 14);
      }
    }
    asm volatile("" :: "v"(y_keep), "v"(rho_keep));
    if (c + 1 < nch) process(t0 + 16, rg, buf ^ 1, false);
    if (c + 3 < nch) load(t0 + 48, rg);
    RAW_BARRIER();
    if (t_l < nsteps) {
      const f32x4* yp = (const f32x4*)(ypart + (t_l * 16 + c4) * 16);
      const f32x4 y0 = yp[0], y1 = yp[1], y2 = yp[2], y3 = yp[3];
      const float y = ((y0[0] + y0[1]) + (y0[2] + y0[3])) + ((y1[0] + y1[1]) + (y1[2] + y1[3])) + ((y2[0] + y2[1]) + (y2[2] + y2[3])) + ((y3[0] + y3[1]) + (y3[2] + y3[3]));
      y_keep = f2bf(y);
      Y[(size_t)(rowbase + t0 + t_l) * 512 + h * 64 + rb * 16 + c4] = (bf16_t)y_keep;
    }
    RAW_BARRIER();
  };
  for (int c = 0; c < nch; c += 2) {
    chunk_body(c, rgB);
    if (c + 1 < nch) chunk_body(c + 1, rgA);
  }
  S.xy = Sa; S.zw = Sb;
  *(f32x4*)(S_out + (size_t)vrow * 64 + kg * 4) = S;
}

__device__ __forceinline__ void ret_item(const Params& p, int rowbase, int T, int h, const float* S_in, float* S_out, unsigned char* lds, int cb, int ce, int seg, float* loc, unsigned* flags) {
  unsigned char* sQ = lds; unsigned char* sK = lds + 9216; unsigned char* sKdT = lds + 18432; unsigned char* sVT = lds + 27648; unsigned char* sP = lds + 46080; unsigned char* sST = lds + 55296;
  float* part = (float*)sK;
  int tid_f = threadIdx.x; asm volatile("" : "+v"(tid_f));
  const int tid = tid_f, lane = tid & 63, w = tid >> 6, l15 = lane & 15, l4 = lane >> 4;
  const bf16_t* QK = (const bf16_t*)(p.ws + OFF_QK); const bf16_t* V = (const bf16_t*)(p.ws + OFF_V); bf16_t* GR = (bf16_t*)(p.ws + OFF_GR);
  const float lg2 = p.lg2g[h];
  f32x4 ST[2][4];
#pragma unroll
  for (int vt = 0; vt < 2; ++vt)
#pragma unroll
    for (int dt = 0; dt < 4; ++dt) ST[vt][dt] = (f32x4){0.f, 0.f, 0.f, 0.f};
  u32x4 pq[2], pk[2], pv[4];
  auto prefetch = [&](int t0n, int tidp) {
    const int Ln = min(64, T - t0n);
#pragma unroll
    for (int i = 0; i < 2; ++i) {
      const int q_ = tidp + i * 256, j = q_ & 63, ck = q_ >> 6;
      pq[i] = (u32x4){0u, 0u, 0u, 0u}; pk[i] = pq[i];
      if (j < Ln) { const bf16_t* src = QK + (size_t)(rowbase + t0n + j) * 512 + h * 64 + ck * 8; pq[i] = *(const u32x4*)src; pk[i] = *(const u32x4*)(src + 256); }
    }
#pragma unroll
    for (int i = 0; i < 4; ++i) {
      const int q_ = tidp + i * 256, j = q_ & 63, cv = q_ >> 6;
      pv[i] = (u32x4){0u, 0u, 0u, 0u};
      if (j < Ln) pv[i] = *(const u32x4*)(V + (size_t)(rowbase + t0n + j) * 512 + h * 128 + cv * 8);
    }
  };
  if (seg >= 0 && seg < 3) {
    prefetch(cb * 64, threadIdx.x);
    for (int c = cb; c < ce; ++c) {
      const int t0 = c * 64, Lc = min(64, T - t0);
      int tid_o = threadIdx.x; asm volatile("" : "+v"(tid_o));
      const int tid = tid_o, lane = tid & 63, w = tid >> 6, l15 = lane & 15, l4 = lane >> 4;
      __syncthreads();
#pragma unroll
      for (int i = 0; i < 2; ++i) {
        const int q_ = tid + i * 256, j = q_ & 63, ck = q_ >> 6;
        const u32x4 kv = pk[i];
        const float kd = __builtin_amdgcn_exp2f((float)(Lc - 1 - j) * lg2);
#pragma unroll
        for (int e = 0; e < 4; ++e) {
          *(bf16_t*)(sKdT + (ck * 8 + 2 * e) * 144 + j * 2) = (bf16_t)f2bf(__uint_as_float(kv[e] << 16) * kd);
          *(bf16_t*)(sKdT + (ck * 8 + 2 * e + 1) * 144 + j * 2) = (bf16_t)f2bf(__uint_as_float(kv[e] & 0xffff0000u) * kd);
        }
      }
#pragma unroll
      for (int i = 0; i < 4; ++i) {
        const int q_ = tid + i * 256, j = q_ & 63, cv = q_ >> 6;
        const u32x4 vv = pv[i];
#pragma unroll
        for (int e = 0; e < 4; ++e) {
          *(bf16_t*)(sVT + (cv * 8 + 2 * e) * 144 + j * 2) = (bf16_t)(vv[e] & 0xffffu);
          *(bf16_t*)(sVT + (cv * 8 + 2 * e + 1) * 144 + j * 2) = (bf16_t)(vv[e] >> 16);
        }
      }
      if (c + 1 < ce) prefetch(t0 + 64, tid);
      __syncthreads();
      const float gl = __builtin_amdgcn_exp2f((float)Lc * lg2);
      bf16x8 bV[2][2];
#pragma unroll
      for (int vt = 0; vt < 2; ++vt)
#pragma unroll
        for (int kk = 0; kk < 2; ++kk) bV[vt][kk] = *(const bf16x8*)(sVT + (32 * w + vt * 16 + l15) * 144 + kk * 64 + l4 * 16);
#pragma unroll
      for (int dt = 0; dt < 4; ++dt) {
        bf16x8 bK[2];
#pragma unroll
        for (int kk = 0; kk < 2; ++kk) bK[kk] = *(const bf16x8*)(sKdT + (dt * 16 + l15) * 144 + kk * 64 + l4 * 16);
#pragma unroll
        for (int vt = 0; vt < 2; ++vt) {
          f32x4 a = ST[vt][dt] * gl;
#pragma unroll
          for (int kk = 0; kk < 2; ++kk) a = __builtin_amdgcn_mfma_f32_16x16x32_bf16(bV[vt][kk], bK[kk], a, 0, 0, 0);
          ST[vt][dt] = a;
        }
      }
    }
    float* lp = loc + (size_t)seg * 8192;
#pragma unroll
    for (int vt = 0; vt < 2; ++vt)
#pragma unroll
      for (int dt = 0; dt < 4; ++dt)
        *(float4*)(lp + (size_t)(dt * 16 + l15) * 128 + 32 * w + vt * 16 + l4 * 4) = make_float4(ST[vt][dt][0], ST[vt][dt][1], ST[vt][dt][2], ST[vt][dt][3]);
    __threadfence();
    __syncthreads();
    if (threadIdx.x == 0) { asm volatile("s_waitcnt vmcnt(0)" ::: "memory"); __hip_atomic_store(flags + seg, 1u, __ATOMIC_RELAXED, __HIP_MEMORY_SCOPE_AGENT); }
  }
#pragma unroll
  for (int vt = 0; vt < 2; ++vt)
#pragma unroll
    for (int dt = 0; dt < 4; ++dt) ST[vt][dt] = (f32x4){0.f, 0.f, 0.f, 0.f};
  if (seg > 0) {
    if (threadIdx.x == 0) {
      for (int s2 = 0; s2 < seg; ++s2) { unsigned sp = 0; while (__hip_atomic_load(flags + s2, __ATOMIC_RELAXED, __HIP_MEMORY_SCOPE_AGENT) == 0u) { __builtin_amdgcn_s_sleep(2); if (++sp > (1u << 22)) break; } }
      __builtin_amdgcn_fence(__ATOMIC_ACQUIRE, "agent");
      asm volatile("s_waitcnt vmcnt(0)" ::: "memory");
    }
    __syncthreads();
    for (int s2 = 0; s2 < seg; ++s2) {
      const float dk = __builtin_amdgcn_exp2f((float)(64 * (cb - 8 * (s2 + 1))) * lg2);
      const float* lp = loc + (size_t)s2 * 8192;
#pragma unroll
      for (int vt = 0; vt < 2; ++vt)
#pragma unroll
        for (int dt = 0; dt < 4; ++dt) {
          const float4 t4 = *(const float4*)(lp + (size_t)(dt * 16 + l15) * 128 + 32 * w + vt * 16 + l4 * 4);
          ST[vt][dt][0] += dk * t4.x; ST[vt][dt][1] += dk * t4.y; ST[vt][dt][2] += dk * t4.z; ST[vt][dt][3] += dk * t4.w;
        }
    }
  } else if (S_in) {
#pragma unroll
    for (int vt = 0; vt < 2; ++vt)
#pragma unroll
      for (int dt = 0; dt < 4; ++dt) {
        const float4 t4 = *(const float4*)(S_in + (size_t)(dt * 16 + l15) * 128 + 32 * w + vt * 16 + l4 * 4);
        ST[vt][dt][0] = t4.x; ST[vt][dt][1] = t4.y; ST[vt][dt][2] = t4.z; ST[vt][dt][3] = t4.w;
      }
  }
  __syncthreads();
#pragma unroll
  for (int vt = 0; vt < 2; ++vt)
#pragma unroll
    for (int dt = 0; dt < 4; ++dt)
#pragma unroll
      for (int jj = 0; jj < 4; ++jj) *(bf16_t*)(sST + (32 * w + vt * 16 + l4 * 4 + jj) * 144 + (dt * 16 + l15) * 2) = (bf16_t)f2bf(ST[vt][dt][jj]);
  prefetch(cb * 64, threadIdx.x);
  for (int c = cb; c < ce; ++c) {
    const int t0 = c * 64, Lc = min(64, T - t0);
    int tid_o = threadIdx.x; asm volatile("" : "+v"(tid_o));
    const int tid = tid_o, lane = tid & 63, w = tid >> 6, l15 = lane & 15, l4 = lane >> 4;
    __syncthreads();
#pragma unroll
    for (int i = 0; i < 2; ++i) {
      const int q_ = tid + i * 256, j = q_ & 63, ck = q_ >> 6;
      const u32x4 kv = pk[i];
      *(u32x4*)(sQ + j * 144 + ck * 16) = pq[i]; *(u32x4*)(sK + j * 144 + ck * 16) = kv;
      const float kd = __builtin_amdgcn_exp2f((float)(Lc - 1 - j) * lg2);
#pragma unroll
      for (int e = 0; e < 4; ++e) {
        *(bf16_t*)(sKdT + (ck * 8 + 2 * e) * 144 + j * 2) = (bf16_t)f2bf(__uint_as_float(kv[e] << 16) * kd);
        *(bf16_t*)(sKdT + (ck * 8 + 2 * e + 1) * 144 + j * 2) = (bf16_t)f2bf(__uint_as_float(kv[e] & 0xffff0000u) * kd);
      }
    }
#pragma unroll
    for (int i = 0; i < 4; ++i) {
      const int q_ = tid + i * 256, j = q_ & 63, cv = q_ >> 6;
      const u32x4 vv = pv[i];
#pragma unroll
      for (int e = 0; e < 4; ++e) {
        *(bf16_t*)(sVT + (cv * 8 + 2 * e) * 144 + j * 2) = (bf16_t)(vv[e] & 0xffffu);
        *(bf16_t*)(sVT + (cv * 8 + 2 * e + 1) * 144 + j * 2) = (bf16_t)(vv[e] >> 16);
      }
    }
    if (c + 1 < ce) prefetch(t0 + 64, tid);
    __syncthreads();
    {
      f32x4 sc[4];
#pragma unroll
      for (int jt = 0; jt < 4; ++jt) sc[jt] = (f32x4){0.f, 0.f, 0.f, 0.f};
#pragma unroll
      for (int kk = 0; kk < 2; ++kk) {
        const bf16x8 aq = *(const bf16x8*)(sQ + (16 * w + l15) * 144 + kk * 64 + l4 * 16);
#pragma unroll
        for (int jt = 0; jt < 4; ++jt) { const bf16x8 bk = *(const bf16x8*)(sK + (jt * 16 + l15) * 144 + kk * 64 + l4 * 16); sc[jt] = __builtin_amdgcn_mfma_f32_16x16x32_bf16(aq, bk, sc[jt], 0, 0, 0); }
      }
#pragma unroll
      for (int jt = 0; jt < 4; ++jt)
#pragma unroll
        for (int jj = 0; jj < 4; ++jj) {
          const int i = 16 * w + l4 * 4 + jj, j = jt * 16 + l15;
          const float pv = i >= j ? sc[jt][jj] * __builtin_amdgcn_exp2f((float)(i - j) * lg2) : 0.f;
          *(bf16_t*)(sP + i * 144 + j * 2) = (bf16_t)f2bf(pv);
        }
    }
    __syncthreads();
    f32x4 o[4][2];
    {
      bf16x8 bV[2][2], bS[2][2];
#pragma unroll
      for (int vt = 0; vt < 2; ++vt)
#pragma unroll
        for (int kk = 0; kk < 2; ++kk) {
          bV[vt][kk] = *(const bf16x8*)(sVT + (32 * w + vt * 16 + l15) * 144 + kk * 64 + l4 * 16);
          bS[vt][kk] = *(const bf16x8*)(sST + (32 * w + vt * 16 + l15) * 144 + kk * 64 + l4 * 16);
        }
#pragma unroll
      for (int it = 0; it < 4; ++it) {
        bf16x8 aP[2], aQ[2];
#pragma unroll
        for (int kk = 0; kk < 2; ++kk) { aP[kk] = *(const bf16x8*)(sP + (it * 16 + l15) * 144 + kk * 64 + l4 * 16); aQ[kk] = *(const bf16x8*)(sQ + (it * 16 + l15) * 144 + kk * 64 + l4 * 16); }
#pragma unroll
        for (int vt = 0; vt < 2; ++vt) {
          f32x4 a1 = (f32x4){0.f, 0.f, 0.f, 0.f}, a2 = (f32x4){0.f, 0.f, 0.f, 0.f};
#pragma unroll
          for (int kk = 0; kk < 2; ++kk) { a1 = __builtin_amdgcn_mfma_f32_16x16x32_bf16(aP[kk], bV[vt][kk], a1, 0, 0, 0); a2 = __builtin_amdgcn_mfma_f32_16x16x32_bf16(aQ[kk], bS[vt][kk], a2, 0, 0, 0); }
#pragma unroll
          for (int jj = 0; jj < 4; ++jj) { const int i = it * 16 + l4 * 4 + jj; o[it][vt][jj] = a1[jj] + __builtin_amdgcn_exp2f((float)(i + 1) * lg2) * a2[jj]; }
        }
      }
      const float gl = __builtin_amdgcn_exp2f((float)Lc * lg2);
#pragma unroll
      for (int dt = 0; dt < 4; ++dt) {
        bf16x8 bK[2];
#pragma unroll
        for (int kk = 0; kk < 2; ++kk) bK[kk] = *(const bf16x8*)(sKdT + (dt * 16 + l15) * 144 + kk * 64 + l4 * 16);
#pragma unroll
        for (int vt = 0; vt < 2; ++vt) {
          f32x4 a = ST[vt][dt] * gl;
#pragma unroll
          for (int kk = 0; kk < 2; ++kk) a = __builtin_amdgcn_mfma_f32_16x16x32_bf16(bV[vt][kk], bK[kk], a, 0, 0, 0);
          ST[vt][dt] = a;
#pragma unroll
          for (int jj = 0; jj < 4; ++jj) *(bf16_t*)(sST + (32 * w + vt * 16 + l4 * 4 + jj) * 144 + (dt * 16 + l15) * 2) = (bf16_t)f2bf(a[jj]);
        }
      }
    }
    unsigned short grv[4][4][2];
#pragma unroll
    for (int it = 0; it < 4; ++it)
#pragma unroll
      for (int jj = 0; jj < 4; ++jj) {
        const int i = it * 16 + l4 * 4 + jj;
#pragma unroll
        for (int vt = 0; vt < 2; ++vt) grv[it][jj][vt] = i < Lc ? GR[(size_t)(rowbase + t0 + i) * 512 + h * 128 + 32 * w + vt * 16 + l15] : (unsigned short)0;
      }
#pragma unroll
    for (int it = 0; it < 4; ++it)
#pragma unroll
      for (int jj = 0; jj < 4; ++jj) {
        float s1 = o[it][0][jj] + o[it][1][jj], s2 = o[it][0][jj] * o[it][0][jj] + o[it][1][jj] * o[it][1][jj];
        s1 = rowsum16(s1); s2 = rowsum16(s2);
        if (l15 == 0) { const int i = it * 16 + l4 * 4 + jj; part[(w * 64 + i) * 2] = s1; part[(w * 64 + i) * 2 + 1] = s2; }
      }
    const float gn[2] = {p.ret_gn_g[h * 128 + 32 * w + l15], p.ret_gn_g[h * 128 + 32 * w + 16 + l15]};
    __syncthreads();
#pragma unroll
    for (int it = 0; it < 4; ++it)
#pragma unroll
      for (int jj = 0; jj < 4; ++jj) {
        const int i = it * 16 + l4 * 4 + jj;
        float s1 = 0.f, s2 = 0.f;
#pragma unroll
        for (int ww = 0; ww < 4; ++ww) { s1 += part[(ww * 64 + i) * 2]; s2 += part[(ww * 64 + i) * 2 + 1]; }
        const float mean = s1 * (1.f / 128.f), var = fmaxf(s2 * (1.f / 128.f) - mean * mean, 0.f), rstd = rsqrtf(var + 1e-6f);
        if (i < Lc) {
#pragma unroll
          for (int vt = 0; vt < 2; ++vt) {
            const int v = 32 * w + vt * 16 + l15;
            bf16_t* gp = GR + (size_t)(rowbase + t0 + i) * 512 + h * 128 + v;
            *gp = (bf16_t)f2bf((o[it][vt][jj] - mean) * rstd * gn[vt] * bf2f(grv[it][jj][vt]));
          }
        }
      }
  }
  if (S_out)
#pragma unroll
  for (int vt = 0; vt < 2; ++vt)
#pragma unroll
    for (int dt = 0; dt < 4; ++dt)
      *(float4*)(S_out + (size_t)(dt * 16 + l15) * 128 + 32 * w + vt * 16 + l4 * 4) = make_float4(ST[vt][dt][0], ST[vt][dt][1], ST[vt][dt][2], ST[vt][dt][3]);
}

constexpr size_t OO_LOC = 56000000;
constexpr int NQ_LIGHT = 4608, NQ_TOTAL = 4608 + 3 * 704;
__device__ __forceinline__ void phase_scan(const Params& p, unsigned char* lds, volatile LAS unsigned* qslot) {
  const int G = gridDim.x;
  unsigned* flags_all = (unsigned*)(p.ws + OFF_BAR + 14336);
  unsigned* qctr = (unsigned*)(p.ws + OFF_BAR + 15360);
  float* loc_all = (float*)((unsigned char*)p.out + OO_LOC);
  int hid = blockIdx.x;
  bool heavy = true;
#pragma unroll 1
  while (true) {
    int item;
    if (heavy) { if (hid < 384) { item = hid; hid += G; } else { heavy = false; continue; } }
    else {
      __syncthreads();
      if (threadIdx.x == 0) *qslot = atomicAdd(qctr, 1u);
      __syncthreads();
      const int qi = (int)*qslot;
      if (qi >= NQ_TOTAL) break;
      item = 384 + qi;
    }
    int kind; int rowbase = 0, T = 0, h = 0, rb = 0, cb = 0, ce = 0, seg = -1; const float* shp = nullptr; const float* sin = nullptr; float* sout = nullptr; float* loc = nullptr; unsigned* flg = nullptr;
    if (item < 256) { const int j = item >> 3, seq = (item & 7) * 8 + (j >> 2), b = seq >> 3; rb = j & 3; h = seq & 7; kind = 0; rowbase = b * TP; T = TP; sout = p.out + O_WKVP + (size_t)seq * 4096; }
    else if (item < 384) { const int idx = item - 256, bh = idx >> 2, b = bh >> 2; seg = idx & 3; h = bh & 3; kind = 1; rowbase = b * TP; T = TP; cb = seg * 8; ce = seg == 3 ? 33 : cb + 8;
      sout = seg == 3 ? p.out + O_RETP + (size_t)bh * 8192 : nullptr; loc = loc_all + (size_t)bh * 3 * 8192; flg = flags_all + bh * 4; }
    else if (item < 384 + 4096) { const int it = item - 384, seq = it >> 2, b = seq >> 3; rb = it & 3; h = seq & 7; kind = 0; rowbase = MP + b * 4; T = 4;
      shp = p.state_shift + (size_t)b * 1792; sin = p.state_wkv + (size_t)seq * 4096; sout = p.out + O_WKVS + (size_t)seq * 4096; }
    else if (item < 384 + NQ_LIGHT) { const int bh = item - 384 - 4096, b = bh >> 2; h = bh & 3; kind = 1; rowbase = MP + b * 4; T = 4; cb = 0; ce = 1; sin = p.state_ret + (size_t)bh * 8192; sout = p.out + O_RETS + (size_t)bh * 8192; }
    else kind = 2;
    if (kind == 0) {
      if (item < 256) __builtin_amdgcn_s_setprio(3);
      const int nrep = ((DUP6 == 1 && item < 256) || (DUP6 == 2 && item >= 384)) ? 2 : 1;
#pragma unroll 1
      for (int rep = 0; rep < nrep; ++rep) rwkv_item(p, rowbase, T, h, rb, shp, sin, sout, lds);
      if (item < 256) __builtin_amdgcn_s_setprio(0);
    }
    else if (kind == 1) ret_item(p, rowbase, T, h, sin, sout, lds, cb, ce, seg, loc, flg);
    else {
      const int tt = item - 384 - NQ_LIGHT, job = tt / 704, t = tt - job * 704;
      const float* src = job == 0 ? p.ffn2_wg : (job == 1 ? p.ffn2_wu : p.ffn2_wd);
      transpose_tile(src, job == 2 ? 2816 : 1024, job == 2 ? 1024 : 2816, (bf16_t*)(p.ws + (job == 2 ? OFF_W1D : OFF_W1GU)), job == 2 ? 1 : 2, job == 1 ? 1 : 0, t, lds);
    }
  }
}

__device__ __forceinline__ void phase_post(const Params& p, unsigned char* lds) {
  const int tid = threadIdx.x, h = (tid >> 4) & 7, c4 = tid & 15, ch = h * 64 + c4 * 4;
  bf16_t* Y = (bf16_t*)(p.ws + OFF_Y); const bf16_t* PR = (const bf16_t*)(p.ws + OFF_PR);
  const bf16_t* GG = (const bf16_t*)((unsigned char*)p.out + OO_GG); const float* RHO = (const float*)((unsigned char*)p.out + OO_RHO);
  float muv[4], lg[4], lb[4];
#pragma unroll
  for (int e = 0; e < 4; ++e) { muv[e] = p.mu[1024 + ch + e]; lg[e] = p.lnx_g[ch + e]; lb[e] = p.lnx_b[ch + e]; }
  for (int pr = blockIdx.x; pr < M_TOK / 2; pr += gridDim.x) {
    const int row = pr * 2 + (tid >> 7);
    float y[4], cv[4], qv[4], g[4];
    unpk4(*(const uint2*)(Y + (size_t)row * 512 + ch), y);
    unpk4(*(const uint2*)(PR + (size_t)row * 1792 + 1024 + ch), cv);
    unpk4(*(const uint2*)(GG + (size_t)row * 512 + ch), g);
    bool first; const float* sprev = nullptr;
    if (row < MP) first = (row % TP) == 0; else { const int r2 = row - MP; first = (r2 & 3) == 0; sprev = p.state_shift + (size_t)(r2 >> 2) * 1792 + 1024 + ch; }
    if (!first) unpk4(*(const uint2*)(PR + (size_t)(row - 1) * 1792 + 1024 + ch), qv);
    else {
#pragma unroll
      for (int e = 0; e < 4; ++e) qv[e] = sprev ? sprev[e] : 0.f;
    }
    const float rho = RHO[(size_t)row * 8 + h];
    float s = y[0] + y[1] + y[2] + y[3]; s = rowsum16(s);
    const float mean = s * (1.f / 64.f);
    float d[4], q = 0.f;
#pragma unroll
    for (int e = 0; e < 4; ++e) { d[e] = y[e] - mean; q += d[e] * d[e]; }
    q = rowsum16(q);
    const float rstd = rsqrtf(q * (1.f / 64.f) + 64e-5f);
    float o[4];
#pragma unroll
    for (int e = 0; e < 4; ++e) { const float v = cv[e] + (qv[e] - cv[e]) * muv[e]; o[e] = (d[e] * rstd * lg[e] + lb[e] + rho * v) * g[e]; }
    *(uint2*)(Y + (size_t)row * 512 + ch) = pk4(o[0], o[1], o[2], o[3]);
  }
}

__device__ __forceinline__ void phase_merge(const Params& p, unsigned char* lds) {
  const bf16_t* OR = (const bf16_t*)(p.ws + OFF_GR); const bf16_t* OW = (const bf16_t*)(p.ws + OFF_Y);
  const bf16_t* WR = (const bf16_t*)(p.ws + OFF_WR); const bf16_t* WWp = (const bf16_t*)(p.ws + OFF_WW);
  const bf16_t* GA = (const bf16_t*)((unsigned char*)p.out + OO_GA); const bf16_t* GB = (const bf16_t*)(p.ws + OFF_GB);
  bf16_t* MG = (bf16_t*)(p.ws + OFF_MG);
  const int nM = NMT5, nN = 8;
  for (int L = blockIdx.x; L < nM * nN; L += gridDim.x) {
    int tm, tn; tile_coords(L, nM, nN, tm, tn);
    f32x4 acc[5][4]; ZERO_ACC5(acc);
    gemm_tile_dma<5>(OR, 512, WR, 512, 512, tm * 160, tn * 128, acc, lds);
    EPI_VARS5;
#pragma unroll
    for (int mi = 0; mi < 5; ++mi) {
      const int row = rbase + mi * 16;
      if (row < M_TOK) {
#pragma unroll
        for (int ni = 0; ni < 4; ++ni) { float g[4]; unpk4(*(const uint2*)(GA + (size_t)row * 1024 + cbase + ni * 16), g);
          *(uint2*)(MG + (size_t)row * 1024 + cbase + ni * 16) = pk4(acc[mi][ni][0] * g[0], acc[mi][ni][1] * g[1], acc[mi][ni][2] * g[2], acc[mi][ni][3] * g[3]); }
      }
    }
    ZERO_ACC5(acc);
    gemm_tile_dma<5>(OW, 512, WWp, 512, 512, tm * 160, tn * 128, acc, lds);
#pragma unroll
    for (int mi = 0; mi < 5; ++mi) {
      const int row = rbase + mi * 16;
      if (row < M_TOK) {
#pragma unroll
        for (int ni = 0; ni < 4; ++ni) { float g[4], t[4]; unpk4(*(const uint2*)(GB + (size_t)row * 1024 + cbase + ni * 16), g);
          uint2* mp = (uint2*)(MG + (size_t)row * 1024 + cbase + ni * 16); unpk4(*mp, t);
          *mp = pk4(t[0] + acc[mi][ni][0] * g[0], t[1] + acc[mi][ni][1] * g[1], t[2] + acc[mi][ni][2] * g[2], t[3] + acc[mi][ni][3] * g[3]); }
      }
    }
  }
}

__device__ __forceinline__ void phase_wout(const Params& p, unsigned char* lds) {
  const bf16_t* A = (const bf16_t*)(p.ws + OFF_MG); const bf16_t* W = (const bf16_t*)(p.ws + OFF_WO); bf16_t* H = (bf16_t*)(p.ws + OFF_H);
  const int nM = NMT5, nN = 8;
  for (int L = blockIdx.x; L < nM * nN; L += gridDim.x) {
    int tm, tn; tile_coords(L, nM, nN, tm, tn);
    f32x4 acc[5][4]; ZERO_ACC5(acc);
    gemm_tile_dma<5>(A, 1024, W, 1024, 1024, tm * 160, tn * 128, acc, lds);
    EPI_VARS5;
#pragma unroll
    for (int mi = 0; mi < 5; ++mi) {
      const int row = rbase + mi * 16;
      if (row < M_TOK) {
#pragma unroll
        for (int ni = 0; ni < 4; ++ni) { bf16_t* hp = H + (size_t)row * 1024 + cbase + ni * 16; float h[4]; unpk4(*(const uint2*)hp, h); const f32x4 a = acc[mi][ni];
          *(uint2*)hp = pk4(h[0] + a[0], h[1] + a[1], h[2] + a[2], h[3] + a[3]); }
      }
    }
  }
}

__global__ void __launch_bounds__(256, 2) mega(Params p) {
  extern __shared__ __attribute__((aligned(16))) unsigned char lds[];
  cg::grid_group grid = cg::this_grid();
  const int lo = p.phase_lo, hi = p.phase_hi;
  __shared__ uint4 xb_words;
  if (threadIdx.x == 0) xb_words = make_uint4(0u, 0u, 0u, 0u);
  __syncthreads();
  XcdBarrier xb = xcd_barrier_post((unsigned*)(p.ws + OFF_BAR), (volatile LAS unsigned*)&xb_words);
  if (hi > 1000) grid.sync();
  unsigned long long tp0 = 0;
#define PROBE_WAIT() do { if (blockIdx.x == 0) { const unsigned long long t1 = __builtin_amdgcn_s_memrealtime(); while (__builtin_amdgcn_s_memrealtime() < t1 + (t1 - tp0)) __builtin_amdgcn_s_sleep(8); } } while (0)
#define RUN_PHASE(k, call) if (PEN(k) && lo <= (k) && (k) < hi) { if ((k) > lo) xcd_barrier(xb); \
    if (PROBE_PHASE >= 0 && (k) == PROBE_PHASE + 1) PROBE_WAIT(); \
    if (PROBE_PHASE == (k)) tp0 = __builtin_amdgcn_s_memrealtime(); \
    call; if (((DUPMASK) >> (k)) & 1) { call; } }
  RUN_PHASE(0, phase0(p, lds))
  RUN_PHASE(1, phase_ffn_up<true>(p, lds))
  RUN_PHASE(2, phase_ffn_down<true>(p, lds))
  RUN_PHASE(3, (rmsnorm_phase<1, 0>(p, p.mix_norm, (bf16_t*)(p.ws + OFF_A))))
  RUN_PHASE(4, phase_win(p, lds))
  RUN_PHASE(5, phase_lora_mfma(p, lds))
  RUN_PHASE(6, phase_scan(p, lds, ((volatile LAS unsigned*)&xb_words) + 2))
  RUN_PHASE(7, phase_post(p, lds))
  RUN_PHASE(8, phase_merge(p, lds))
  RUN_PHASE(9, phase_wout(p, lds))
  RUN_PHASE(10, (rmsnorm_phase<1, 0>(p, p.ffn2_norm, (bf16_t*)(p.ws + OFF_A))))
  RUN_PHASE(11, phase_ffn_up<false>(p, lds))
  RUN_PHASE(12, phase_ffn_down<false>(p, lds))
  RUN_PHASE(13, (rmsnorm_phase<2, 1>(p, p.final_norm, nullptr)))
  if (PROBE_PHASE == 13) { xcd_barrier(xb); PROBE_WAIT(); }
}

extern "C" void kernel_launch(void* const* d_in, const int* in_sizes, int n_in, void* d_out, int out_size, void* d_ws, size_t ws_size, hipStream_t stream) {
  static int grid_blocks = 0;
  if (grid_blocks == 0) {
    if (n_in != 32 || ws_size < WS_NEED || out_size != 26458112) { fprintf(stderr, "kernel_launch: unexpected sizes n_in %d ws %zu out %d\n", n_in, ws_size, out_size); grid_blocks = -1; return; }
    int dev = 0, cus = 0, per_cu = 0;
    hipGetDevice(&dev);
    hipDeviceGetAttribute(&cus, hipDeviceAttributeMultiprocessorCount, dev);
    if (hipFuncSetAttribute((const void*)mega, hipFuncAttributeMaxDynamicSharedMemorySize, LDS_BYTES) != hipSuccess) { fprintf(stderr, "hipFuncSetAttribute failed\n"); grid_blocks = -1; return; }
    hipOccupancyMaxActiveBlocksPerMultiprocessor(&per_cu, (const void*)mega, NT, LDS_BYTES);
    if (per_cu < 1) { fprintf(stderr, "occupancy query returned %d\n", per_cu); grid_blocks = -1; return; }
    if (per_cu > 2) per_cu = 2;
    grid_blocks = cus * per_cu;
  }
  if (grid_blocks < 0) return;
  if (hipMemsetAsync((unsigned char*)d_ws + OFF_BAR, 0, 16384, stream) != hipSuccess) { fprintf(stderr, "memset failed\n"); return; }
  Params p{};
  const float** pp = (const float**)&p;
  for (int i = 0; i < 32; ++i) pp[i] = (const float*)d_in[i];
  p.out = (float*)d_out; p.ws = (unsigned char*)d_ws;
  for (int j = 0; j < 32; ++j) p.invf[j] = (float)pow(10000.0, -(double)j / 32.0);
  for (int h = 0; h < 4; ++h) p.lg2g[h] = (float)log2(1.0 - exp2(-5.0 - (double)h));
#if SINGLE_LAUNCH
  p.phase_lo = 0; p.phase_hi = NPHASE;
  void* args[] = {&p};
  hipError_t e = hipLaunchCooperativeKernel((const void*)mega, dim3(grid_blocks), dim3(NT), args, LDS_BYTES, stream);
  if (e != hipSuccess) fprintf(stderr, "cooperative launch failed: %s (grid %d)\n", hipGetErrorString(e), grid_blocks);
#else
  for (int ph = 0; ph < NPHASE; ++ph) {
    p.phase_lo = ph; p.phase_hi = ph + 1;
    hipLaunchKernelGGL(mega, dim3(grid_blocks), dim3(NT), LDS_BYTES, stream, p);
  }
#endif
}
```
